# Optimizing an MI355X kernel written in HIP

```python
import math, functools
import jax, jax.numpy as jnp
from jax import lax
import numpy as np

D_MODEL = 1024
BATCH = 32
SEQ = 2048
DEPTH = 4
DEC_BATCH = 1
DEC_SEQ = 16384
PAST_LEN = 128

N_EVEN = (DEPTH + 1) // 2
N_ODD = DEPTH // 2

A_HEADS = 4
A_HEAD_DIM = 128
A_WIDTH = A_HEADS * A_HEAD_DIM
A_CHUNK = 64
B_HEADS = 8
B_KV_HEADS = 2
B_GROUP = B_HEADS // B_KV_HEADS
B_HEAD_DIM = 64
B_WIDTH = B_HEADS * B_HEAD_DIM
B_KV_WIDTH = B_KV_HEADS * B_HEAD_DIM
WINDOW = 128
ATTN_BLOCK = 128
AB_IN = 5 * A_WIDTH + B_WIDTH + 2 * B_KV_WIDTH
AB_MIX = A_WIDTH + B_WIDTH
C_WIDTH = 2 * D_MODEL
C_GROUPS = 8
C_GROUP_DIM = C_WIDTH // C_GROUPS
C_CHUNK = 128
FFN_DIM = ((8 * D_MODEL + 3 * 256 - 1) // (3 * 256)) * 256
DEEPNORM_ALPHA = (2.0 * DEPTH) ** 0.25
DEEPNORM_BETA = (8.0 * DEPTH) ** -0.25
LN_EPS = 1e-5
RMS_EPS = 1e-6

kernel_name = 'hgrn2_swa_gmlp_deepnorm_encoder'


def _layernorm(x, g, b):
    xf = x.astype(jnp.float32)
    mu = jnp.mean(xf, axis=-1, keepdims=True)
    var = jnp.mean(jnp.square(xf - mu), axis=-1, keepdims=True)
    return ((xf - mu) * lax.rsqrt(var + LN_EPS) * g.astype(jnp.float32) + b.astype(jnp.float32)).astype(x.dtype)


def _split(z, sizes):
    out, off = [], 0
    for s in sizes:
        out.append(z[..., off:off + s])
        off += s
    return out


def _gla_scan(q, k, v, logf):
    B, L, H, dk = q.shape
    dv = v.shape[-1]
    nc = L // A_CHUNK

    def chunks(a):
        return a.reshape(B, nc, A_CHUNK, H, a.shape[-1]).transpose(1, 0, 3, 2, 4)

    lower = jnp.tril(jnp.ones((A_CHUNK, A_CHUNK), dtype=bool))[:, :, None]

    def step(S, inp):
        qc, kc, vc, gc = inp
        b = jnp.cumsum(gc, axis=2)
        b_last = b[:, :, -1:, :]
        o = jnp.einsum('bhtd,bhde->bhte', qc * jnp.exp(b), S)
        diff = b[:, :, :, None, :] - b[:, :, None, :, :]
        decay = jnp.exp(jnp.where(lower, diff, -jnp.inf))
        scores = jnp.einsum('bhtd,bhtsd->bhts', qc, decay * kc[:, :, None, :, :])
        o = o + jnp.einsum('bhts,bhse->bhte', scores, vc)
        S = jnp.exp(b_last[:, :, 0, :, None]) * S + jnp.einsum('bhsd,bhse->bhde', kc * jnp.exp(b_last - b), vc)
        return S, o

    S0 = jnp.zeros((B, H, dk, dv), jnp.float32)
    _, o = lax.scan(step, S0, (chunks(q), chunks(k), chunks(v), chunks(logf)))
    return o.transpose(1, 0, 3, 2, 4).reshape(B, L, H, dv)


def _hgrn2(q_raw, ff_raw, fb_raw, i_raw, g_raw, lb_f, lb_b, norm_g):
    B, L, _ = q_raw.shape

    def heads(a):
        return a.reshape(B, L, A_HEADS, A_HEAD_DIM).astype(jnp.float32)

    q = jax.nn.silu(heads(q_raw))
    v = heads(i_raw)

    def gates(f_raw, lb):
        f_raw = heads(f_raw)
        lb = lb.astype(jnp.float32).reshape(A_HEADS, A_HEAD_DIM)
        logf = jnp.logaddexp(jnp.log(lb), jnp.log1p(-lb) + jax.nn.log_sigmoid(f_raw))
        k = (1.0 - lb) * jax.nn.sigmoid(-f_raw)
        return k, logf

    k_f, g_f = gates(ff_raw, lb_f)
    k_b, g_b = gates(fb_raw, lb_b)
    flip = lambda a: jnp.flip(a, axis=1)
    o = _gla_scan(q, k_f, v, g_f) + flip(_gla_scan(flip(q), flip(k_b), flip(v), flip(g_b)))
    o = o * lax.rsqrt(jnp.mean(jnp.square(o), axis=-1, keepdims=True) + RMS_EPS) * norm_g.astype(jnp.float32)
    o = o * jax.nn.silu(heads(g_raw))
    return o.reshape(B, L, A_WIDTH)


def _window_gqa(q_raw, k_raw, v_raw, sink):
    B, L, _ = q_raw.shape
    nb = L // ATTN_BLOCK
    q = q_raw.reshape(B, nb, ATTN_BLOCK, B_KV_HEADS, B_GROUP, B_HEAD_DIM).astype(jnp.float32)

    def neighbourhood(a):
        a = a.reshape(B, L, B_KV_HEADS, B_HEAD_DIM).astype(jnp.float32)
        ap = jnp.pad(a, ((0, 0), (ATTN_BLOCK, ATTN_BLOCK), (0, 0), (0, 0)))
        return jnp.concatenate(
            [ap[:, j * ATTN_BLOCK:j * ATTN_BLOCK + L].reshape(B, nb, ATTN_BLOCK, B_KV_HEADS, B_HEAD_DIM)
             for j in range(3)], axis=2)

    kb, vb = neighbourhood(k_raw), neighbourhood(v_raw)
    t = jnp.arange(ATTN_BLOCK)[:, None]
    s = jnp.arange(3 * ATTN_BLOCK)[None, :]
    dist = jnp.abs(t - s + ATTN_BLOCK)
    kpos = jnp.arange(nb)[:, None] * ATTN_BLOCK + jnp.arange(3 * ATTN_BLOCK)[None, :] - ATTN_BLOCK
    valid = (dist <= WINDOW)[None] & ((kpos >= 0) & (kpos < L))[:, None, :]
    slopes = jnp.exp2(-(8.0 / B_HEADS) * jnp.arange(1, B_HEADS + 1, dtype=jnp.float32))
    slopes = slopes.reshape(B_KV_HEADS, B_GROUP)[:, :, None, None]
    scores = jnp.einsum('bnqhgd,bnkhd->bnhgqk', q, kb) * (B_HEAD_DIM ** -0.5)
    scores = scores - slopes * dist.astype(jnp.float32)
    scores = jnp.where(valid[None, :, None, None], scores, -jnp.inf)
    sink_l = sink.astype(jnp.float32).reshape(B_KV_HEADS, B_GROUP)[:, :, None, None]
    m = jnp.maximum(jnp.max(scores, axis=-1, keepdims=True), sink_l)
    p = jnp.exp(scores - m)
    denom = jnp.sum(p, axis=-1, keepdims=True) + jnp.exp(sink_l - m)
    o = jnp.einsum('bnhgqk,bnkhd->bnqhgd', p / denom, vb)
    return o.reshape(B, L, B_WIDTH)


def _sgu(x, w_in, ln_g, ln_b, w_s, b_s, w_out):
    B, L, _ = x.shape
    z = jax.nn.gelu(x @ w_in, approximate=False)
    u, v = jnp.split(z, 2, axis=-1)
    v = _layernorm(v, ln_g, ln_b)
    v = v.reshape(B, L // C_CHUNK, C_CHUNK, C_GROUPS, C_GROUP_DIM)
    s = jnp.einsum('gts,bnsgc->bntgc', w_s, v) + b_s.T[:, :, None]
    return (u * s.reshape(B, L, C_WIDTH)) @ w_out


def _swiglu(x, wg, wu, wd):
    return (jax.nn.silu(x @ wg) * (x @ wu)) @ wd


def _trunk(x, w_in_ab, hgrn_lb_logits, hgrn_norm_g, attn_sink, w_out_ab, w_in_c, c_ln_g, c_ln_b, c_ws, c_bs,
           w_out_c, ffn_w_gate, ffn_w_up, ffn_w_down, ln_mix_g, ln_mix_b, ln_ffn_g, ln_ffn_b):
    p = jax.nn.softmax(hgrn_lb_logits.astype(jnp.float32), axis=0)
    lower_bounds = jnp.maximum(jnp.cumsum(p, axis=0) - p[0:1], 0.0)
    for layer in range(DEPTH):
        j = layer // 2
        if layer % 2 == 0:
            z = x @ w_in_ab[j]
            q_a, ff_a, fb_a, i_a, g_a, q_b, k_b, v_b = _split(
                z, (A_WIDTH,) * 5 + (B_WIDTH, B_KV_WIDTH, B_KV_WIDTH))
            o_a = _hgrn2(q_a, ff_a, fb_a, i_a, g_a, lower_bounds[j, 0], lower_bounds[j, 1], hgrn_norm_g[j])
            o_b = _window_gqa(q_b, k_b, v_b, attn_sink[j])
            y = jnp.concatenate([o_a.astype(x.dtype), o_b.astype(x.dtype)], axis=-1) @ w_out_ab[j]
        else:
            y = _sgu(x, w_in_c[j], c_ln_g[j], c_ln_b[j], c_ws[j], c_bs[j], w_out_c[j])
        x = _layernorm(DEEPNORM_ALPHA * x + y, ln_mix_g[layer], ln_mix_b[layer])
        x = _layernorm(DEEPNORM_ALPHA * x + _swiglu(x, ffn_w_gate[layer], ffn_w_up[layer], ffn_w_down[layer]),
                       ln_ffn_g[layer], ln_ffn_b[layer])
    return x


def setup_inputs(seed: int = 0) -> dict:
    key = jax.random.key(seed)
    ks = jax.random.split(key, 20)

    def nrm(k, shape, scale):
        return jax.random.normal(k, shape, jnp.float32) * scale

    return {
        'x_prompt': nrm(ks[0], (BATCH, SEQ, D_MODEL), 1.0),
        'x_sample': nrm(ks[1], (DEC_BATCH, DEC_SEQ, D_MODEL), 1.0),
        'w_in_ab': nrm(ks[2], (N_EVEN, D_MODEL, AB_IN), D_MODEL ** -0.5),
        'hgrn_lb_logits': nrm(ks[3], (N_EVEN, 2, A_WIDTH), 0.5),
        'hgrn_norm_g': 1.0 + nrm(ks[4], (N_EVEN, A_HEAD_DIM), 0.02),
        'attn_sink': nrm(ks[5], (N_EVEN, B_HEADS), 0.5),
        'w_out_ab': nrm(ks[6], (N_EVEN, AB_MIX, D_MODEL), AB_MIX ** -0.5 * DEEPNORM_BETA),
        'w_in_c': nrm(ks[7], (N_ODD, D_MODEL, 2 * C_WIDTH), D_MODEL ** -0.5),
        'c_ln_g': 1.0 + nrm(ks[8], (N_ODD, C_WIDTH), 0.02),
        'c_ln_b': nrm(ks[9], (N_ODD, C_WIDTH), 0.02),
        'c_ws': nrm(ks[10], (N_ODD, C_GROUPS, C_CHUNK, C_CHUNK), C_CHUNK ** -0.5),
        'c_bs': 1.0 + nrm(ks[11], (N_ODD, C_GROUPS, C_CHUNK), 0.02),
        'w_out_c': nrm(ks[12], (N_ODD, C_WIDTH, D_MODEL), C_WIDTH ** -0.5 * DEEPNORM_BETA),
        'ffn_w_gate': nrm(ks[13], (DEPTH, D_MODEL, FFN_DIM), D_MODEL ** -0.5),
        'ffn_w_up': nrm(ks[14], (DEPTH, D_MODEL, FFN_DIM), D_MODEL ** -0.5 * DEEPNORM_BETA),
        'ffn_w_down': nrm(ks[15], (DEPTH, FFN_DIM, D_MODEL), FFN_DIM ** -0.5 * DEEPNORM_BETA),
        'ln_mix_g': 1.0 + nrm(ks[16], (DEPTH, D_MODEL), 0.02),
        'ln_mix_b': nrm(ks[17], (DEPTH, D_MODEL), 0.02),
        'ln_ffn_g': 1.0 + nrm(ks[18], (DEPTH, D_MODEL), 0.02),
        'ln_ffn_b': nrm(ks[19], (DEPTH, D_MODEL), 0.02),
    }


def reference(x_prompt, x_sample, w_in_ab, hgrn_lb_logits, hgrn_norm_g, attn_sink, w_out_ab, w_in_c, c_ln_g,
              c_ln_b, c_ws, c_bs, w_out_c, ffn_w_gate, ffn_w_up, ffn_w_down, ln_mix_g, ln_mix_b, ln_ffn_g,
              ln_ffn_b):
    trunk = functools.partial(
        _trunk, w_in_ab=w_in_ab, hgrn_lb_logits=hgrn_lb_logits, hgrn_norm_g=hgrn_norm_g, attn_sink=attn_sink,
        w_out_ab=w_out_ab, w_in_c=w_in_c, c_ln_g=c_ln_g, c_ln_b=c_ln_b, c_ws=c_ws, c_bs=c_bs, w_out_c=w_out_c,
        ffn_w_gate=ffn_w_gate, ffn_w_up=ffn_w_up, ffn_w_down=ffn_w_down, ln_mix_g=ln_mix_g, ln_mix_b=ln_mix_b,
        ln_ffn_g=ln_ffn_g, ln_ffn_b=ln_ffn_b)
    y_prompt = trunk(x_prompt)
    y_sample = trunk(x_sample)
    return (y_prompt, y_sample)
```

```cpp
#include <hip/hip_runtime.h>
#include <cstdio>
#include <cstdint>

#ifndef NAIVE_HGRN
#define NAIVE_HGRN 0
#endif
#ifndef NAIVE_ATTN
#define NAIVE_ATTN 0
#endif
#ifndef REP_G
#define REP_G 1
#endif
#ifndef REP_HA
#define REP_HA 1
#endif
#ifndef REP_ATT
#define REP_ATT 1
#endif
#ifndef REP_HBC
#define REP_HBC 1
#endif
#ifndef NAIVE_SGU
#define NAIVE_SGU 0
#endif

__device__ __forceinline__ int tid_from_wave(int wave_s) { return wave_s * 64 + (int)__builtin_amdgcn_mbcnt_hi(~0u, __builtin_amdgcn_mbcnt_lo(~0u, 0u)); }
namespace pg8 {
#define PG8_LAS __attribute__((address_space(3)))
typedef unsigned short bf16_t;
typedef short bf16x8 __attribute__((ext_vector_type(8)));
typedef _Float16 f16x8 __attribute__((ext_vector_type(8)));
typedef _Float16 f16x2 __attribute__((ext_vector_type(2)));
typedef float f32x4 __attribute__((ext_vector_type(4)));
typedef float f32x2 __attribute__((ext_vector_type(2)));
typedef unsigned u32x4 __attribute__((ext_vector_type(4)));
typedef unsigned u32x2 __attribute__((ext_vector_type(2)));
constexpr int BM = 256, BK = 64, HALF = 128, HTB = HALF * BK * 2, STAGE_BYTES = 8 * HTB, NXCD = 8, WGM = 8;

__host__ __device__ __forceinline__ int lds_byte(int r, int c) { const int st = (r >> 4) * 2 + (c >> 5), rr = r & 15, cc = c & 31, ob = rr * 64 + cc * 2; return st * 1024 + (ob ^ (((ob >> 9) & 1) << 5)); }
__host__ __device__ __forceinline__ void stage_rc(int b, int& R, int& C) { const int st = b / 1024, sb = b % 1024, swz = sb ^ (((sb >> 9) & 1) << 5); R = (st >> 1) * 16 + swz / 64; C = (st & 1) * 32 + (swz % 64) / 2; }
__host__ __device__ __forceinline__ int perm32(int rho) { const int n = rho >> 4, i = rho & 15; return 8 * (i >> 2) + 4 * n + (i & 3); }

struct Unit { int pm, pn; };
struct Gemm { const bf16_t* A; const bf16_t* Bt; int M, N, K; };

struct StaticOrder {
    int nM, nN, nwg, G, c; bool rev;
    __host__ __device__ void init(int M, int N, int G_, int c_, bool rev_ = false) { nM = M / BM; nN = N / BM; nwg = nM * nN; G = G_; c = c_; rev = rev_; }
    __host__ __device__ bool next(int i, Unit& u) const {
        const long L = (long)i * G + c; if (L >= nwg) return false;
        int wgid = (int)L; { const int q = nwg / NXCD, r = nwg % NXCD, xcd = wgid % NXCD, off = wgid / NXCD, cnt = xcd < r ? q + 1 : q; wgid = (xcd < r ? xcd * (q + 1) : r * (q + 1) + (xcd - r) * q) + (rev ? cnt - 1 - off : off); }
        const int nig = WGM * nN, gid = wgid / nig, fm = gid * WGM, gsz = (nM - fm) < WGM ? (nM - fm) : WGM;
        u.pm = fm + ((wgid % nig) % gsz); u.pn = (wgid % nig) / gsz; return true;
    }
    __device__ __forceinline__ void a_ready(const Unit&) const {}
    __device__ __forceinline__ void done(const Unit&) const {}
};

typedef __bf16 bf16x2_t __attribute__((ext_vector_type(2)));
__device__ __forceinline__ unsigned cvt_pk_bf16(float lo, float hi) { bf16x2_t v = {(__bf16)lo, (__bf16)hi}; return __builtin_bit_cast(unsigned, v); }
__device__ __forceinline__ f32x2 gelu_pk(f32x2 v) {
    const f32x2 av = __builtin_elementwise_abs(v), d = av * 0.2316418882f + 1.0f;
    f32x2 t; t.x = __builtin_amdgcn_rcpf(d.x); t.y = __builtin_amdgcn_rcpf(d.y);
    f32x2 q = t * 0.5307027145f + (-0.7265760135f); q = q * t + 0.7107068705f; q = q * t + (-0.142248368f); q = q * t + 0.127414796f; q = q * t;
    const f32x2 s = (v * v) * (-0.72134752044f);
    f32x2 e; e.x = __builtin_amdgcn_exp2f(s.x); e.y = __builtin_amdgcn_exp2f(s.y);
    const f32x2 m = v * (q * e), r = v - m;
    f32x2 o; o.x = v.x < 0.f ? m.x : r.x; o.y = v.y < 0.f ? m.y : r.y; return o;
}

constexpr float LN_EPS = 1e-5f;
__device__ __forceinline__ void row_mu_rstd(const float* stat, int row, float& mu, float& rstd) {
    const f32x4* p = (const f32x4*)(stat + (size_t)row * 32);
    f32x4 v[8]; float ms = 0.f;
#pragma unroll
    for (int i = 0; i < 8; ++i) { v[i] = p[i]; ms += v[i][0] + v[i][2]; }
    const float mean = ms * (1.0f / 16.0f); float q = 0.f;
#pragma unroll
    for (int i = 0; i < 8; ++i) { const float d0 = v[i][0] - mean, d1 = v[i][2] - mean; q += (v[i][1] + v[i][3]) + 64.0f * (d0 * d0 + d1 * d1); }
    mu = mean; rstd = __builtin_amdgcn_rsqf(q * (1.0f / 1024.0f) + LN_EPS);
}

constexpr int STAT_TAB_OFF = STAGE_BYTES;
__device__ __forceinline__ float lane_xor1(float x) { return __builtin_bit_cast(float, __builtin_amdgcn_update_dpp(0, __builtin_bit_cast(int, x), 0xB1, 0xF, 0xF, false)); }
__device__ __forceinline__ void stat_tab_build(PG8_LAS unsigned char* lds, const float* stat, int pm, int wr, int wc, int lane) {
    const int lrow = (wc >> 1) * HALF + wr * 64 + (wc & 1) * 32 + (lane >> 1);
    const f32x4* p = (const f32x4*)(stat + (size_t)(pm * BM + lrow) * 32 + (lane & 1) * 16);
    const f32x4 v0 = p[0], v1 = p[1], v2 = p[2], v3 = p[3];
    float ms = ((v0[0] + v0[2]) + (v1[0] + v1[2])) + ((v2[0] + v2[2]) + (v3[0] + v3[2])); ms += lane_xor1(ms);
    const float mean = ms * (1.0f / 16.0f);
    const float d0 = v0[0] - mean, d1 = v0[2] - mean, d2 = v1[0] - mean, d3 = v1[2] - mean, d4 = v2[0] - mean, d5 = v2[2] - mean, d6 = v3[0] - mean, d7 = v3[2] - mean;
    float q = (((v0[1] + v0[3]) + (v1[1] + v1[3])) + ((v2[1] + v2[3]) + (v3[1] + v3[3]))) + 64.0f * (((d0 * d0 + d1 * d1) + (d2 * d2 + d3 * d3)) + ((d4 * d4 + d5 * d5) + (d6 * d6 + d7 * d7)));
    q += lane_xor1(q);
    const float rstd = __builtin_amdgcn_rsqf(q * (1.0f / 1024.0f) + LN_EPS);
    if ((lane & 1) == 0) *(PG8_LAS f32x2*)(lds + STAT_TAB_OFF + lrow * 8) = (f32x2){mean, rstd};
    asm volatile("s_waitcnt lgkmcnt(0)" ::: "memory");
    __builtin_amdgcn_s_barrier();
}
__device__ __forceinline__ void stat_tab_get(PG8_LAS unsigned char* lds, int lrow, float& mu, float& rstd) { const f32x2 t = *(const PG8_LAS f32x2*)(lds + STAT_TAB_OFF + lrow * 8); mu = t.x; rstd = t.y; }
#define RG_ROW(rg) (row0 + ((rg) >> 2) * HALF + ((rg) & 3) * 16)

struct EpiZ {
    static constexpr bool PERM = true, AFTER_DRAIN = false;
    bf16_t* O; int ldc; const float* stat; const float* gW; const float* bW;
    __device__ __forceinline__ void operator()(const f32x4 (&acc)[2][2][4][2], const Unit& u, int wr, int wc, int fr, int fq, PG8_LAS unsigned char* lds, bool tab_valid) const {
        const int row0 = u.pm * BM + wr * 64 + fr, col0 = u.pn * BM + wc * 32 + 8 * fq;
        f32x4 gv[2][2], bv[2][2];
#pragma unroll
        for (int bj = 0; bj < 2; ++bj)
#pragma unroll
            for (int n = 0; n < 2; ++n) { gv[bj][n] = stat ? *(const f32x4*)(gW + col0 + bj * HALF + 4 * n) : (f32x4){0.f, 0.f, 0.f, 0.f}; bv[bj][n] = stat ? *(const f32x4*)(bW + col0 + bj * HALF + 4 * n) : (f32x4){0.f, 0.f, 0.f, 0.f}; }
        if (stat && !tab_valid) stat_tab_build(lds, stat, u.pm, wr, wc, fr + 16 * fq);
#pragma unroll
        for (int rg = 0; rg < 8; ++rg) { const int ai = rg >> 2, m = rg & 3; const int row = RG_ROW(rg); bf16_t* rowp = O + (size_t)row * ldc + col0;
                float mu = 0.f, rstd = 1.f; if (stat) stat_tab_get(lds, row - u.pm * BM, mu, rstd);
#pragma unroll
                for (int bj = 0; bj < 2; ++bj) { const f32x4 v0 = (acc[ai][bj][m][0] - mu * gv[bj][0]) * rstd + bv[bj][0], v1 = (acc[ai][bj][m][1] - mu * gv[bj][1]) * rstd + bv[bj][1];
                    u32x4 w; w.x = cvt_pk_bf16(v0[0], v0[1]); w.y = cvt_pk_bf16(v0[2], v0[3]); w.z = cvt_pk_bf16(v1[0], v1[1]); w.w = cvt_pk_bf16(v1[2], v1[3]);
                    *(u32x4*)(rowp + bj * HALF) = w; }
                asm volatile("" ::: "memory"); }
    }
};
struct EpiGeluUV {
    static constexpr bool PERM = true, AFTER_DRAIN = false;
    bf16_t* U; bf16_t* V; float* vstat; const float* stat; const float* gW; const float* bW;
    __device__ __forceinline__ void operator()(const f32x4 (&acc)[2][2][4][2], const Unit& u, int wr, int wc, int fr, int fq, PG8_LAS unsigned char* lds, bool tab_valid) const {
        const int row0 = u.pm * BM + wr * 64 + fr, col0 = u.pn * BM + wc * 32 + 8 * fq;
        const bool isv = u.pn >= 8; bf16_t* base = isv ? V : U; const int ocol0 = col0 - (isv ? 2048 : 0);
        f32x4 gv[2][2], bv[2][2];
#pragma unroll
        for (int bj = 0; bj < 2; ++bj)
#pragma unroll
            for (int n = 0; n < 2; ++n) { gv[bj][n] = *(const f32x4*)(gW + col0 + bj * HALF + 4 * n); bv[bj][n] = *(const f32x4*)(bW + col0 + bj * HALF + 4 * n); }
        if (!tab_valid) stat_tab_build(lds, stat, u.pm, wr, wc, fr + 16 * fq);
#pragma unroll
        for (int rg = 0; rg < 8; ++rg) { const int ai = rg >> 2, m = rg & 3; const int row = RG_ROW(rg); bf16_t* rowp = base + (size_t)row * 2048 + ocol0;
                float mu, rstd; stat_tab_get(lds, row - u.pm * BM, mu, rstd);
                f32x4 y[2][2];
#pragma unroll
                for (int bj = 0; bj < 2; ++bj) {
#pragma unroll
                    for (int n = 0; n < 2; ++n) { const f32x4 z = (acc[ai][bj][m][n] - mu * gv[bj][n]) * rstd + bv[bj][n];
                        const f32x2 a = gelu_pk((f32x2){z[0], z[1]}), b = gelu_pk((f32x2){z[2], z[3]}); y[bj][n] = (f32x4){a.x, a.y, b.x, b.y}; }
                    u32x4 w; w.x = cvt_pk_bf16(y[bj][0][0], y[bj][0][1]); w.y = cvt_pk_bf16(y[bj][0][2], y[bj][0][3]); w.z = cvt_pk_bf16(y[bj][1][0], y[bj][1][1]); w.w = cvt_pk_bf16(y[bj][1][2], y[bj][1][3]);
                    *(u32x4*)(rowp + bj * HALF) = w; }
                if (isv) {
                    float s = 0.f;
#pragma unroll
                    for (int bj = 0; bj < 2; ++bj)
#pragma unroll
                        for (int n = 0; n < 2; ++n) s += (y[bj][n][0] + y[bj][n][1]) + (y[bj][n][2] + y[bj][n][3]);
                    s += __shfl_xor(s, 16); s += __shfl_xor(s, 32);
                    const float mw = s * (1.0f / 64.0f); float q = 0.f;
#pragma unroll
                    for (int bj = 0; bj < 2; ++bj)
#pragma unroll
                        for (int n = 0; n < 2; ++n) { const f32x4 d = y[bj][n] - mw; q += (d[0] * d[0] + d[1] * d[1]) + (d[2] * d[2] + d[3] * d[3]); }
                    q += __shfl_xor(q, 16); q += __shfl_xor(q, 32);
                    if (fq == 0) *(f32x2*)(vstat + ((size_t)row * 32 + (u.pn - 8) * 4 + wc) * 2) = (f32x2){mw, q};
                }
                asm volatile("" ::: "memory"); }
    }
};
__device__ __forceinline__ float silu_e(float x) { return x * __builtin_amdgcn_rcpf(1.0f + __expf(-x)); }
struct EpiSwiglu {
    static constexpr bool PERM = true, AFTER_DRAIN = false;
    bf16_t* H; const float* stat; const float* gW; const float* bW;
    __device__ __forceinline__ void operator()(const f32x4 (&acc)[2][2][4][2], const Unit& u, int wr, int wc, int fr, int fq, PG8_LAS unsigned char* lds, bool tab_valid) const {
        const int row0 = u.pm * BM + wr * 64 + fr, col0 = u.pn * BM + wc * 32 + 8 * fq, hcol0 = u.pn * HALF + wc * 32 + 8 * fq;
        f32x4 gv[2][2], bv[2][2];
#pragma unroll
        for (int bj = 0; bj < 2; ++bj)
#pragma unroll
            for (int n = 0; n < 2; ++n) { gv[bj][n] = *(const f32x4*)(gW + col0 + bj * HALF + 4 * n); bv[bj][n] = *(const f32x4*)(bW + col0 + bj * HALF + 4 * n); }
        if (!tab_valid) stat_tab_build(lds, stat, u.pm, wr, wc, fr + 16 * fq);
#pragma unroll
        for (int rg = 0; rg < 8; ++rg) { const int ai = rg >> 2, m = rg & 3; const int row = RG_ROW(rg);
                float mu, rstd; stat_tab_get(lds, row - u.pm * BM, mu, rstd);
                f32x4 h[2];
#pragma unroll
                for (int n = 0; n < 2; ++n) { const f32x4 g = (acc[ai][0][m][n] - mu * gv[0][n]) * rstd + bv[0][n], up = (acc[ai][1][m][n] - mu * gv[1][n]) * rstd + bv[1][n];
#pragma unroll
                    for (int j = 0; j < 4; ++j) h[n][j] = silu_e(g[j]) * up[j]; }
                u32x4 w; w.x = cvt_pk_bf16(h[0][0], h[0][1]); w.y = cvt_pk_bf16(h[0][2], h[0][3]); w.z = cvt_pk_bf16(h[1][0], h[1][1]); w.w = cvt_pk_bf16(h[1][2], h[1][3]);
                *(u32x4*)(H + (size_t)row * 2816 + hcol0) = w;
                asm volatile("" ::: "memory"); }
    }
};
__device__ __forceinline__ f32x4 f16x4_to_f32(const u32x2 w) { const unsigned wx = w.x, wy = w.y;
    const f16x2 a = __builtin_bit_cast(f16x2, wx), b = __builtin_bit_cast(f16x2, wy); return (f32x4){(float)a.x, (float)a.y, (float)b.x, (float)b.y}; }
__device__ __forceinline__ unsigned cvt_pk_f16(float lo, float hi) { f16x2 t; t.x = (_Float16)lo; t.y = (_Float16)hi; return __builtin_bit_cast(unsigned, t); }
template <bool F32IN>
struct EpiResid {
    static constexpr bool PERM = true, AFTER_DRAIN = false;
    const float* Xa; const float* Xb; float* out; bf16_t* xb; float* statOut; const float* stat; const float* lg; const float* lb; float alpha;
    __device__ __forceinline__ void operator()(const f32x4 (&acc)[2][2][4][2], const Unit& u, int wr, int wc, int fr, int fq, PG8_LAS unsigned char* lds, bool tab_valid) const {
        const int row0 = u.pm * BM + wr * 64 + fr, col0 = u.pn * BM + wc * 32 + 8 * fq;
        f32x4 gv[2][2], bv[2][2];
        if constexpr (!F32IN) {
#pragma unroll
            for (int bj = 0; bj < 2; ++bj)
#pragma unroll
                for (int n = 0; n < 2; ++n) { gv[bj][n] = *(const f32x4*)(lg + col0 + bj * HALF + 4 * n); bv[bj][n] = *(const f32x4*)(lb + col0 + bj * HALF + 4 * n); }
        }
        const bf16_t* qbase = xb + (size_t)row0 * 1024 + col0;
        u32x4 xq[2][2];
#pragma unroll
        for (int bj = 0; bj < 2; ++bj) xq[0][bj] = *(const u32x4*)(qbase + bj * HALF);
        if constexpr (!F32IN) { if (!tab_valid) stat_tab_build(lds, stat, u.pm, wr, wc, fr + 16 * fq); }
#pragma unroll
        for (int rg = 0; rg < 8; ++rg) { const int ai = rg >> 2, m = rg & 3; const int row = RG_ROW(rg);
                if (rg < 7) { const size_t ro = (size_t)((((rg + 1) >> 2) * HALF + ((rg + 1) & 3) * 16)) * 1024;
#pragma unroll
                    for (int bj = 0; bj < 2; ++bj) xq[(rg + 1) & 1][bj] = *(const u32x4*)(qbase + ro + bj * HALF); }
                float mu = 0.f, rstd = 1.f; if constexpr (!F32IN) stat_tab_get(lds, row - u.pm * BM, mu, rstd);
                f32x4 y[2][2]; float s = 0.f;
#pragma unroll
                for (int bj = 0; bj < 2; ++bj)
#pragma unroll
                    for (int n = 0; n < 2; ++n) { f32x4 xin;
                        { const u32x4 w4 = xq[rg & 1][bj]; u32x2 w2; w2.x = n ? w4.z : w4.x; w2.y = n ? w4.w : w4.y; xin = f16x4_to_f32(w2); if constexpr (!F32IN) xin = (xin - mu) * rstd * gv[bj][n] + bv[bj][n]; }
                        y[bj][n] = alpha * xin + acc[ai][bj][m][n]; s += (y[bj][n][0] + y[bj][n][1]) + (y[bj][n][2] + y[bj][n][3]); }
                s += __shfl_xor(s, 16); s += __shfl_xor(s, 32);
                const float mw = s * (1.0f / 64.0f); float q = 0.f;
#pragma unroll
                for (int bj = 0; bj < 2; ++bj) {
#pragma unroll
                    for (int n = 0; n < 2; ++n) { const f32x4 d = y[bj][n] - mw; q += (d[0] * d[0] + d[1] * d[1]) + (d[2] * d[2] + d[3] * d[3]);
                        if (out) *(f32x4*)(out + (size_t)row * 1024 + col0 + bj * HALF + 4 * n) = y[bj][n]; }
                    u32x4 w; w.x = cvt_pk_f16(y[bj][0][0], y[bj][0][1]); w.y = cvt_pk_f16(y[bj][0][2], y[bj][0][3]); w.z = cvt_pk_f16(y[bj][1][0], y[bj][1][1]); w.w = cvt_pk_f16(y[bj][1][2], y[bj][1][3]);
                    *(u32x4*)(xb + (size_t)row * 1024 + col0 + bj * HALF) = w; }
                q += __shfl_xor(q, 16); q += __shfl_xor(q, 32);
                if (fq == 0) *(f32x2*)(statOut + ((size_t)row * 16 + u.pn * 4 + wc) * 2) = (f32x2){mw, q};
                asm volatile("" ::: "memory"); }
    }
};

template <class Epi, class Sched, bool ALIGN_EPI = false, bool SP2 = false, bool F16 = false>
__device__ __forceinline__ void gemm_phase(PG8_LAS unsigned char* lds, const Gemm g, const Sched& S, const Epi& E, int wave_s) {
    int tid_ = tid_from_wave(wave_s); asm volatile("" : "+v"(tid_));
    const int tid = tid_, wid = __builtin_amdgcn_readfirstlane(tid >> 6), lane = tid & 63, wr = wid >> 2, wc = wid & 3, fr = lane & 15, fq = lane >> 4;
    const int K = g.K, nt = K / BK;
    unsigned voffA[2], voffB[2];
#pragma unroll
    for (int i = 0; i < 2; ++i) { int R, C; stage_rc(tid * 16 + i * 8192, R, C); const int Rb = Epi::PERM ? ((R & ~31) + perm32(R & 31)) : R;
        voffA[i] = (unsigned)(R * K + C) * 2u; voffB[i] = (unsigned)(Rb * K + C) * 2u; }
    const size_t kstep = (size_t)(BK * 2);
    const size_t hstep = (size_t)HALF * K * 2;
    const size_t tstep = 2 * hstep;
    const unsigned ldsw = (unsigned)wid * 1024u;
    const int aoff = lds_byte(wr * 64 + fr, fq * 8), boff = lds_byte(wc * 32 + fr, fq * 8);
#define PG8_SA(b, h) (((b) * 2 + (h)) * HTB)
#define PG8_SB(b, h) ((4 + (b) * 2 + (h)) * HTB)
#define PG8_STAGE(bufoff, gbase, voff) do { _Pragma("unroll") for (int _i = 0; _i < 2; ++_i) \
        __builtin_amdgcn_global_load_lds((const unsigned*)((const char*)(gbase) + (voff)[_i]), (PG8_LAS unsigned*)(lds + (bufoff) + ldsw + _i * 8192), 16, 0, 0); } while (0)
#define PG8_LDA(dst, b, h) do { _Pragma("unroll") for (int m = 0; m < 4; ++m) _Pragma("unroll") for (int k = 0; k < 2; ++k) dst[m][k] = *(const PG8_LAS bf16x8*)(lds + PG8_SA(b, h) + aoff + m * 2048 + k * 1024); } while (0)
#define PG8_LDB(dst, b, h) do { _Pragma("unroll") for (int n = 0; n < 2; ++n) _Pragma("unroll") for (int k = 0; k < 2; ++k) dst[n][k] = *(const PG8_LAS bf16x8*)(lds + PG8_SB(b, h) + boff + n * 2048 + k * 1024); } while (0)
#define PG8_MMA(ai, bj, At, Bt) do { __builtin_amdgcn_s_setprio(1); _Pragma("unroll") for (int m = 0; m < 4; ++m) _Pragma("unroll") for (int n = 0; n < 2; ++n) _Pragma("unroll") for (int k = 0; k < 2; ++k) \
        { if constexpr (F16) acc[ai][bj][m][n] = __builtin_amdgcn_mfma_f32_16x16x32_f16(__builtin_bit_cast(f16x8, Bt[n][k]), __builtin_bit_cast(f16x8, At[m][k]), acc[ai][bj][m][n], 0, 0, 0); \
          else acc[ai][bj][m][n] = __builtin_amdgcn_mfma_f32_16x16x32_bf16(Bt[n][k], At[m][k], acc[ai][bj][m][n], 0, 0, 0); } __builtin_amdgcn_s_setprio(0); } while (0)
#define PG8_WAIT_V(n) asm volatile("s_waitcnt vmcnt(" #n ")" ::: "memory")
#define PG8_WAIT_L(n) asm volatile("s_waitcnt lgkmcnt(" #n ")" ::: "memory")
#define PG8_BAR __builtin_amdgcn_s_barrier()
#define PG8_SCHED __builtin_amdgcn_sched_barrier(0)
    Unit cur, nxt; int ui = 0, tab_pm = -1;
    if (!S.next(0, cur)) return;
    f32x4 acc[2][2][4][2];
#pragma unroll
    for (int a = 0; a < 2; ++a)
#pragma unroll
        for (int b = 0; b < 2; ++b)
#pragma unroll
            for (int m = 0; m < 4; ++m)
#pragma unroll
                for (int n = 0; n < 2; ++n) acc[a][b][m][n] = (f32x4){0.f, 0.f, 0.f, 0.f};
    bf16x8 At[4][2], B0[2][2], B1[2][2];
    const char* cA = (const char*)g.A + (size_t)cur.pm * tstep; const char* cB = (const char*)g.Bt + (size_t)cur.pn * tstep;
    S.a_ready(cur);
    if constexpr (SP2) {
        PG8_STAGE(PG8_SB(0, 0), cB, voffB); PG8_STAGE(PG8_SB(0, 1), cB + hstep, voffB); PG8_STAGE(PG8_SA(0, 0), cA, voffA); PG8_STAGE(PG8_SA(0, 1), cA + hstep, voffA);
        if (wr == 1) PG8_BAR;
        PG8_WAIT_V(2); PG8_BAR;
        PG8_STAGE(PG8_SB(1, 0), cB + kstep, voffB); PG8_STAGE(PG8_SA(1, 0), cA + kstep, voffA); PG8_STAGE(PG8_SB(1, 1), cB + hstep + kstep, voffB);
        PG8_WAIT_V(6); PG8_BAR;
    } else {
        PG8_STAGE(PG8_SB(0, 0), cB, voffB); PG8_STAGE(PG8_SA(0, 0), cA, voffA); PG8_STAGE(PG8_SB(0, 1), cB + hstep, voffB); PG8_STAGE(PG8_SA(0, 1), cA + hstep, voffA);
        if (wr == 1) PG8_BAR;
        PG8_WAIT_V(4); PG8_BAR;
        PG8_STAGE(PG8_SB(1, 0), cB + kstep, voffB); PG8_STAGE(PG8_SA(1, 0), cA + kstep, voffA); PG8_STAGE(PG8_SB(1, 1), cB + hstep + kstep, voffB);
        PG8_WAIT_V(6); PG8_BAR;
    }
    for (;;) {
        const bool has_next = S.next(ui + 1, nxt);
        const char* nA = has_next ? (const char*)g.A + (size_t)nxt.pm * tstep : cA; const char* nB = has_next ? (const char*)g.Bt + (size_t)nxt.pn * tstep : cB;
        for (int t = 0; t < nt; t += 2) {
            const bool last = (t == nt - 2);
            const char* a1 = cA + (size_t)(t + 1) * kstep;
            const char* a2 = last ? nA : cA + (size_t)(t + 2) * kstep; const char* b2 = last ? nB : cB + (size_t)(t + 2) * kstep;
            const char* a3 = a2 + kstep; const char* b3 = b2 + kstep;
            if (last && has_next) S.a_ready(nxt);
            if constexpr (SP2) {
            PG8_LDB(B0, 0, 0); PG8_LDB(B1, 0, 1); PG8_SCHED; PG8_LDA(At, 0, 0); PG8_STAGE(PG8_SA(1, 1), a1 + hstep, voffA);
            PG8_WAIT_V(8); PG8_WAIT_L(0); PG8_BAR; PG8_MMA(0, 0, At, B0); PG8_MMA(0, 1, At, B1); PG8_BAR; PG8_SCHED;
            PG8_LDA(At, 0, 1); PG8_STAGE(PG8_SB(0, 0), b2, voffB); PG8_STAGE(PG8_SB(0, 1), b2 + hstep, voffB); PG8_STAGE(PG8_SA(0, 0), a2, voffA);
            PG8_WAIT_V(8); PG8_WAIT_L(0); PG8_BAR; PG8_MMA(1, 0, At, B0); PG8_MMA(1, 1, At, B1); PG8_BAR; PG8_SCHED;
            PG8_LDB(B0, 1, 0); PG8_LDB(B1, 1, 1); PG8_SCHED; PG8_LDA(At, 1, 0); PG8_STAGE(PG8_SA(0, 1), a2 + hstep, voffA);
            PG8_WAIT_V(8); PG8_WAIT_L(0); PG8_BAR; PG8_MMA(0, 0, At, B0); PG8_MMA(0, 1, At, B1); PG8_BAR; PG8_SCHED;
            PG8_LDA(At, 1, 1); PG8_STAGE(PG8_SB(1, 0), b3, voffB); PG8_STAGE(PG8_SB(1, 1), b3 + hstep, voffB); PG8_STAGE(PG8_SA(1, 0), a3, voffA);
            PG8_WAIT_V(8); PG8_WAIT_L(0); PG8_BAR; PG8_MMA(1, 0, At, B0); PG8_MMA(1, 1, At, B1); PG8_BAR; PG8_SCHED;
            } else {
            PG8_LDB(B0, 0, 0); PG8_SCHED; PG8_LDA(At, 0, 0); PG8_STAGE(PG8_SA(1, 1), a1 + hstep, voffA);
            PG8_WAIT_L(8); PG8_BAR; PG8_WAIT_L(0); PG8_MMA(0, 0, At, B0); PG8_BAR; PG8_SCHED;
            PG8_LDB(B1, 0, 1); PG8_STAGE(PG8_SB(0, 0), b2, voffB);
            PG8_BAR; PG8_WAIT_L(0); PG8_MMA(0, 1, At, B1); PG8_BAR;
            PG8_LDA(At, 0, 1); PG8_STAGE(PG8_SA(0, 0), a2, voffA);
            PG8_BAR; PG8_WAIT_L(0); PG8_MMA(1, 0, At, B0); PG8_BAR; PG8_SCHED;
            PG8_STAGE(PG8_SB(0, 1), b2 + hstep, voffB);
            PG8_WAIT_V(6); PG8_BAR; PG8_MMA(1, 1, At, B1); PG8_BAR;
            PG8_LDB(B0, 1, 0); PG8_SCHED; PG8_LDA(At, 1, 0); PG8_STAGE(PG8_SA(0, 1), a2 + hstep, voffA);
            PG8_WAIT_L(8); PG8_BAR; PG8_WAIT_L(0); PG8_MMA(0, 0, At, B0); PG8_BAR; PG8_SCHED;
            PG8_LDB(B1, 1, 1); PG8_STAGE(PG8_SB(1, 0), b3, voffB);
            PG8_BAR; PG8_WAIT_L(0); PG8_MMA(0, 1, At, B1); PG8_BAR;
            PG8_LDA(At, 1, 1); PG8_STAGE(PG8_SA(1, 0), a3, voffA);
            PG8_BAR; PG8_WAIT_L(0); PG8_MMA(1, 0, At, B0); PG8_BAR; PG8_SCHED;
            PG8_STAGE(PG8_SB(1, 1), b3 + hstep, voffB);
            PG8_WAIT_V(6); PG8_BAR; PG8_MMA(1, 1, At, B1); PG8_BAR;
            }
        }
        if constexpr (ALIGN_EPI) { if (wr == 0) PG8_BAR; }
        if constexpr (!Epi::AFTER_DRAIN) { E(acc, cur, wr, wc, fr, fq, lds, cur.pm == tab_pm); tab_pm = cur.pm; S.done(cur); }
        if (!has_next) break;
#pragma unroll
        for (int a = 0; a < 2; ++a)
#pragma unroll
            for (int b = 0; b < 2; ++b)
#pragma unroll
                for (int m = 0; m < 4; ++m)
#pragma unroll
                    for (int n = 0; n < 2; ++n) acc[a][b][m][n] = (f32x4){0.f, 0.f, 0.f, 0.f};
        cur = nxt; cA = nA; cB = nB; ++ui;
        if constexpr (ALIGN_EPI) { if (wr == 1) PG8_BAR; }
    }
    PG8_WAIT_V(0);
    if constexpr (!ALIGN_EPI) { if (wr == 0) PG8_BAR; }
    PG8_BAR;
#undef PG8_SA
#undef PG8_SB
#undef PG8_STAGE
#undef PG8_LDA
#undef PG8_LDB
#undef PG8_MMA
#undef PG8_WAIT_V
#undef PG8_WAIT_L
#undef PG8_BAR
#undef PG8_SCHED
}
}

__device__ __forceinline__ float silu_f(float x) { return x * __builtin_amdgcn_rcpf(1.0f + __expf(-x)); }
constexpr int NWAVES = 8, NTHR = 512;
constexpr int D = 1024, MP = 65536, MS = 16384, M = MP + MS;
constexpr int AW = 512, NZ = 3328, FF = 2816, CW = 2048;
constexpr int ZQ = 0, ZFF = 512, ZFB = 1024, ZI = 1536, ZG = 2048, ZQB = 2560, ZKB = 3072, ZVB = 3200;
constexpr float ALPHA = 1.681792830507429f, RMS_EPS = 1e-6f;
__device__ __forceinline__ int seq_start(int t) { return t < MP ? (t & ~2047) : MP; }
__device__ __forceinline__ int seq_end(int t) { return t < MP ? (t & ~2047) + 2048 : M; }

constexpr size_t MiB = 1u << 20;
constexpr size_t WS_CTL = 0, CTL_ZERO_BYTES = 64 * 1024;
constexpr size_t WS_SMALL = 1 * MiB;
constexpr size_t SM_LB = 0;
constexpr size_t SM_GW_AB1 = 4096, SM_BW_AB1 = SM_GW_AB1 + 3328;
constexpr size_t SM_GW_C = SM_BW_AB1 + 3328;
constexpr size_t SM_BW_C = SM_GW_C + 2 * 4096;
constexpr size_t SM_GW_GU = SM_BW_C + 2 * 4096;
constexpr size_t SM_BW_GU = SM_GW_GU + 4 * 5632;
constexpr size_t SM_RSW = SM_BW_GU + 4 * 5632;
constexpr size_t SM_TDEC = SM_RSW + 2048;
constexpr size_t SM_END = SM_TDEC + 1280 * 128;
constexpr int FOLD_N = (int)(SM_RSW - SM_GW_AB1);
constexpr size_t WS_PF = 3 * MiB + 512 * 1024;
static_assert(WS_PF + 16ull * FOLD_N * 4 <= 8 * MiB, "fold partials");
static_assert(SM_END * 4 <= 2 * MiB, "small region");
constexpr size_t WS_WSB = 3 * MiB;
constexpr size_t WS_STATMIX = 8 * MiB, WS_STATFFN = 18 * MiB, WS_VSTAT = 28 * MiB;
constexpr size_t WS_W = 48 * MiB;
constexpr size_t W_INAB = 0, W_OUTAB = W_INAB + 2ull * NZ * D, W_INC = W_OUTAB + 2ull * D * D, W_OUTC = W_INC + 2ull * 4096 * D, W_GU = W_OUTC + 2ull * D * CW, W_DN = W_GU + 4ull * 2 * FF * D, W_END = W_DN + 4ull * D * FF;
static_assert(W_END * 2 <= 108 * MiB, "weights");
constexpr size_t WS_XB = 156 * MiB;
constexpr size_t WS_Z = 316 * MiB;
constexpr size_t WS_R1 = 836 * MiB;
constexpr size_t WS_OB = WS_R1, WS_QT = WS_R1 + 160 * MiB;
constexpr size_t WS_F = 1156 * MiB, WS_SIN = 1236 * MiB, WS_END = 1276 * MiB;

constexpr int LDS_BYTES = 163840;
constexpr int MISC_OFF = 163840 - 256;

#define GAS __attribute__((address_space(1)))
#define LAS __attribute__((address_space(3)))
typedef unsigned short bf16;
typedef unsigned v4u __attribute__((ext_vector_type(4)));
typedef unsigned v2u __attribute__((ext_vector_type(2)));
typedef float f32x4 __attribute__((ext_vector_type(4)));
typedef short bf16x8 __attribute__((ext_vector_type(8)));
typedef GAS unsigned gu32;
#define RLX_AGENT __ATOMIC_RELAXED, __HIP_MEMORY_SCOPE_AGENT
#define LDS_WAIT() asm volatile("s_waitcnt lgkmcnt(0)" ::: "memory")
#define LDS_SYNC() do { asm volatile("s_waitcnt lgkmcnt(0)" ::: "memory"); __builtin_amdgcn_s_barrier(); asm volatile("" ::: "memory"); } while (0)
#define VM_WAIT() asm volatile("s_waitcnt vmcnt(0)" ::: "memory")
__device__ __forceinline__ unsigned f2bf(float f) { unsigned u = __builtin_bit_cast(unsigned, f); return (u + 0x7fffu + ((u >> 16) & 1u)) >> 16; }
__device__ __forceinline__ unsigned pk2(float lo, float hi) { return f2bf(lo) | (f2bf(hi) << 16); }
__device__ __forceinline__ unsigned pk2h(float lo, float hi) { pg8::f16x2 t; t.x = (_Float16)lo; t.y = (_Float16)hi; return __builtin_bit_cast(unsigned, t); }
__device__ __forceinline__ float bf2f(unsigned short b) { return __builtin_bit_cast(float, (unsigned)b << 16); }
__device__ __forceinline__ float bflo(unsigned w) { return __builtin_bit_cast(float, w << 16); }
__device__ __forceinline__ float bfhi(unsigned w) { return __builtin_bit_cast(float, w & 0xffff0000u); }

#define XB_TMO      128
#define XB_XCNT(j)  (256  + 64 * (j))
#define XB_XSUB(j)  (1280 + 64 * (j))
#define XB_XGEN(j)  (2304 + 64 * (j))
#define XB_TOP      3328
#define XB_TOPGEN   3392
#define XCD_BAR_WORDS 3456
#define XB_SPIN_CAP (1u << 22)
__device__ __forceinline__ unsigned xb_ld(unsigned* p)              { return __hip_atomic_load(p, __ATOMIC_RELAXED, __HIP_MEMORY_SCOPE_AGENT); }
__device__ __forceinline__ unsigned xb_add(unsigned* p, unsigned v) { return __hip_atomic_fetch_add(p, v, __ATOMIC_RELAXED, __HIP_MEMORY_SCOPE_AGENT); }
__device__ __forceinline__ unsigned xb_xcc_id() { return (unsigned)__builtin_amdgcn_s_getreg((3 << 11) | 20) & 0xFu; }
#define XB_SPIN(cond, bar) do { unsigned _sp = 0; while (cond) { __builtin_amdgcn_s_sleep(1); \
    if ((++_sp & 255u) == 0u) { if (xb_ld(&(bar)[XB_TMO])) break; if (_sp > XB_SPIN_CAP) { atomicAdd(&(bar)[XB_TMO], 1u); break; } } } } while (0)
struct XcdBarrier { unsigned* bar; unsigned x; volatile LAS unsigned* st; };
__device__ __forceinline__ XcdBarrier xcd_barrier_post(unsigned* bar, volatile LAS unsigned* st, bool is_t0) {
    XcdBarrier b; b.bar = bar; b.x = xb_xcc_id(); b.st = st;
    if (is_t0) (void)xb_add(&bar[XB_XCNT(b.x)], 1u);
    return b;
}
__device__ __forceinline__ void xcd_barrier_complete(unsigned* bar, unsigned x, unsigned& nloc, unsigned& nx) {
    const unsigned G = gridDim.x * gridDim.y * gridDim.z;
    unsigned sum, cnt, mine, sp = 0u;
    for (;;) {
        sum = 0u; cnt = 0u; mine = 0u;
#pragma unroll
        for (unsigned j = 0; j < 16; ++j) { const unsigned c = xb_ld(&bar[XB_XCNT(j)]); sum += c; cnt += (c > 0u) ? 1u : 0u; mine = (j == x) ? c : mine; }
        if (sum == G) break;
        __builtin_amdgcn_s_sleep(1);
        if ((++sp & 255u) == 0u) { if (xb_ld(&bar[XB_TMO])) break; if (sp > XB_SPIN_CAP) { atomicAdd(&bar[XB_TMO], 1u); break; } }
    }
    nloc = mine > 0u ? mine : 1u; nx = cnt > 0u ? cnt : 1u;
}
__device__ __forceinline__ void xcd_barrier(const XcdBarrier& b, bool is_t0) {
    asm volatile("s_waitcnt vmcnt(0)" ::: "memory");
    __syncthreads();
    if (is_t0) {
        unsigned* bar = b.bar;
        __builtin_amdgcn_s_waitcnt(0);
        unsigned nloc = b.st[0], nx = b.st[1];
        if (nloc == 0u) { xcd_barrier_complete(bar, b.x, nloc, nx); b.st[0] = nloc; b.st[1] = nx; }
        const unsigned old = xb_add(&bar[XB_XSUB(b.x)], 1u);
        const unsigned gen = old / nloc;
        if (old + 1u == (gen + 1u) * nloc) {
            __builtin_amdgcn_fence(__ATOMIC_RELEASE, "agent");
            asm volatile("s_waitcnt vmcnt(0)" ::: "memory");
            const unsigned og = xb_add(&bar[XB_TOP], 1u);
            const unsigned tg = og / nx;
            if (og + 1u == (tg + 1u) * nx) xb_add(&bar[XB_TOPGEN], 1u);
            else XB_SPIN(xb_ld(&bar[XB_TOPGEN]) == tg, bar);
            __builtin_amdgcn_fence(__ATOMIC_ACQUIRE, "agent");
            xb_add(&bar[XB_XGEN(b.x)], 1u);
            asm volatile("s_waitcnt vmcnt(0)" ::: "memory");
        } else {
            XB_SPIN(xb_ld(&bar[XB_XGEN(b.x)]) == gen, bar);
            __builtin_amdgcn_fence(__ATOMIC_ACQUIRE, "agent");
            asm volatile("s_waitcnt vmcnt(0)" ::: "memory");
        }
    }
    __syncthreads();
}

struct Args {
    const float* x_prompt; const float* x_sample; const float* w_in_ab; const float* lb_logits; const float* hgrn_norm_g; const float* attn_sink; const float* w_out_ab;
    const float* w_in_c; const float* c_ln_g; const float* c_ln_b; const float* c_ws; const float* c_bs; const float* w_out_c;
    const float* w_gate; const float* w_up; const float* w_down; const float* ln_mix_g; const float* ln_mix_b; const float* ln_ffn_g; const float* ln_ffn_b;
    float* out; unsigned char* ws;
};

__device__ __forceinline__ float wave_sum(float v) {
#pragma unroll
    for (int o = 1; o < 64; o <<= 1) v += __shfl_xor(v, o);
    return v;
}

__device__ __forceinline__ int rowmap(int n, int mode) { return mode == 0 ? n : (256 * (n >> 7) + (n & 127) + (mode == 2 ? 128 : 0)); }
__device__ __forceinline__ void p0_transpose_item(const float* W, int K, int N, bf16* WT, int mode, const float* scale, LAS float* scr, int item, int lane, bool f16 = false, const float* bvec = nullptr, float* pg = nullptr, float* pb = nullptr) {
    const int nblk = N / 64, kb = item / nblk, nb = item % nblk, k0 = 64 * kb, n0 = 64 * nb;
    float sg = 0.f, sb = 0.f;
    const float scv = scale ? scale[k0 + lane] : 1.0f, bvv = bvec ? bvec[k0 + lane] : 0.0f;
    float wv[64];
#pragma unroll
    for (int kk = 0; kk < 64; ++kk) wv[kk] = W[(size_t)(k0 + kk) * N + n0 + lane];
    __builtin_amdgcn_sched_barrier(0);
#pragma unroll
    for (int kk = 0; kk < 64; ++kk) { const float sc = __builtin_bit_cast(float, __builtin_amdgcn_readlane(__builtin_bit_cast(int, scv), kk)); const float w = wv[kk]; scr[kk * 65 + lane] = w * sc;
        if (pg) { sg += w * sc; sb += w * __builtin_bit_cast(float, __builtin_amdgcn_readlane(__builtin_bit_cast(int, bvv), kk)); } }
    if (pg) { const size_t o = (size_t)kb * FOLD_N + rowmap(n0 + lane, mode); pg[o] = sg; pb[o] = sb; }
    LDS_WAIT(); asm volatile("" ::: "memory");
    const int c = lane & 7;
#pragma unroll
    for (int j = 0; j < 8; ++j) { const int n = (lane >> 3) + 8 * j; const LAS float* s = scr + (8 * c) * 65 + n;
        v4u o; if (f16) { o.x = pk2h(s[0 * 65], s[1 * 65]); o.y = pk2h(s[2 * 65], s[3 * 65]); o.z = pk2h(s[4 * 65], s[5 * 65]); o.w = pk2h(s[6 * 65], s[7 * 65]); }
        else { o.x = pk2(s[0 * 65], s[1 * 65]); o.y = pk2(s[2 * 65], s[3 * 65]); o.z = pk2(s[4 * 65], s[5 * 65]); o.w = pk2(s[6 * 65], s[7 * 65]); }
        *(GAS v4u*)(WT + (size_t)rowmap(n0 + n, mode) * K + k0 + 8 * c) = o; }
    LDS_WAIT(); asm volatile("" ::: "memory");
}
__device__ __forceinline__ void p0_fold_item(const float* W, int N, const float* g, const float* b, float* gW, float* bW, int mode, int item, int lane) {
    const int n = item * 64 + lane; float sg = 0.f, sb = 0.f;
#pragma unroll 32
    for (int k = 0; k < 1024; ++k) { const float w = W[(size_t)k * N + n]; sg += g[k] * w; sb += b[k] * w; }
    gW[rowmap(n, mode)] = sg; bW[rowmap(n, mode)] = sb;
}

__device__ __forceinline__ void naive_hgrn_unit(const Args& a, int unit, int j, LAS unsigned char* lds, int wave_s) {
    const bf16* Z = (const bf16*)(a.ws + WS_Z); bf16* OP = (bf16*)a.out; const float* lbv = (const float*)(a.ws + WS_SMALL) + SM_LB + (size_t)j * 1024;
    int tid_ = tid_from_wave(wave_s); asm volatile("" : "+v"(tid_)); const int tid = tid_, grp = tid >> 7, e = tid & 127;
    int seq, h, dir;
    if (unit < 64) { const int ch = unit * 4 + grp; seq = ch >> 3; h = (ch >> 1) & 3; dir = ch & 1; } else { const int ch = (unit - 64) * 4 + grp; seq = 32; h = ch >> 1; dir = ch & 1; }
    const int t0 = seq < 32 ? seq * 2048 : MP, len = seq < 32 ? 2048 : MS;
    const float lb = lbv[dir * 512 + h * 128 + e], oml = 1.0f - lb;
    LAS float* sq = (LAS float*)lds + grp * (3 * 16 * 128); LAS float* sf = sq + 16 * 128; LAS float* sk = sf + 16 * 128;
    float S[128];
#pragma unroll
    for (int i = 0; i < 128; ++i) S[i] = 0.f;
    for (int tb = 0; tb < len; tb += 16) {
        float v[16];
#pragma unroll
        for (int i = 0; i < 16; ++i) { const int tok = dir == 0 ? t0 + tb + i : t0 + len - 1 - tb - i; const bf16* zr = Z + (size_t)tok * NZ + h * 128 + e;
            const float qr = bf2f(zr[ZQ]), fr = bf2f(zr[dir == 0 ? ZFF : ZFB]); v[i] = bf2f(zr[ZI]);
            const float sg = 1.0f / (1.0f + expf(-fr));
            sq[i * 128 + e] = qr / (1.0f + expf(-qr)); sf[i * 128 + e] = lb + oml * sg; sk[i * 128 + e] = oml * (1.0f - sg); }
        __syncthreads();
        for (int i = 0; i < 16; ++i) { const int tok = dir == 0 ? t0 + tb + i : t0 + len - 1 - tb - i; float o = 0.f; const float vi = v[0];
#pragma unroll
            for (int d4 = 0; d4 < 32; ++d4) { const f32x4 q4 = *(const LAS f32x4*)(sq + i * 128 + d4 * 4), f4 = *(const LAS f32x4*)(sf + i * 128 + d4 * 4), k4 = *(const LAS f32x4*)(sk + i * 128 + d4 * 4);
#pragma unroll
                for (int jj = 0; jj < 4; ++jj) { S[d4 * 4 + jj] = f4[jj] * S[d4 * 4 + jj] + k4[jj] * vi; o += q4[jj] * S[d4 * 4 + jj]; } }
            OP[((size_t)dir * M + tok) * 512 + h * 128 + e] = (bf16)f2bf(o);
#pragma unroll
            for (int s = 0; s < 15; ++s) v[s] = v[s + 1]; }
        __syncthreads();
    }
}
__device__ __forceinline__ void naive_hgrn_finish(const Args& a, int j, int vcu, int ngw, int wave_s) {
    int tid_ = tid_from_wave(wave_s); asm volatile("" : "+v"(tid_)); const int lane = tid_ & 63, gw = vcu * NWAVES + __builtin_amdgcn_readfirstlane(tid_ >> 6);
    const bf16* Z = (const bf16*)(a.ws + WS_Z); const bf16* OP = (const bf16*)a.out; bf16* OB = (bf16*)(a.ws + WS_OB); const float* ng = a.hgrn_norm_g + j * 128;
    for (int it = gw; it < M * 4; it += ngw) { const int tok = it >> 2, h = it & 3; const size_t o0 = (size_t)tok * 512 + h * 128 + 2 * lane;
        const unsigned w0 = *(const unsigned*)(OP + o0), w1 = *(const unsigned*)(OP + (size_t)M * 512 + o0);
        const float x0 = bflo(w0) + bflo(w1), x1 = bfhi(w0) + bfhi(w1);
        const float ss = wave_sum(x0 * x0 + x1 * x1); const float r = 1.0f / sqrtf(ss * (1.0f / 128.0f) + RMS_EPS);
        const unsigned gw2 = *(const unsigned*)(Z + (size_t)tok * NZ + ZG + h * 128 + 2 * lane); const float g0 = bflo(gw2), g1 = bfhi(gw2);
        const float y0 = x0 * r * ng[2 * lane] * (g0 / (1.0f + expf(-g0))), y1 = x1 * r * ng[2 * lane + 1] * (g1 / (1.0f + expf(-g1)));
        *(unsigned*)(OB + (size_t)tok * 1024 + h * 128 + 2 * lane) = pk2(y0, y1); }
}
__device__ __forceinline__ void naive_attn_unit(const Args& a, int unit, int j, int wave_s) {
    const bf16* Z = (const bf16*)(a.ws + WS_Z); bf16* OB = (bf16*)(a.ws + WS_OB);
    int tid_ = tid_from_wave(wave_s); asm volatile("" : "+v"(tid_)); const int tid = tid_, hq = tid & 7, t = unit * 64 + (tid >> 3), kvh = hq >> 2;
    const float slope = exp2f(-(float)(hq + 1)), sink = a.attn_sink[j * 8 + hq];
    float q[64], o[64];
    { const v4u* qp = (const v4u*)(Z + (size_t)t * NZ + ZQB + hq * 64);
#pragma unroll
      for (int i = 0; i < 8; ++i) { const v4u w = qp[i]; q[8 * i] = bflo(w.x); q[8 * i + 1] = bfhi(w.x); q[8 * i + 2] = bflo(w.y); q[8 * i + 3] = bfhi(w.y); q[8 * i + 4] = bflo(w.z); q[8 * i + 5] = bfhi(w.z); q[8 * i + 6] = bflo(w.w); q[8 * i + 7] = bfhi(w.w); } }
#pragma unroll
    for (int i = 0; i < 64; ++i) o[i] = 0.f;
    float mx = sink, l = 1.0f;
    const int s0 = seq_start(t), s1 = seq_end(t);
    for (int dlt = -128; dlt <= 128; ++dlt) { const int s = t + dlt; if (s < s0 || s >= s1) continue;
        const v4u* kp = (const v4u*)(Z + (size_t)s * NZ + ZKB + kvh * 64); float sc = 0.f;
#pragma unroll
        for (int i = 0; i < 8; ++i) { const v4u w = kp[i]; sc += q[8 * i] * bflo(w.x) + q[8 * i + 1] * bfhi(w.x) + q[8 * i + 2] * bflo(w.y) + q[8 * i + 3] * bfhi(w.y) + q[8 * i + 4] * bflo(w.z) + q[8 * i + 5] * bfhi(w.z) + q[8 * i + 6] * bflo(w.w) + q[8 * i + 7] * bfhi(w.w); }
        sc = sc * 0.125f - slope * fabsf((float)dlt);
        const float mn = fmaxf(mx, sc), cf = expf(mx - mn), p = expf(sc - mn); l = l * cf + p; mx = mn;
        const v4u* vp = (const v4u*)(Z + (size_t)s * NZ + ZVB + kvh * 64);
#pragma unroll
        for (int i = 0; i < 8; ++i) { const v4u w = vp[i]; o[8 * i] = o[8 * i] * cf + p * bflo(w.x); o[8 * i + 1] = o[8 * i + 1] * cf + p * bfhi(w.x); o[8 * i + 2] = o[8 * i + 2] * cf + p * bflo(w.y); o[8 * i + 3] = o[8 * i + 3] * cf + p * bfhi(w.y);
            o[8 * i + 4] = o[8 * i + 4] * cf + p * bflo(w.z); o[8 * i + 5] = o[8 * i + 5] * cf + p * bfhi(w.z); o[8 * i + 6] = o[8 * i + 6] * cf + p * bflo(w.w); o[8 * i + 7] = o[8 * i + 7] * cf + p * bfhi(w.w); } }
    const float inv = 1.0f / l; v4u* op = (v4u*)(OB + (size_t)t * 1024 + 512 + hq * 64);
#pragma unroll
    for (int i = 0; i < 8; ++i) { v4u w; w.x = pk2(o[8 * i] * inv, o[8 * i + 1] * inv); w.y = pk2(o[8 * i + 2] * inv, o[8 * i + 3] * inv); w.z = pk2(o[8 * i + 4] * inv, o[8 * i + 5] * inv); w.w = pk2(o[8 * i + 6] * inv, o[8 * i + 7] * inv); op[i] = w; }
}
__device__ __forceinline__ void vrow_mu_rstd(const float* vstat, int row, float& mu, float& rstd) {
    const f32x4* p = (const f32x4*)(vstat + (size_t)row * 64); float ms = 0.f; f32x4 v[16];
#pragma unroll
    for (int i = 0; i < 16; ++i) v[i] = p[i];
    __builtin_amdgcn_sched_barrier(0);
#pragma unroll
    for (int i = 0; i < 16; ++i) ms += v[i][0] + v[i][2];
    const float mean = ms * (1.0f / 32.0f); float q = 0.f;
#pragma unroll
    for (int i = 0; i < 16; ++i) { const float d0 = v[i][0] - mean, d1 = v[i][2] - mean; q += (v[i][1] + v[i][3]) + 64.0f * (d0 * d0 + d1 * d1); }
    mu = mean; rstd = 1.0f / sqrtf(q * (1.0f / 2048.0f) + pg8::LN_EPS);
}
__device__ __forceinline__ void naive_sgu_unit(const Args& a, int unit, int j, LAS unsigned char* lds, int wave_s) {
    int tid_ = tid_from_wave(wave_s); asm volatile("" : "+v"(tid_)); const int chunk = unit >> 3, g = unit & 7, tid = tid_, ch = tid & 255, half = tid >> 8;
    bf16* U = (bf16*)(a.ws + WS_Z); const bf16* V = (const bf16*)(a.ws + WS_R1); const float* vstat = (const float*)(a.ws + WS_VSTAT);
    LAS float* vn = (LAS float*)lds; LAS float* st = vn + 128 * 256;
    const int tok0 = chunk * 128;
    __syncthreads();
    if (tid < 128) { float mu, rstd; vrow_mu_rstd(vstat, tok0 + tid, mu, rstd); st[2 * tid] = mu; st[2 * tid + 1] = rstd; }
    __syncthreads();
    const float cg = a.c_ln_g[j * 2048 + g * 256 + ch], cb = a.c_ln_b[j * 2048 + g * 256 + ch];
    for (int s = half; s < 128; s += 2) vn[s * 256 + ch] = (bf2f(V[(size_t)(tok0 + s) * 2048 + g * 256 + ch]) - st[2 * s]) * st[2 * s + 1] * cg + cb;
    __syncthreads();
    const float* Wg = a.c_ws + ((size_t)(j * 8 + g) * 128) * 128;
    for (int t = half * 64; t < half * 64 + 64; ++t) { float acc = 0.f; const float* wr = Wg + (size_t)t * 128;
#pragma unroll 8
        for (int s = 0; s < 128; ++s) acc += wr[s] * vn[s * 256 + ch];
        acc += a.c_bs[(j * 8 + g) * 128 + t];
        bf16* up = U + (size_t)(tok0 + t) * 2048 + g * 256 + ch; *up = (bf16)f2bf(bf2f(*up) * acc); }
}


typedef float f32x16 __attribute__((ext_vector_type(16)));
__device__ __forceinline__ unsigned cvtpk(float lo, float hi) { return pg8::cvt_pk_bf16(lo, hi); }
__device__ __forceinline__ float max_xor32(float x) { const unsigned xi = __builtin_bit_cast(unsigned, x); const auto r = __builtin_amdgcn_permlane32_swap(xi, xi, false, false); const unsigned a = r[0], b = r[1]; return fmaxf(__builtin_bit_cast(float, a), __builtin_bit_cast(float, b)); }
__device__ __forceinline__ float sum_xor32(float x) { const unsigned xi = __builtin_bit_cast(unsigned, x); const auto r = __builtin_amdgcn_permlane32_swap(xi, xi, false, false); const unsigned a = r[0], b = r[1]; return __builtin_bit_cast(float, a) + __builtin_bit_cast(float, b); }
__device__ __forceinline__ v4u widen_pair(v2u a, v2u b) {
    const auto r0 = __builtin_amdgcn_permlane32_swap(a.x, b.x, false, false); const auto r1 = __builtin_amdgcn_permlane32_swap(a.y, b.y, false, false);
    const unsigned ax = r0[0], bx = r0[1], ay = r1[0], by = r1[1];
    return (v4u){ax, ay, bx, by};
}

__device__ __forceinline__ void sgu_unit(const Args& a, int unit, int j, LAS unsigned char* lds, int wave_s) {
    int tid_ = tid_from_wave(wave_s); asm volatile("" : "+v"(tid_)); const int tid = tid_, lane = tid & 63, wave = __builtin_amdgcn_readfirstlane(tid >> 6), l31 = lane & 31, h = lane >> 5;
    const int chunk = unit >> 3, g = unit & 7, tok0 = chunk * 128;
    bf16* U = (bf16*)(a.ws + WS_Z); const bf16* V = (const bf16*)(a.ws + WS_R1); const float* vstat = (const float*)(a.ws + WS_VSTAT);
    const bf16* Wsb = (const bf16*)(a.ws + WS_WSB) + (size_t)(j * 8 + g) * 128 * 128;
    const float* rsw = (const float*)(a.ws + WS_SMALL) + SM_RSW + (j * 8 + g) * 128; const float* bs = a.c_bs + (j * 8 + g) * 128;
    LAS float* st = (LAS float*)(lds + 65536);
    __syncthreads();
    if (tid < 128) { float mu, rstd; vrow_mu_rstd(vstat, tok0 + tid, mu, rstd); st[2 * tid] = mu; st[2 * tid + 1] = rstd; }
    __syncthreads();
#pragma unroll
    for (int it = 0; it < 8; ++it) { const int p = tid & 7, sl = (it >> 2) * 64 + (tid >> 3), c0 = (it & 3) * 64 + 8 * p;
        const v4u w = *(const v4u*)(V + (size_t)(tok0 + sl) * 2048 + g * 256 + c0); const float mu = st[2 * sl], rstd = st[2 * sl + 1];
        const unsigned ww[4] = {w.x, w.y, w.z, w.w};
#pragma unroll
        for (int i = 0; i < 8; ++i) { const int c = c0 + i; const float x = (i & 1) ? bfhi(ww[i >> 1]) : bflo(ww[i >> 1]);
            const unsigned short ob = (unsigned short)f2bf((x - mu) * rstd);
            *(LAS unsigned short*)(lds + c * 256 + ((((sl >> 3) ^ ((c ^ (c >> 3)) & 15))) << 4) + (sl & 7) * 2) = ob; } }
    __syncthreads();
    const int tt = wave & 3, cq = wave >> 2, t = 32 * tt + l31;
    bf16x8 bw[8];
#pragma unroll
    for (int kk = 0; kk < 8; ++kk) bw[kk] = *(const bf16x8*)(Wsb + (size_t)t * 128 + 16 * kk + 8 * h);
    f32x16 acc[4];
#pragma unroll
    for (int i = 0; i < 4; ++i) { acc[i] = (f32x16){0.f, 0.f, 0.f, 0.f, 0.f, 0.f, 0.f, 0.f, 0.f, 0.f, 0.f, 0.f, 0.f, 0.f, 0.f, 0.f};
        const int c = 32 * (4 * cq + i) + l31, sw = (c ^ (c >> 3)) & 15;
#pragma unroll
        for (int kk = 0; kk < 8; ++kk) { const bf16x8 af = *(const LAS bf16x8*)(lds + c * 256 + (((2 * kk + h) ^ sw) << 4));
            acc[i] = __builtin_amdgcn_mfma_f32_32x32x16_bf16(af, bw[kk], acc[i], 0, 0, 0); } }
    const float rswt = rsw[t], bst = bs[t];
    bf16* urow = U + (size_t)(tok0 + t) * 2048 + g * 256; const float* cgp = a.c_ln_g + j * 2048 + g * 256; const float* cbp = a.c_ln_b + j * 2048 + g * 256;
#pragma unroll
    for (int i = 0; i < 4; ++i)
#pragma unroll
        for (int qd = 0; qd < 4; ++qd) { const int c = 32 * (4 * cq + i) + 8 * qd + 4 * h;
            const v2u uw = *(const v2u*)(urow + c); const f32x4 cg4 = *(const f32x4*)(cgp + c), cb4 = *(const f32x4*)(cbp + c);
            const float o0 = bflo(uw.x) * (cg4[0] * acc[i][4 * qd + 0] + cb4[0] * rswt + bst), o1 = bfhi(uw.x) * (cg4[1] * acc[i][4 * qd + 1] + cb4[1] * rswt + bst);
            const float o2 = bflo(uw.y) * (cg4[2] * acc[i][4 * qd + 2] + cb4[2] * rswt + bst), o3 = bfhi(uw.y) * (cg4[3] * acc[i][4 * qd + 3] + cb4[3] * rswt + bst);
            v2u ow; ow.x = cvtpk(o0, o1); ow.y = cvtpk(o2, o3); *(v2u*)(urow + c) = ow; }
}

__device__ __forceinline__ void sgu_unit2(const Args& a, int unit, int j, LAS unsigned char* lds, int wave_s) {
    int tid_ = tid_from_wave(wave_s); asm volatile("" : "+v"(tid_)); const int tid = tid_, lane = tid & 63, wave = __builtin_amdgcn_readfirstlane(tid >> 6), l31 = lane & 31, h = lane >> 5;
    const int chunk = unit >> 1, g0 = (unit & 1) * 4, tok0 = chunk * 128;
    bf16* U = (bf16*)(a.ws + WS_Z); const bf16* V = (const bf16*)(a.ws + WS_R1); const float* vstat = (const float*)(a.ws + WS_VSTAT);
    LAS float* st = (LAS float*)(lds + 131072);
    __syncthreads();
    if (tid < 128) { float mu, rstd; vrow_mu_rstd(vstat, tok0 + tid, mu, rstd); st[2 * tid] = mu; st[2 * tid + 1] = rstd; }
    const int tt = wave & 3, cq = wave >> 2, t = 32 * tt + l31;
    v4u vreg[8];
#pragma unroll
    for (int it = 0; it < 8; ++it) { const int sl = (it >> 2) * 64 + (tid >> 3), c0 = (it & 3) * 64 + 8 * (tid & 7); vreg[it] = *(const v4u*)(V + (size_t)(tok0 + sl) * 2048 + g0 * 256 + c0); }
    __syncthreads();
    for (int k = 0; k < 4; ++k) {
        const int g = g0 + k; LAS unsigned char* buf = lds + (k & 1) * 65536;
        const float* cgp = a.c_ln_g + j * 2048 + g * 256; const float* cbp = a.c_ln_b + j * 2048 + g * 256;
        int tk = tid; asm volatile("" : "+v"(tk)); const int p = tk & 7;
#pragma unroll
        for (int it = 0; it < 8; ++it) { const int sl = (it >> 2) * 64 + (tk >> 3), c0 = (it & 3) * 64 + 8 * p; const float mu = st[2 * sl], rstd = st[2 * sl + 1];
            const f32x4 ga = *(const f32x4*)(cgp + c0), gb = *(const f32x4*)(cgp + c0 + 4); const float gg[8] = {ga[0], ga[1], ga[2], ga[3], gb[0], gb[1], gb[2], gb[3]};
            const unsigned ww[4] = {vreg[it].x, vreg[it].y, vreg[it].z, vreg[it].w};
#pragma unroll
            for (int i = 0; i < 8; ++i) { const int c = c0 + i; const float x = (i & 1) ? bfhi(ww[i >> 1]) : bflo(ww[i >> 1]);
                *(LAS unsigned short*)(buf + c * 256 + ((((sl >> 3) ^ ((c ^ (c >> 3)) & 15))) << 4) + (sl & 7) * 2) = (unsigned short)f2bf((x - mu) * rstd * gg[i]); } }
        __syncthreads();
        const bf16* Wsb = (const bf16*)(a.ws + WS_WSB) + (size_t)(j * 8 + g) * 128 * 128;
        bf16x8 bw[8];
#pragma unroll
        for (int kk = 0; kk < 8; ++kk) bw[kk] = *(const bf16x8*)(Wsb + (size_t)t * 128 + 16 * kk + 8 * h);
        f32x16 acc[4];
#pragma unroll
        for (int i = 0; i < 4; ++i) { acc[i] = (f32x16){0.f, 0.f, 0.f, 0.f, 0.f, 0.f, 0.f, 0.f, 0.f, 0.f, 0.f, 0.f, 0.f, 0.f, 0.f, 0.f};
            const int c = 32 * (4 * cq + i) + l31, sw = (c ^ (c >> 3)) & 15;
#pragma unroll
            for (int kk = 0; kk < 8; ++kk) { const bf16x8 af = *(const LAS bf16x8*)(buf + c * 256 + (((2 * kk + h) ^ sw) << 4));
                acc[i] = __builtin_amdgcn_mfma_f32_32x32x16_bf16(af, bw[kk], acc[i], 0, 0, 0); } }
        if (k < 3) {
#pragma unroll
            for (int it = 0; it < 8; ++it) { const int sl = (it >> 2) * 64 + (tk >> 3), c0 = (it & 3) * 64 + 8 * p; vreg[it] = *(const v4u*)(V + (size_t)(tok0 + sl) * 2048 + (g + 1) * 256 + c0); } }
        const float rswt = ((const float*)(a.ws + WS_SMALL))[SM_RSW + (j * 8 + g) * 128 + t], bst = a.c_bs[(j * 8 + g) * 128 + t];
        bf16* urow = U + (size_t)(tok0 + t) * 2048 + g * 256;
#pragma unroll
        for (int i = 0; i < 4; ++i)
#pragma unroll
            for (int qd = 0; qd < 4; ++qd) { const int c = 32 * (4 * cq + i) + 8 * qd + 4 * h;
                const v2u uw = *(const v2u*)(urow + c); const f32x4 cb4 = *(const f32x4*)(cbp + c);
                const float o0 = bflo(uw.x) * (acc[i][4 * qd + 0] + cb4[0] * rswt + bst), o1 = bfhi(uw.x) * (acc[i][4 * qd + 1] + cb4[1] * rswt + bst);
                const float o2 = bflo(uw.y) * (acc[i][4 * qd + 2] + cb4[2] * rswt + bst), o3 = bfhi(uw.y) * (acc[i][4 * qd + 3] + cb4[3] * rswt + bst);
                v2u ow; ow.x = cvtpk(o0, o1); ow.y = cvtpk(o2, o3); *(v2u*)(urow + c) = ow; }
    }
}

typedef short s16x4 __attribute__((ext_vector_type(4)));
__device__ __forceinline__ unsigned sgu_off_b(unsigned row, unsigned ch) { return 256u * row + 16u * (ch ^ (((row & 3) << 2) | ((row >> 2) & 3))); }
__device__ __forceinline__ s16x4 sgu_tr(const LAS unsigned char* p) { return __builtin_amdgcn_ds_read_tr16_b64_v4i16((LAS s16x4*)p); }
__device__ __forceinline__ void sgu_unit3(const Args& a, int unit, int j, LAS unsigned char* lds, int wave_s) {
    int tid_ = tid_from_wave(wave_s); asm volatile("" : "+v"(tid_)); const int tid = tid_, lane = tid & 63, wave = __builtin_amdgcn_readfirstlane(tid >> 6), l31 = lane & 31, h = lane >> 5;
    const int chunk = unit >> 1, g0 = (unit & 1) * 4, tok0 = chunk * 128;
    bf16* U = (bf16*)(a.ws + WS_Z); const bf16* V = (const bf16*)(a.ws + WS_R1); const float* vstat = (const float*)(a.ws + WS_VSTAT);
    LAS float* st = (LAS float*)(lds + 131072);
    __syncthreads();
    if (tid < 128) { float mu, rstd; vrow_mu_rstd(vstat, tok0 + tid, mu, rstd); st[2 * tid] = mu; st[2 * tid + 1] = rstd; }
    const int tt = wave & 3, cq = wave >> 2, t = 32 * tt + l31;
    v4u vreg[8];
#pragma unroll
    for (int it = 0; it < 8; ++it) { const int sl = (it >> 2) * 64 + (tid >> 3), c0 = (it & 3) * 64 + 8 * (tid & 7); vreg[it] = *(const v4u*)(V + (size_t)(tok0 + sl) * 2048 + g0 * 256 + c0); }
    __syncthreads();
    for (int k = 0; k < 4; ++k) {
        const int g = g0 + k; LAS unsigned char* buf = lds + (k & 1) * 65536;
        const float* cgp = a.c_ln_g + j * 2048 + g * 256; const float* cbp = a.c_ln_b + j * 2048 + g * 256;
        int tk = tid; asm volatile("" : "+v"(tk)); const int p = tk & 7;
#pragma unroll
        for (int it = 0; it < 8; ++it) { const int sl = (it >> 2) * 64 + (tk >> 3), c0 = (it & 3) * 64 + 8 * p; const float mu = st[2 * sl], rstd = st[2 * sl + 1];
            const f32x4 ga = *(const f32x4*)(cgp + c0), gb = *(const f32x4*)(cgp + c0 + 4);
            const unsigned w0 = vreg[it].x, w1 = vreg[it].y, w2 = vreg[it].z, w3 = vreg[it].w;
            v4u o; o.x = cvtpk((bflo(w0) - mu) * rstd * ga[0], (bfhi(w0) - mu) * rstd * ga[1]); o.y = cvtpk((bflo(w1) - mu) * rstd * ga[2], (bfhi(w1) - mu) * rstd * ga[3]);
            o.z = cvtpk((bflo(w2) - mu) * rstd * gb[0], (bfhi(w2) - mu) * rstd * gb[1]); o.w = cvtpk((bflo(w3) - mu) * rstd * gb[2], (bfhi(w3) - mu) * rstd * gb[3]);
            *(LAS v4u*)(buf + ((it & 3) >> 1) * 32768 + sgu_off_b((unsigned)sl, (unsigned)((it & 1) * 8 + p))) = o; }
        __syncthreads();
        const bf16* Wsb = (const bf16*)(a.ws + WS_WSB) + (size_t)(j * 8 + g) * 128 * 128;
        bf16x8 bw[8];
#pragma unroll
        for (int kk = 0; kk < 8; ++kk) bw[kk] = *(const bf16x8*)(Wsb + (size_t)t * 128 + 16 * kk + 8 * h);
        f32x16 acc[4];
#pragma unroll
        for (int i = 0; i < 4; ++i) { acc[i] = (f32x16){0.f, 0.f, 0.f, 0.f, 0.f, 0.f, 0.f, 0.f, 0.f, 0.f, 0.f, 0.f, 0.f, 0.f, 0.f, 0.f};
            const int ct = 4 * cq + i; const unsigned lq = (unsigned)(lane & 15) >> 2, lp = (unsigned)lane & 3, lblk = ((unsigned)lane >> 4) & 1;
            const LAS unsigned char* ib = buf + (ct >> 2) * 32768;
            const unsigned a0 = sgu_off_b(8u * h + lq, 4u * (ct & 3) + 2u * lblk + (lp >> 1)) + 8u * (lp & 1), a1 = sgu_off_b(8u * h + 4u + lq, 4u * (ct & 3) + 2u * lblk + (lp >> 1)) + 8u * (lp & 1);
#pragma unroll
            for (int kk = 0; kk < 8; ++kk) { const s16x4 lo = sgu_tr(ib + a0 + kk * 4096), hi = sgu_tr(ib + a1 + kk * 4096);
                const bf16x8 af = __builtin_shufflevector(lo, hi, 0, 1, 2, 3, 4, 5, 6, 7);
                acc[i] = __builtin_amdgcn_mfma_f32_32x32x16_bf16(af, bw[kk], acc[i], 0, 0, 0); } }
        if (k < 3) {
#pragma unroll
            for (int it = 0; it < 8; ++it) { const int sl = (it >> 2) * 64 + (tk >> 3), c0 = (it & 3) * 64 + 8 * p; vreg[it] = *(const v4u*)(V + (size_t)(tok0 + sl) * 2048 + (g + 1) * 256 + c0); } }
        const float rswt = ((const float*)(a.ws + WS_SMALL))[SM_RSW + (j * 8 + g) * 128 + t], bst = a.c_bs[(j * 8 + g) * 128 + t];
        bf16* urow = U + (size_t)(tok0 + t) * 2048 + g * 256;
#pragma unroll
        for (int i = 0; i < 4; ++i)
#pragma unroll
            for (int qd = 0; qd < 4; ++qd) { const int c = 32 * (4 * cq + i) + 8 * qd + 4 * h;
                const v2u uw = *(const v2u*)(urow + c); const f32x4 cb4 = *(const f32x4*)(cbp + c);
                const float o0 = bflo(uw.x) * (acc[i][4 * qd + 0] + cb4[0] * rswt + bst), o1 = bfhi(uw.x) * (acc[i][4 * qd + 1] + cb4[1] * rswt + bst);
                const float o2 = bflo(uw.y) * (acc[i][4 * qd + 2] + cb4[2] * rswt + bst), o3 = bfhi(uw.y) * (acc[i][4 * qd + 3] + cb4[3] * rswt + bst);
                v2u ow; ow.x = cvtpk(o0, o1); ow.y = cvtpk(o2, o3); *(v2u*)(urow + c) = ow; }
    }
}

__device__ __forceinline__ void sgu_unit4(const Args& a, int unit, int j, LAS unsigned char* lds, int wave_s) {
    int tid_ = tid_from_wave(wave_s); asm volatile("" : "+v"(tid_)); const int tid = tid_, lane = tid & 63, wave = __builtin_amdgcn_readfirstlane(tid >> 6), l31 = lane & 31, h = lane >> 5;
    const int chunk = unit >> 1, g0 = (unit & 1) * 4, tok0 = chunk * 128;
    bf16* U = (bf16*)(a.ws + WS_Z); const bf16* V = (const bf16*)(a.ws + WS_R1); const float* vstat = (const float*)(a.ws + WS_VSTAT);
    LAS float* st = (LAS float*)(lds + 131072);
    __syncthreads();
    const int tt = wave & 3, cq = wave >> 2, t = 32 * tt + l31;
    v4u vreg[8];
#pragma unroll
    for (int it = 0; it < 8; ++it) { const int sl = (it >> 2) * 64 + (tid >> 3), c0 = (it & 3) * 64 + 8 * (tid & 7); vreg[it] = *(const v4u*)(V + (size_t)(tok0 + sl) * 2048 + g0 * 256 + c0); }
    if (tid < 128) { float mu, rstd; vrow_mu_rstd(vstat, tok0 + tid, mu, rstd); st[2 * tid] = mu; st[2 * tid + 1] = rstd; }
    __syncthreads();
    for (int k = 0; k < 4; ++k) {
        const int g = g0 + k; LAS unsigned char* buf = lds + (k & 1) * 65536;
        const float* cgp = a.c_ln_g + j * 2048 + g * 256; const float* cbp = a.c_ln_b + j * 2048 + g * 256;
        bf16* ubase = U + (size_t)(tok0 + 32 * tt + 4 * h) * 2048 + g * 256 + 128 * cq + 2 * l31;
        unsigned uwv[16][2];
#pragma unroll
        for (int r = 0; r < 16; ++r)
#pragma unroll
            for (int u = 0; u < 2; ++u) uwv[r][u] = *(const unsigned*)(ubase + (size_t)(8 * (r >> 2) + (r & 3)) * 2048 + 64 * u);
        int tk = tid; asm volatile("" : "+v"(tk)); const int p = tk & 7;
#pragma unroll
        for (int it = 0; it < 8; ++it) { const int sl = (it >> 2) * 64 + (tk >> 3), c0 = (it & 3) * 64 + 8 * p; const float mu = st[2 * sl], rstd = st[2 * sl + 1];
            const f32x4 ga = *(const f32x4*)(cgp + c0), gb = *(const f32x4*)(cgp + c0 + 4);
            const unsigned w0 = vreg[it].x, w1 = vreg[it].y, w2 = vreg[it].z, w3 = vreg[it].w;
            const float e0 = (bflo(w0) - mu) * rstd * ga[0], e1 = (bfhi(w0) - mu) * rstd * ga[1], e2 = (bflo(w1) - mu) * rstd * ga[2], e3 = (bfhi(w1) - mu) * rstd * ga[3];
            const float e4 = (bflo(w2) - mu) * rstd * gb[0], e5 = (bfhi(w2) - mu) * rstd * gb[1], e6 = (bflo(w3) - mu) * rstd * gb[2], e7 = (bfhi(w3) - mu) * rstd * gb[3];
            v2u ev, od; ev.x = cvtpk(e0, e2); ev.y = cvtpk(e4, e6); od.x = cvtpk(e1, e3); od.y = cvtpk(e5, e7);
            LAS unsigned char* ib = buf + ((it & 3) >> 1) * 32768 + 8 * (p & 1);
            *(LAS v2u*)(ib + sgu_off_b((unsigned)sl, (unsigned)((it & 1) * 8 + (p >> 1)))) = ev; *(LAS v2u*)(ib + sgu_off_b((unsigned)sl, (unsigned)((it & 1) * 8 + 4 + (p >> 1)))) = od; }
        const bf16* Wsb = (const bf16*)(a.ws + WS_WSB) + (size_t)(j * 8 + g) * 128 * 128;
        bf16x8 bw[8];
#pragma unroll
        for (int kk = 0; kk < 8; ++kk) bw[kk] = *(const bf16x8*)(Wsb + (size_t)((tt * 8 + kk) * 64 + lane) * 8);
        if (k < 3) {
#pragma unroll
            for (int it = 0; it < 8; ++it) { const int sl = (it >> 2) * 64 + (tk >> 3), c0 = (it & 3) * 64 + 8 * p; vreg[it] = *(const v4u*)(V + (size_t)(tok0 + sl) * 2048 + (g + 1) * 256 + c0); } }
        LDS_SYNC();
        f32x16 acc[4];
#pragma unroll
        for (int i = 0; i < 4; ++i) { acc[i] = (f32x16){0.f, 0.f, 0.f, 0.f, 0.f, 0.f, 0.f, 0.f, 0.f, 0.f, 0.f, 0.f, 0.f, 0.f, 0.f, 0.f};
            const int ct = 4 * cq + i; const unsigned lq = (unsigned)(lane & 15) >> 2, lp = (unsigned)lane & 3, lblk = ((unsigned)lane >> 4) & 1;
            const LAS unsigned char* ib = buf + (ct >> 2) * 32768;
            const unsigned a0 = sgu_off_b(8u * h + lq, 4u * (ct & 3) + 2u * lblk + (lp >> 1)) + 8u * (lp & 1), a1 = sgu_off_b(8u * h + 4u + lq, 4u * (ct & 3) + 2u * lblk + (lp >> 1)) + 8u * (lp & 1);
#pragma unroll
            for (int kk = 0; kk < 8; ++kk) { const s16x4 lo = sgu_tr(ib + a0 + kk * 4096), hi = sgu_tr(ib + a1 + kk * 4096);
                const bf16x8 af = __builtin_shufflevector(lo, hi, 0, 1, 2, 3, 4, 5, 6, 7);
                acc[i] = __builtin_amdgcn_mfma_f32_32x32x16_bf16(bw[kk], af, acc[i], 0, 0, 0); } }
        const float* rswp = (const float*)(a.ws + WS_SMALL) + SM_RSW + (j * 8 + g) * 128 + 32 * tt + 4 * h; const float* bsp = a.c_bs + (j * 8 + g) * 128 + 32 * tt + 4 * h;
        pg8::f32x2 cb2[2];
#pragma unroll
        for (int u = 0; u < 2; ++u) cb2[u] = *(const pg8::f32x2*)(cbp + 64 * (2 * cq + u) + 2 * l31);
#pragma unroll
        for (int rq = 0; rq < 4; ++rq) { const f32x4 rs4 = *(const f32x4*)(rswp + 8 * rq), bs4 = *(const f32x4*)(bsp + 8 * rq);
#pragma unroll
            for (int rr = 0; rr < 4; ++rr)
#pragma unroll
                for (int u = 0; u < 2; ++u) { unsigned* up = (unsigned*)(ubase + (size_t)(8 * rq + rr) * 2048 + 64 * u); const unsigned uw = uwv[4 * rq + rr][u];
                    const float o0 = bflo(uw) * (acc[2 * u][4 * rq + rr] + cb2[u].x * rs4[rr] + bs4[rr]), o1 = bfhi(uw) * (acc[2 * u + 1][4 * rq + rr] + cb2[u].y * rs4[rr] + bs4[rr]);
                    *up = cvtpk(o0, o1); } }
    }
}

constexpr int ATT_VT_OFF = 49152, ATT_VT_PITCH = 776;
__device__ __forceinline__ void attn_unit(const Args& a, int unit, int j, LAS unsigned char* lds, int wave_s) {
    int tid_ = tid_from_wave(wave_s); asm volatile("" : "+v"(tid_)); const int tid = tid_, lane = tid & 63, wave = __builtin_amdgcn_readfirstlane(tid >> 6), l31 = lane & 31, h = lane >> 5;
    const bf16* Z = (const bf16*)(a.ws + WS_Z); bf16* OB = (bf16*)(a.ws + WS_OB);
    const int blk = unit >> 1, kvh = unit & 1, t0 = blk * 128, ss = seq_start(t0), se = seq_end(t0), kbase = t0 - 128;
    __syncthreads();
    v4u kwv[6], vwv[6];
#pragma unroll
    for (int it = 0; it < 6; ++it) { const int idx = it * 512 + tid, row = idx >> 3, q = idx & 7; int sr = kbase + row; sr = sr < ss ? ss : sr; sr = sr > se - 1 ? se - 1 : sr;
        kwv[it] = *(const v4u*)(Z + (size_t)sr * NZ + ZKB + kvh * 64 + 8 * q); vwv[it] = *(const v4u*)(Z + (size_t)sr * NZ + ZVB + kvh * 64 + 8 * q); }
    bf16x8 qfa[2][4];
#pragma unroll
    for (int qi = 0; qi < 2; ++qi) { const int qt = wave * 2 + qi, hq = kvh * 4 + (qt >> 2), tq = t0 + 32 * (qt & 3) + l31;
#pragma unroll
        for (int kk = 0; kk < 4; ++kk) qfa[qi][kk] = *(const bf16x8*)(Z + (size_t)tq * NZ + ZQB + hq * 64 + 16 * kk + 8 * h); }
    __builtin_amdgcn_sched_barrier(0);
#pragma unroll
    for (int it = 0; it < 6; ++it) { const int idx = it * 512 + tid, row = idx >> 3, q = idx & 7, sx = kbase + row; const bool ok = sx >= ss && sx < se;
        const v4u zero4 = (v4u){0u, 0u, 0u, 0u}; const v4u kw = ok ? kwv[it] : zero4, vw = ok ? vwv[it] : zero4;
        *(LAS v4u*)(lds + row * 128 + ((q ^ ((row >> 1) & 7)) << 4)) = kw;
        const unsigned ww[4] = {vw.x, vw.y, vw.z, vw.w};
#pragma unroll
        for (int i = 0; i < 8; ++i) *(LAS unsigned short*)(lds + ATT_VT_OFF + (8 * q + i) * ATT_VT_PITCH + row * 2) = (unsigned short)((i & 1) ? (ww[i >> 1] >> 16) : (ww[i >> 1] & 0xffffu)); }
    __syncthreads();
    const float ninf = -__builtin_inff(); const bool edge = !(kbase >= ss && kbase + 384 <= se);
    for (int qi = 0; qi < 2; ++qi) {
        const int qt = wave * 2 + qi, g = qt >> 2, sb = qt & 3, hq = kvh * 4 + g, tq = t0 + 32 * sb + l31;
        const float slope = exp2f(-(float)(hq + 1)), sink = a.attn_sink[j * 8 + hq];
        bf16x8 qf[4];
#pragma unroll
        for (int kk = 0; kk < 4; ++kk) qf[kk] = qi ? qfa[1][kk] : qfa[0][kk];
        float m = sink, lsum = h == 0 ? 1.0f : 0.0f;
        f32x16 o0 = (f32x16){0.f, 0.f, 0.f, 0.f, 0.f, 0.f, 0.f, 0.f, 0.f, 0.f, 0.f, 0.f, 0.f, 0.f, 0.f, 0.f}, o1 = o0;
        for (int kt = sb; kt < sb + 9; ++kt) {
            f32x16 sc = (f32x16){0.f, 0.f, 0.f, 0.f, 0.f, 0.f, 0.f, 0.f, 0.f, 0.f, 0.f, 0.f, 0.f, 0.f, 0.f, 0.f};
            const int row = 32 * kt + l31, rsw = (row >> 1) & 7;
#pragma unroll
            for (int kk = 0; kk < 4; ++kk) { const bf16x8 kf = *(const LAS bf16x8*)(lds + row * 128 + (((2 * kk + h) ^ rsw) << 4)); sc = __builtin_amdgcn_mfma_f32_32x32x16_bf16(kf, qf[kk], sc, 0, 0, 0); }
            float mx = m;
            if (edge || kt == sb || kt == sb + 8) {
#pragma unroll
                for (int r = 0; r < 16; ++r) { const int s = kbase + 32 * kt + (r & 3) + 8 * (r >> 2) + 4 * h; const int dd = tq - s, dist = dd < 0 ? -dd : dd;
                    const bool ok = dist <= 128 && s >= ss && s < se; const float v = ok ? sc[r] * 0.125f - slope * (float)dist : ninf; sc[r] = v; mx = fmaxf(mx, v); }
            } else {
                const float fd = (float)(tq - (kbase + 32 * kt) - 4 * h);
#pragma unroll
                for (int r = 0; r < 16; ++r) { const float v = sc[r] * 0.125f - slope * fabsf(fd - (float)((r & 3) + 8 * (r >> 2))); sc[r] = v; mx = fmaxf(mx, v); }
            }
            mx = max_xor32(mx);
            const float cf = __expf(m - mx); m = mx; lsum *= cf; o0 = o0 * cf; o1 = o1 * cf;
#pragma unroll
            for (int r = 0; r < 16; ++r) { sc[r] = __expf(sc[r] - m); lsum += sc[r]; }
            bf16x8 pf[2];
#pragma unroll
            for (int sp = 0; sp < 2; ++sp) { v4u w; w.x = cvtpk(sc[8 * sp + 0], sc[8 * sp + 1]); w.y = cvtpk(sc[8 * sp + 2], sc[8 * sp + 3]); w.z = cvtpk(sc[8 * sp + 4], sc[8 * sp + 5]); w.w = cvtpk(sc[8 * sp + 6], sc[8 * sp + 7]); pf[sp] = __builtin_bit_cast(bf16x8, w); }
#pragma unroll
            for (int sp = 0; sp < 2; ++sp) {
                const int ko = (32 * kt + 16 * sp + 4 * h) * 2;
                { const LAS unsigned char* vp = lds + ATT_VT_OFF + l31 * ATT_VT_PITCH + ko; const v2u lo = *(const LAS v2u*)vp, hi = *(const LAS v2u*)(vp + 16); const v4u w = (v4u){lo.x, lo.y, hi.x, hi.y};
                  o0 = __builtin_amdgcn_mfma_f32_32x32x16_bf16(__builtin_bit_cast(bf16x8, w), pf[sp], o0, 0, 0, 0); }
                { const LAS unsigned char* vp = lds + ATT_VT_OFF + (32 + l31) * ATT_VT_PITCH + ko; const v2u lo = *(const LAS v2u*)vp, hi = *(const LAS v2u*)(vp + 16); const v4u w = (v4u){lo.x, lo.y, hi.x, hi.y};
                  o1 = __builtin_amdgcn_mfma_f32_32x32x16_bf16(__builtin_bit_cast(bf16x8, w), pf[sp], o1, 0, 0, 0); } }
        }
        lsum = sum_xor32(lsum); const float inv = 1.0f / lsum;
        bf16* orow = OB + (size_t)tq * 1024 + 512 + hq * 64;
#pragma unroll
        for (int qp = 0; qp < 2; ++qp) { v2u a0, a1, b0, b1;
            a0.x = cvtpk(o0[8 * qp] * inv, o0[8 * qp + 1] * inv); a0.y = cvtpk(o0[8 * qp + 2] * inv, o0[8 * qp + 3] * inv); a1.x = cvtpk(o0[8 * qp + 4] * inv, o0[8 * qp + 5] * inv); a1.y = cvtpk(o0[8 * qp + 6] * inv, o0[8 * qp + 7] * inv);
            b0.x = cvtpk(o1[8 * qp] * inv, o1[8 * qp + 1] * inv); b0.y = cvtpk(o1[8 * qp + 2] * inv, o1[8 * qp + 3] * inv); b1.x = cvtpk(o1[8 * qp + 4] * inv, o1[8 * qp + 5] * inv); b1.y = cvtpk(o1[8 * qp + 6] * inv, o1[8 * qp + 7] * inv);
            *(v4u*)(orow + 16 * qp + 8 * h) = widen_pair(a0, a1); *(v4u*)(orow + 32 + 16 * qp + 8 * h) = widen_pair(b0, b1); }
    }
}


constexpr int HA_G = 0, HA_T = 32768, HA_QT = 34816, HA_KT = HA_QT + 17408, HA_QF = HA_KT + 17408, HA_KE = HA_QF + 17408, HA_VT = HA_KE + 17408, HA_ST = HA_VT + 17408, HA_END = HA_ST + 34816;
static_assert(HA_END <= MISC_OFF, "HGRN level A LDS map");
__device__ __forceinline__ void hgrn_a_unit(const Args& a, int unit, int j, LAS unsigned char* lds, int wave_s) {
    int tid_ = tid_from_wave(wave_s); asm volatile("" : "+v"(tid_)); const int tid = tid_, lane = tid & 63, wave = __builtin_amdgcn_readfirstlane(tid >> 6), l31 = lane & 31, h = lane >> 5;
    const int sc = unit >> 3, hh = (unit >> 1) & 3, dir = unit & 1, scbase = sc * 512;
    const bf16* Z = (const bf16*)(a.ws + WS_Z); bf16* OP = (bf16*)a.out + (size_t)dir * M * 512; bf16* QTg = (bf16*)(a.ws + WS_QT) + (size_t)dir * M * 512;
    float* Fo = (float*)(a.ws + WS_F) + (size_t)unit * 16384; float* Td = (float*)(a.ws + WS_SMALL) + SM_TDEC + (size_t)unit * 128;
    const float* lbv = (const float*)(a.ws + WS_SMALL) + SM_LB + (size_t)j * 1024 + dir * 512 + hh * 128;
    const int ri = tid >> 3, d0 = (tid & 7) * 16, cd = tid & 127, rg = tid >> 7, ti = wave >> 2, ej = wave & 3;
    LAS float* Gm = (LAS float*)(lds + HA_G); LAS float* Tm = (LAS float*)(lds + HA_T);
    float lb16[16], Bc[16];
#pragma unroll
    for (int e = 0; e < 16; ++e) { lb16[e] = lbv[d0 + e]; Bc[e] = 0.f; }
    const f32x16 zero16 = (f32x16){0.f, 0.f, 0.f, 0.f, 0.f, 0.f, 0.f, 0.f, 0.f, 0.f, 0.f, 0.f, 0.f, 0.f, 0.f, 0.f};
    f32x16 sacc0 = zero16, sacc1 = zero16;
    __syncthreads();
    for (int i = tid; i < 34816 / 16; i += NTHR) *(LAS v4u*)(lds + HA_ST + 16 * i) = (v4u){0u, 0u, 0u, 0u};
    __syncthreads();
    for (int cc = 0; cc < 8; ++cc) {
        const int tok = dir == 0 ? scbase + 64 * cc + ri : scbase + 511 - 64 * cc - ri;
        float q[16], kk[16]; unsigned vraw[8];
        {
            const bf16* zr = Z + (size_t)tok * NZ + hh * 128 + d0;
            const v4u qa = *(const v4u*)(zr + ZQ), qb = *(const v4u*)(zr + ZQ + 8), fa = *(const v4u*)(zr + (dir == 0 ? ZFF : ZFB)), fb = *(const v4u*)(zr + (dir == 0 ? ZFF : ZFB) + 8), va = *(const v4u*)(zr + ZI), vb = *(const v4u*)(zr + ZI + 8);
            const unsigned qw[8] = {qa.x, qa.y, qa.z, qa.w, qb.x, qb.y, qb.z, qb.w}, fw[8] = {fa.x, fa.y, fa.z, fa.w, fb.x, fb.y, fb.z, fb.w};
            vraw[0] = va.x; vraw[1] = va.y; vraw[2] = va.z; vraw[3] = va.w; vraw[4] = vb.x; vraw[5] = vb.y; vraw[6] = vb.z; vraw[7] = vb.w;
            float lf[16];
#pragma unroll
            for (int e = 0; e < 16; ++e) { const float qr = (e & 1) ? bfhi(qw[e >> 1]) : bflo(qw[e >> 1]), fr = (e & 1) ? bfhi(fw[e >> 1]) : bflo(fw[e >> 1]);
                q[e] = qr * __builtin_amdgcn_rcpf(1.0f + __expf(-qr));
                const float ea = __expf(-fabsf(fr)), rc = __builtin_amdgcn_rcpf(1.0f + ea), sg = fr >= 0.f ? rc : ea * rc;
                const float lb = lb16[e], oml = 1.0f - lb;
                kk[e] = oml * (1.0f - sg);
                lf[e] = lb == 0.f ? (fminf(fr, 0.f) - __logf(1.0f + ea)) : __logf(lb + oml * sg); }
#pragma unroll
            for (int c4 = 0; c4 < 4; ++c4) *(LAS f32x4*)(Gm + ri * 128 + d0 + 4 * c4) = (f32x4){lf[4 * c4], lf[4 * c4 + 1], lf[4 * c4 + 2], lf[4 * c4 + 3]};
        }
        __syncthreads();
        {
            float pre[16]; float run = 0.f;
#pragma unroll
            for (int k = 0; k < 16; ++k) { run += Gm[(16 * rg + k) * 128 + cd]; pre[k] = run; }
            Tm[rg * 128 + cd] = run;
            __syncthreads();
            float off = 0.f;
#pragma unroll
            for (int r2 = 0; r2 < 3; ++r2) off += (r2 < rg) ? Tm[r2 * 128 + cd] : 0.f;
#pragma unroll
            for (int k = 0; k < 16; ++k) Gm[(16 * rg + k) * 128 + cd] = pre[k] + off;
        }
        __syncthreads();
        {
            float b[16], rr[16], bl[16];
#pragma unroll
            for (int c4 = 0; c4 < 4; ++c4) { const f32x4 x = *(const LAS f32x4*)(Gm + ri * 128 + d0 + 4 * c4), y = *(const LAS f32x4*)(Gm + 31 * 128 + d0 + 4 * c4), z = *(const LAS f32x4*)(Gm + 63 * 128 + d0 + 4 * c4);
#pragma unroll
                for (int i = 0; i < 4; ++i) { b[4 * c4 + i] = x[i]; rr[4 * c4 + i] = y[i]; bl[4 * c4 + i] = z[i]; } }
            unsigned wqt[8], wkt[8], wqf[8], wqg[8]; unsigned short ke[16];
#pragma unroll
            for (int e2 = 0; e2 < 8; ++e2) { float qt2[2], kt2[2], qf2[2], qg2[2];
#pragma unroll
                for (int x = 0; x < 2; ++x) { const int e = 2 * e2 + x; const float ex = __expf(b[e] - rr[e]), er = __expf(rr[e]), elr = __expf(bl[e] - rr[e]), ebc = __expf(Bc[e]);
                    qt2[x] = q[e] * ex; kt2[x] = kk[e] * __builtin_amdgcn_rcpf(ex); qf2[x] = qt2[x] * er; qg2[x] = qf2[x] * ebc; ke[e] = (unsigned short)f2bf(kt2[x] * elr); }
                wqt[e2] = cvtpk(qt2[0], qt2[1]); wkt[e2] = cvtpk(kt2[0], kt2[1]); wqf[e2] = cvtpk(qf2[0], qf2[1]); wqg[e2] = cvtpk(qg2[0], qg2[1]); }
            *(LAS v4u*)(lds + HA_QT + ri * 272 + d0 * 2) = (v4u){wqt[0], wqt[1], wqt[2], wqt[3]}; *(LAS v4u*)(lds + HA_QT + ri * 272 + d0 * 2 + 16) = (v4u){wqt[4], wqt[5], wqt[6], wqt[7]};
            *(LAS v4u*)(lds + HA_KT + ri * 272 + d0 * 2) = (v4u){wkt[0], wkt[1], wkt[2], wkt[3]}; *(LAS v4u*)(lds + HA_KT + ri * 272 + d0 * 2 + 16) = (v4u){wkt[4], wkt[5], wkt[6], wkt[7]};
            *(LAS v4u*)(lds + HA_QF + ri * 272 + d0 * 2) = (v4u){wqf[0], wqf[1], wqf[2], wqf[3]}; *(LAS v4u*)(lds + HA_QF + ri * 272 + d0 * 2 + 16) = (v4u){wqf[4], wqf[5], wqf[6], wqf[7]};
            *(v4u*)(QTg + (size_t)tok * 512 + hh * 128 + d0) = (v4u){wqg[0], wqg[1], wqg[2], wqg[3]}; *(v4u*)(QTg + (size_t)tok * 512 + hh * 128 + d0 + 8) = (v4u){wqg[4], wqg[5], wqg[6], wqg[7]};
#pragma unroll
            for (int e = 0; e < 16; ++e) { *(LAS unsigned short*)(lds + HA_KE + (d0 + e) * 136 + ri * 2) = ke[e];
                *(LAS unsigned short*)(lds + HA_VT + (d0 + e) * 136 + ri * 2) = (unsigned short)((e & 1) ? (vraw[e >> 1] >> 16) : (vraw[e >> 1] & 0xffffu)); Bc[e] += bl[e]; }
        }
        __syncthreads();
        bf16x8 vf[2][2]; float dec0, dec1;
        {
            bf16x8 pf[2][2];
#pragma unroll
            for (int sj = 0; sj < 2; ++sj) {
                if (sj <= ti) {
                    f32x16 pt = zero16;
#pragma unroll
                    for (int k8 = 0; k8 < 8; ++k8) { const bf16x8 af = *(const LAS bf16x8*)(lds + HA_KT + (32 * sj + l31) * 272 + (16 * k8 + 8 * h) * 2), bq = *(const LAS bf16x8*)(lds + HA_QT + (32 * ti + l31) * 272 + (16 * k8 + 8 * h) * 2);
                        pt = __builtin_amdgcn_mfma_f32_32x32x16_bf16(af, bq, pt, 0, 0, 0); }
#pragma unroll
                    for (int r = 0; r < 16; ++r) { const int sl = 32 * sj + (r & 3) + 8 * (r >> 2) + 4 * h, tl = 32 * ti + l31; pt[r] = sl <= tl ? pt[r] : 0.f; }
#pragma unroll
                    for (int sp = 0; sp < 2; ++sp) { v4u w; w.x = cvtpk(pt[8 * sp + 0], pt[8 * sp + 1]); w.y = cvtpk(pt[8 * sp + 2], pt[8 * sp + 3]); w.z = cvtpk(pt[8 * sp + 4], pt[8 * sp + 5]); w.w = cvtpk(pt[8 * sp + 6], pt[8 * sp + 7]); pf[sj][sp] = __builtin_bit_cast(bf16x8, w); }
                } else { pf[sj][0] = (bf16x8){0, 0, 0, 0, 0, 0, 0, 0}; pf[sj][1] = pf[sj][0]; }
            }
            f32x16 ot = zero16;
#pragma unroll
            for (int k8 = 0; k8 < 8; ++k8) { const bf16x8 af = *(const LAS bf16x8*)(lds + HA_ST + (32 * ej + l31) * 272 + (16 * k8 + 8 * h) * 2), bq = *(const LAS bf16x8*)(lds + HA_QF + (32 * ti + l31) * 272 + (16 * k8 + 8 * h) * 2);
                ot = __builtin_amdgcn_mfma_f32_32x32x16_bf16(af, bq, ot, 0, 0, 0); }
#pragma unroll
            for (int sj = 0; sj < 2; ++sj)
#pragma unroll
                for (int sp = 0; sp < 2; ++sp) { const LAS unsigned char* vp = lds + HA_VT + (32 * ej + l31) * 136 + (32 * sj + 16 * sp + 4 * h) * 2; const v2u lo = *(const LAS v2u*)vp, hi = *(const LAS v2u*)(vp + 16);
                    vf[sj][sp] = __builtin_bit_cast(bf16x8, ((v4u){lo.x, lo.y, hi.x, hi.y})); }
#pragma unroll
            for (int sj = 0; sj < 2; ++sj)
#pragma unroll
                for (int sp = 0; sp < 2; ++sp) ot = __builtin_amdgcn_mfma_f32_32x32x16_bf16(vf[sj][sp], pf[sj][sp], ot, 0, 0, 0);
            dec0 = __expf(Gm[63 * 128 + 32 * (2 * ti) + l31]); dec1 = __expf(Gm[63 * 128 + 32 * (2 * ti + 1) + l31]);
            const int tl = 32 * ti + l31, tokc = dir == 0 ? scbase + 64 * cc + tl : scbase + 511 - 64 * cc - tl;
            bf16* orow = OP + (size_t)tokc * 512 + hh * 128 + 32 * ej + 4 * h;
#pragma unroll
            for (int qd = 0; qd < 4; ++qd) { v2u w; w.x = cvtpk(ot[4 * qd], ot[4 * qd + 1]); w.y = cvtpk(ot[4 * qd + 2], ot[4 * qd + 3]); *(v2u*)(orow + 8 * qd) = w; }
        }
        __syncthreads();
        {
            sacc0 = sacc0 * dec0; sacc1 = sacc1 * dec1;
#pragma unroll
            for (int sj = 0; sj < 2; ++sj)
#pragma unroll
                for (int sp = 0; sp < 2; ++sp) {
                    { const LAS unsigned char* kp = lds + HA_KE + (32 * (2 * ti) + l31) * 136 + (32 * sj + 16 * sp + 4 * h) * 2; const v2u lo = *(const LAS v2u*)kp, hi = *(const LAS v2u*)(kp + 16);
                      sacc0 = __builtin_amdgcn_mfma_f32_32x32x16_bf16(vf[sj][sp], __builtin_bit_cast(bf16x8, ((v4u){lo.x, lo.y, hi.x, hi.y})), sacc0, 0, 0, 0); }
                    { const LAS unsigned char* kp = lds + HA_KE + (32 * (2 * ti + 1) + l31) * 136 + (32 * sj + 16 * sp + 4 * h) * 2; const v2u lo = *(const LAS v2u*)kp, hi = *(const LAS v2u*)(kp + 16);
                      sacc1 = __builtin_amdgcn_mfma_f32_32x32x16_bf16(vf[sj][sp], __builtin_bit_cast(bf16x8, ((v4u){lo.x, lo.y, hi.x, hi.y})), sacc1, 0, 0, 0); } }
#pragma unroll
            for (int r = 0; r < 16; ++r) { const int e = 32 * ej + (r & 3) + 8 * (r >> 2) + 4 * h;
                *(LAS unsigned short*)(lds + HA_ST + e * 272 + (32 * (2 * ti) + l31) * 2) = (unsigned short)f2bf(sacc0[r]);
                *(LAS unsigned short*)(lds + HA_ST + e * 272 + (32 * (2 * ti + 1) + l31) * 2) = (unsigned short)f2bf(sacc1[r]); }
        }
    }
#pragma unroll
    for (int r = 0; r < 16; ++r) { const int e = 32 * ej + (r & 3) + 8 * (r >> 2) + 4 * h; Fo[(size_t)e * 128 + 32 * (2 * ti) + l31] = sacc0[r]; Fo[(size_t)e * 128 + 32 * (2 * ti + 1) + l31] = sacc1[r]; }
    if (ri == 0) {
#pragma unroll
        for (int e = 0; e < 16; ++e) Td[d0 + e] = __expf(Bc[e]); }
}
constexpr int HB_T = 0, HB_BL = 4096, HB_QT = 8192, HB_KT = HB_QT + 17408, HB_QF = HB_KT + 17408, HB_KE = HB_QF + 17408, HB_VT = HB_KE + 17408, HB_ST = HB_VT + 17408, HB_END = HB_ST + 34816;
static_assert(HB_END <= MISC_OFF, "HGRN level A v2 LDS map");
__device__ __forceinline__ void hgrn_a_unit2(const Args& a, int unit, int j, LAS unsigned char* lds, int wave_s) {
    int tid_ = tid_from_wave(wave_s); asm volatile("" : "+v"(tid_)); const int tid = tid_, lane = tid & 63, wave = __builtin_amdgcn_readfirstlane(tid >> 6), l31 = lane & 31, h = lane >> 5;
    const bool smp = unit >= 256; const int uv = smp ? unit - 256 : unit, hh = (uv >> 1) & 3, dir = uv & 1;
    const int scbase = smp ? MP + (uv >> 3) * 512 : (uv >> 3) * 2048, nch = smp ? 8 : 32, lastt = 64 * nch - 1;
    const int funit = smp ? (MP / 512 + (uv >> 3)) * 8 + hh * 2 + dir : 0;
    const bf16* Z = (const bf16*)(a.ws + WS_Z); bf16* OP = (bf16*)a.out + (size_t)dir * M * 512; bf16* QTg = (bf16*)(a.ws + WS_QT) + (size_t)dir * M * 512;
    float* Fo = (float*)(a.ws + WS_F) + (size_t)funit * 16384; float* Td = (float*)(a.ws + WS_SMALL) + SM_TDEC + (size_t)funit * 128;
    const float* lbv = (const float*)(a.ws + WS_SMALL) + SM_LB + (size_t)j * 1024 + dir * 512 + hh * 128;
    const int c0 = 2 * lane, rg = wave, ti = wave >> 2, ej = wave & 3, zf = dir == 0 ? ZFF : ZFB;
    LAS float* Tm = (LAS float*)(lds + HB_T); LAS float* BLm = (LAS float*)(lds + HB_BL);
    const float lb0 = lbv[c0], lb1 = lbv[c0 + 1];
    float Bc0 = 0.f, Bc1 = 0.f;
    const f32x16 zero16 = (f32x16){0.f, 0.f, 0.f, 0.f, 0.f, 0.f, 0.f, 0.f, 0.f, 0.f, 0.f, 0.f, 0.f, 0.f, 0.f, 0.f};
    f32x16 sacc0 = zero16, sacc1 = zero16;
    unsigned rq[8], rf[8], rv[8];
#pragma unroll
    for (int r = 0; r < 8; ++r) { const int tok = dir == 0 ? scbase + 8 * rg + r : scbase + lastt - 8 * rg - r; const bf16* zr = Z + (size_t)tok * NZ + hh * 128 + c0;
        rq[r] = *(const unsigned*)(zr + ZQ); rf[r] = *(const unsigned*)(zr + zf); rv[r] = *(const unsigned*)(zr + ZI); }
    __syncthreads();
    for (int i = tid; i < 34816 / 16; i += NTHR) *(LAS v4u*)(lds + HB_ST + 16 * i) = (v4u){0u, 0u, 0u, 0u};
    for (int cc = 0; cc < nch; ++cc) {
        float q[8][2], kk[8][2], pre[8][2]; unsigned vw[8];
        {
            float run0 = 0.f, run1 = 0.f;
#pragma unroll
            for (int r = 0; r < 8; ++r) { vw[r] = rv[r];
#pragma unroll
                for (int x = 0; x < 2; ++x) { const float qr = x ? bfhi(rq[r]) : bflo(rq[r]), fr = x ? bfhi(rf[r]) : bflo(rf[r]), lb = x ? lb1 : lb0, oml = 1.0f - lb;
                    q[r][x] = qr * __builtin_amdgcn_rcpf(1.0f + __expf(-qr));
                    const float ea = __expf(-fabsf(fr)), rc = __builtin_amdgcn_rcpf(1.0f + ea), sg = fr >= 0.f ? rc : ea * rc;
                    kk[r][x] = oml * (1.0f - sg);
                    const float lf = lb == 0.f ? (fminf(fr, 0.f) - __logf(1.0f + ea)) : __logf(lb + oml * sg);
                    if (x) { run1 += lf; pre[r][1] = run1; } else { run0 += lf; pre[r][0] = run0; } } }
            *(LAS pg8::f32x2*)(Tm + rg * 128 + c0) = (pg8::f32x2){run0, run1};
        }
        __syncthreads();
        {
            float off0 = 0.f, off1 = 0.f, r310 = 0.f, r311 = 0.f, bl0 = 0.f, bl1 = 0.f;
#pragma unroll
            for (int r2 = 0; r2 < 8; ++r2) { const pg8::f32x2 tv = *(const LAS pg8::f32x2*)(Tm + r2 * 128 + c0); if (r2 < rg) { off0 += tv[0]; off1 += tv[1]; } if (r2 < 4) { r310 += tv[0]; r311 += tv[1]; } bl0 += tv[0]; bl1 += tv[1]; }
            const float er0 = __expf(r310), er1 = __expf(r311), elr0 = __expf(bl0 - r310), elr1 = __expf(bl1 - r311), ebc0 = __expf(Bc0), ebc1 = __expf(Bc1);
            float ke[8][2];
#pragma unroll
            for (int r = 0; r < 8; ++r) { const int row = 8 * rg + r, tok = dir == 0 ? scbase + 64 * cc + row : scbase + lastt - 64 * cc - row;
                const float ex0 = __expf(pre[r][0] + off0 - r310), ex1 = __expf(pre[r][1] + off1 - r311);
                const float qt0 = q[r][0] * ex0, qt1 = q[r][1] * ex1, kt0 = kk[r][0] * __builtin_amdgcn_rcpf(ex0), kt1 = kk[r][1] * __builtin_amdgcn_rcpf(ex1);
                const float qf0 = qt0 * er0, qf1 = qt1 * er1; ke[r][0] = kt0 * elr0; ke[r][1] = kt1 * elr1;
                *(LAS unsigned*)(lds + HB_QT + row * 272 + c0 * 2) = cvtpk(qt0, qt1);
                *(LAS unsigned*)(lds + HB_KT + row * 272 + c0 * 2) = cvtpk(kt0, kt1);
                *(LAS unsigned*)(lds + HB_QF + row * 272 + c0 * 2) = cvtpk(qf0, qf1);
                if (smp) *(unsigned*)(QTg + (size_t)tok * 512 + hh * 128 + c0) = cvtpk(qf0 * ebc0, qf1 * ebc1); }
#pragma unroll
            for (int x = 0; x < 2; ++x) { LAS unsigned char* kp = lds + HB_KE + (c0 + x) * 136 + 16 * rg; LAS unsigned char* vp = lds + HB_VT + (c0 + x) * 136 + 16 * rg;
                *(LAS v2u*)kp = (v2u){cvtpk(ke[0][x], ke[1][x]), cvtpk(ke[2][x], ke[3][x])}; *(LAS v2u*)(kp + 8) = (v2u){cvtpk(ke[4][x], ke[5][x]), cvtpk(ke[6][x], ke[7][x])};
                unsigned vv[4];
#pragma unroll
                for (int r2 = 0; r2 < 4; ++r2) vv[r2] = x ? ((vw[2 * r2] >> 16) | (vw[2 * r2 + 1] & 0xffff0000u)) : ((vw[2 * r2] & 0xffffu) | (vw[2 * r2 + 1] << 16));
                *(LAS v2u*)vp = (v2u){vv[0], vv[1]}; *(LAS v2u*)(vp + 8) = (v2u){vv[2], vv[3]}; }
            if (rg == 0) *(LAS pg8::f32x2*)(BLm + c0) = (pg8::f32x2){bl0, bl1};
            Bc0 += bl0; Bc1 += bl1;
            if (cc < nch - 1) {
#pragma unroll
                for (int r = 0; r < 8; ++r) { const int row = 8 * rg + r, tok = dir == 0 ? scbase + 64 * (cc + 1) + row : scbase + lastt - 64 * (cc + 1) - row; const bf16* zr = Z + (size_t)tok * NZ + hh * 128 + c0;
                    rq[r] = *(const unsigned*)(zr + ZQ); rf[r] = *(const unsigned*)(zr + zf); rv[r] = *(const unsigned*)(zr + ZI); } }
        }
        __syncthreads();
        bf16x8 vf[2][2]; float dec0, dec1;
        {
            bf16x8 pf[2][2];
#pragma unroll
            for (int sj = 0; sj < 2; ++sj) {
                if (sj <= ti) {
                    f32x16 pt = zero16;
#pragma unroll
                    for (int k8 = 0; k8 < 8; ++k8) { const bf16x8 af = *(const LAS bf16x8*)(lds + HB_KT + (32 * sj + l31) * 272 + (16 * k8 + 8 * h) * 2), bq = *(const LAS bf16x8*)(lds + HB_QT + (32 * ti + l31) * 272 + (16 * k8 + 8 * h) * 2);
                        pt = __builtin_amdgcn_mfma_f32_32x32x16_bf16(af, bq, pt, 0, 0, 0); }
#pragma unroll
                    for (int r = 0; r < 16; ++r) { const int sl = 32 * sj + (r & 3) + 8 * (r >> 2) + 4 * h, tl = 32 * ti + l31; pt[r] = sl <= tl ? pt[r] : 0.f; }
#pragma unroll
                    for (int sp = 0; sp < 2; ++sp) { v4u w; w.x = cvtpk(pt[8 * sp + 0], pt[8 * sp + 1]); w.y = cvtpk(pt[8 * sp + 2], pt[8 * sp + 3]); w.z = cvtpk(pt[8 * sp + 4], pt[8 * sp + 5]); w.w = cvtpk(pt[8 * sp + 6], pt[8 * sp + 7]); pf[sj][sp] = __builtin_bit_cast(bf16x8, w); }
                } else { pf[sj][0] = (bf16x8){0, 0, 0, 0, 0, 0, 0, 0}; pf[sj][1] = pf[sj][0]; }
            }
            f32x16 ot = zero16;
#pragma unroll
            for (int k8 = 0; k8 < 8; ++k8) { const bf16x8 af = *(const LAS bf16x8*)(lds + HB_ST + (32 * ej + l31) * 272 + (16 * k8 + 8 * h) * 2), bq = *(const LAS bf16x8*)(lds + HB_QF + (32 * ti + l31) * 272 + (16 * k8 + 8 * h) * 2);
                ot = __builtin_amdgcn_mfma_f32_32x32x16_bf16(af, bq, ot, 0, 0, 0); }
#pragma unroll
            for (int sj = 0; sj < 2; ++sj)
#pragma unroll
                for (int sp = 0; sp < 2; ++sp) { const LAS unsigned char* vp = lds + HB_VT + (32 * ej + l31) * 136 + (32 * sj + 16 * sp + 4 * h) * 2; const v2u lo = *(const LAS v2u*)vp, hi = *(const LAS v2u*)(vp + 16);
                    vf[sj][sp] = __builtin_bit_cast(bf16x8, ((v4u){lo.x, lo.y, hi.x, hi.y})); }
#pragma unroll
            for (int sj = 0; sj < 2; ++sj)
#pragma unroll
                for (int sp = 0; sp < 2; ++sp) ot = __builtin_amdgcn_mfma_f32_32x32x16_bf16(vf[sj][sp], pf[sj][sp], ot, 0, 0, 0);
            dec0 = __expf(BLm[32 * (2 * ti) + l31]); dec1 = __expf(BLm[32 * (2 * ti + 1) + l31]);
            const int tl = 32 * ti + l31, tokc = dir == 0 ? scbase + 64 * cc + tl : scbase + lastt - 64 * cc - tl;
            bf16* orow = OP + (size_t)tokc * 512 + hh * 128 + 32 * ej + 8 * h;
#pragma unroll
            for (int qp = 0; qp < 2; ++qp) { v2u w0, w1; w0.x = cvtpk(ot[8 * qp], ot[8 * qp + 1]); w0.y = cvtpk(ot[8 * qp + 2], ot[8 * qp + 3]); w1.x = cvtpk(ot[8 * qp + 4], ot[8 * qp + 5]); w1.y = cvtpk(ot[8 * qp + 6], ot[8 * qp + 7]);
                *(v4u*)(orow + 16 * qp) = widen_pair(w0, w1); }
        }
        __syncthreads();
        {
            sacc0 = sacc0 * dec0; sacc1 = sacc1 * dec1;
#pragma unroll
            for (int sj = 0; sj < 2; ++sj)
#pragma unroll
                for (int sp = 0; sp < 2; ++sp) {
                    { const LAS unsigned char* kp = lds + HB_KE + (32 * (2 * ti) + l31) * 136 + (32 * sj + 16 * sp + 4 * h) * 2; const v2u lo = *(const LAS v2u*)kp, hi = *(const LAS v2u*)(kp + 16);
                      sacc0 = __builtin_amdgcn_mfma_f32_32x32x16_bf16(vf[sj][sp], __builtin_bit_cast(bf16x8, ((v4u){lo.x, lo.y, hi.x, hi.y})), sacc0, 0, 0, 0); }
                    { const LAS unsigned char* kp = lds + HB_KE + (32 * (2 * ti + 1) + l31) * 136 + (32 * sj + 16 * sp + 4 * h) * 2; const v2u lo = *(const LAS v2u*)kp, hi = *(const LAS v2u*)(kp + 16);
                      sacc1 = __builtin_amdgcn_mfma_f32_32x32x16_bf16(vf[sj][sp], __builtin_bit_cast(bf16x8, ((v4u){lo.x, lo.y, hi.x, hi.y})), sacc1, 0, 0, 0); } }
#pragma unroll
            for (int r = 0; r < 16; ++r) { const int e = 32 * ej + (r & 3) + 8 * (r >> 2) + 4 * h;
                *(LAS unsigned short*)(lds + HB_ST + e * 272 + (32 * (2 * ti) + l31) * 2) = (unsigned short)f2bf(sacc0[r]);
                *(LAS unsigned short*)(lds + HB_ST + e * 272 + (32 * (2 * ti + 1) + l31) * 2) = (unsigned short)f2bf(sacc1[r]); }
        }
    }
    if (smp) {
#pragma unroll
    for (int r = 0; r < 16; ++r) { const int e = 32 * ej + (r & 3) + 8 * (r >> 2) + 4 * h; Fo[(size_t)e * 128 + 32 * (2 * ti) + l31] = sacc0[r]; Fo[(size_t)e * 128 + 32 * (2 * ti + 1) + l31] = sacc1[r]; }
    if (rg == 0) *(pg8::f32x2*)(Td + c0) = (pg8::f32x2){__expf(Bc0), __expf(Bc1)}; }
}
__device__ __forceinline__ int sin_frag_off(int e4) { const int e = e4 >> 7, dk = e4 & 127; return ((((e >> 5) * 8 + (dk >> 4)) * 64) + (e & 31) + 32 * ((dk >> 3) & 1)) * 8 + (dk & 7); }
template <int NB>
__device__ __forceinline__ void hgrn_b_chain(const float* Fo, const float* Td, bf16* SIN, int sc0, int nsc, int hh, int dir, int e4, f32x4& carry) {
    const int dk = e4 & 127;
    for (int k0 = 0; k0 < nsc; k0 += NB) {
        f32x4 f[NB], t[NB];
#pragma unroll
        for (int i = 0; i < NB; ++i) { const int sc = dir == 0 ? sc0 + k0 + i : sc0 + nsc - 1 - (k0 + i); const size_t unit = (size_t)sc * 8 + hh * 2 + dir;
            f[i] = *(const f32x4*)(Fo + unit * 16384 + e4); t[i] = *(const f32x4*)(Td + unit * 128 + dk); }
#pragma unroll
        for (int i = 0; i < NB; ++i) { const int sc = dir == 0 ? sc0 + k0 + i : sc0 + nsc - 1 - (k0 + i); const size_t unit = (size_t)sc * 8 + hh * 2 + dir;
            v2u w; w.x = cvtpk(carry[0], carry[1]); w.y = cvtpk(carry[2], carry[3]); *(v2u*)(SIN + unit * 16384 + sin_frag_off(e4)) = w; carry = t[i] * carry + f[i]; }
    }
}
__device__ __forceinline__ void hgrn_b_item(const Args& a, int it, int wave_s) {
    int tid_ = tid_from_wave(wave_s); asm volatile("" : "+v"(tid_)); const int tid = tid_;
    const float* Fo = (const float*)(a.ws + WS_F); const float* Td = (const float*)(a.ws + WS_SMALL) + SM_TDEC; bf16* SIN = (bf16*)(a.ws + WS_SIN);
    f32x4 carry = (f32x4){0.f, 0.f, 0.f, 0.f};
    if (it < 256) { if (tid < 128) { const int ch = it >> 5; hgrn_b_chain<8>(Fo, Td, SIN, MP / 512, MS / 512, ch >> 1, ch & 1, (it & 31) * 512 + tid * 4, carry); } }
    else { const int r = it - 256, pc = r >> 3; hgrn_b_chain<4>(Fo, Td, SIN, (pc >> 3) * 4, 4, (pc >> 1) & 3, pc & 1, (r & 7) * 2048 + tid * 4, carry); }
}
__device__ __forceinline__ void hgrn_c_unit(const Args& a, int unit, int j, LAS unsigned char* lds, int wave_s) {
    int tid_ = tid_from_wave(wave_s); asm volatile("" : "+v"(tid_)); const int tid = tid_, lane = tid & 63, wave = __builtin_amdgcn_readfirstlane(tid >> 6), l31 = lane & 31, h = lane >> 5;
    const int tt = unit >> 2, hh = unit & 3, ti = wave >> 2, ej = wave & 3, tok = tt * 64 + 32 * ti + l31, sc = (tt * 64) >> 9;
    const bf16* Z = (const bf16*)(a.ws + WS_Z); const bf16* OP = (const bf16*)a.out; const bf16* QTg = (const bf16*)(a.ws + WS_QT); const bf16* SIN = (const bf16*)(a.ws + WS_SIN); bf16* OB = (bf16*)(a.ws + WS_OB);
    f32x16 acc = (f32x16){0.f, 0.f, 0.f, 0.f, 0.f, 0.f, 0.f, 0.f, 0.f, 0.f, 0.f, 0.f, 0.f, 0.f, 0.f, 0.f};
#pragma unroll
    for (int dir = 0; dir < 2; ++dir) { const bf16* sin = SIN + ((size_t)sc * 8 + hh * 2 + dir) * 16384 + (size_t)(32 * ej + l31) * 128 + 8 * h; const bf16* qt = QTg + ((size_t)dir * M + tok) * 512 + hh * 128 + 8 * h;
        bf16x8 af[8], bq[8];
#pragma unroll
        for (int k8 = 0; k8 < 8; ++k8) { af[k8] = *(const bf16x8*)(sin + 16 * k8); bq[k8] = *(const bf16x8*)(qt + 16 * k8); }
#pragma unroll
        for (int k8 = 0; k8 < 8; ++k8) acc = __builtin_amdgcn_mfma_f32_32x32x16_bf16(af[k8], bq[k8], acc, 0, 0, 0); }
    float ss = 0.f;
#pragma unroll
    for (int qd = 0; qd < 4; ++qd) { const int e0 = 32 * ej + 8 * qd + 4 * h; const v2u p0 = *(const v2u*)(OP + (size_t)tok * 512 + hh * 128 + e0), p1 = *(const v2u*)(OP + ((size_t)M + tok) * 512 + hh * 128 + e0);
        acc[4 * qd] += bflo(p0.x) + bflo(p1.x); acc[4 * qd + 1] += bfhi(p0.x) + bfhi(p1.x); acc[4 * qd + 2] += bflo(p0.y) + bflo(p1.y); acc[4 * qd + 3] += bfhi(p0.y) + bfhi(p1.y);
        ss += (acc[4 * qd] * acc[4 * qd] + acc[4 * qd + 1] * acc[4 * qd + 1]) + (acc[4 * qd + 2] * acc[4 * qd + 2] + acc[4 * qd + 3] * acc[4 * qd + 3]); }
    ss += __shfl_xor(ss, 32);
    LAS float* sq = (LAS float*)lds;
    __syncthreads();
    if (h == 0) sq[(ti * 4 + ej) * 32 + l31] = ss;
    __syncthreads();
    const float tot = (sq[(ti * 4 + 0) * 32 + l31] + sq[(ti * 4 + 1) * 32 + l31]) + (sq[(ti * 4 + 2) * 32 + l31] + sq[(ti * 4 + 3) * 32 + l31]);
    const float rstd = 1.0f / sqrtf(tot * (1.0f / 128.0f) + RMS_EPS);
    const float* ng = a.hgrn_norm_g + j * 128;
#pragma unroll
    for (int qd = 0; qd < 4; ++qd) { const int e0 = 32 * ej + 8 * qd + 4 * h; const v2u gw2 = *(const v2u*)(Z + (size_t)tok * NZ + ZG + hh * 128 + e0); const f32x4 n4 = *(const f32x4*)(ng + e0);
        const float g0 = bflo(gw2.x), g1 = bfhi(gw2.x), g2 = bflo(gw2.y), g3 = bfhi(gw2.y);
        const float y0 = acc[4 * qd] * rstd * n4[0] * silu_f(g0), y1 = acc[4 * qd + 1] * rstd * n4[1] * silu_f(g1), y2 = acc[4 * qd + 2] * rstd * n4[2] * silu_f(g2), y3 = acc[4 * qd + 3] * rstd * n4[3] * silu_f(g3);
        v2u w; w.x = cvtpk(y0, y1); w.y = cvtpk(y2, y3); *(v2u*)(OB + (size_t)tok * 1024 + hh * 128 + e0) = w; }
}

__device__ __forceinline__ void hgrn_c_wave(const Args& a, int wu, int j, int wave_s) {
    int tid_ = tid_from_wave(wave_s); asm volatile("" : "+v"(tid_)); const int lane = tid_ & 63, l31 = lane & 31, h = lane >> 5;
    const int tile = wu >> 2, hh = wu & 3, tok = tile * 32 + l31, sc = (tile * 32) >> 9;
    const bf16* Z = (const bf16*)(a.ws + WS_Z); const bf16* OP = (const bf16*)a.out; const bf16* QTg = (const bf16*)(a.ws + WS_QT); const bf16* SIN = (const bf16*)(a.ws + WS_SIN); bf16* OB = (bf16*)(a.ws + WS_OB);
    const f32x16 zero16 = (f32x16){0.f, 0.f, 0.f, 0.f, 0.f, 0.f, 0.f, 0.f, 0.f, 0.f, 0.f, 0.f, 0.f, 0.f, 0.f, 0.f};
    f32x16 acc[4] = {zero16, zero16, zero16, zero16};
#pragma unroll
    for (int dir = 0; dir < 2; ++dir) {
        const bf16* sin = SIN + ((size_t)sc * 8 + hh * 2 + dir) * 16384 + (size_t)l31 * 128 + 8 * h; const bf16* qt = QTg + ((size_t)dir * M + tok) * 512 + hh * 128 + 8 * h;
#pragma unroll
        for (int kh = 0; kh < 2; ++kh) {
            bf16x8 af[4][4], bq[4];
#pragma unroll
            for (int k4 = 0; k4 < 4; ++k4) { bq[k4] = *(const bf16x8*)(qt + 16 * (4 * kh + k4));
#pragma unroll
                for (int et = 0; et < 4; ++et) af[k4][et] = *(const bf16x8*)(sin + (size_t)et * 32 * 128 + 16 * (4 * kh + k4)); }
#pragma unroll
            for (int k4 = 0; k4 < 4; ++k4)
#pragma unroll
                for (int et = 0; et < 4; ++et) acc[et] = __builtin_amdgcn_mfma_f32_32x32x16_bf16(af[k4][et], bq[k4], acc[et], 0, 0, 0);
        }
    }
    float ss = 0.f;
#pragma unroll
    for (int et = 0; et < 4; ++et)
#pragma unroll
        for (int qd = 0; qd < 4; ++qd) { const int e0 = 32 * et + 8 * qd + 4 * h; const v2u p0 = *(const v2u*)(OP + (size_t)tok * 512 + hh * 128 + e0), p1 = *(const v2u*)(OP + ((size_t)M + tok) * 512 + hh * 128 + e0);
            acc[et][4 * qd] += bflo(p0.x) + bflo(p1.x); acc[et][4 * qd + 1] += bfhi(p0.x) + bfhi(p1.x); acc[et][4 * qd + 2] += bflo(p0.y) + bflo(p1.y); acc[et][4 * qd + 3] += bfhi(p0.y) + bfhi(p1.y);
            ss += (acc[et][4 * qd] * acc[et][4 * qd] + acc[et][4 * qd + 1] * acc[et][4 * qd + 1]) + (acc[et][4 * qd + 2] * acc[et][4 * qd + 2] + acc[et][4 * qd + 3] * acc[et][4 * qd + 3]); }
    ss += __shfl_xor(ss, 32);
    const float rstd = 1.0f / sqrtf(ss * (1.0f / 128.0f) + RMS_EPS);
    const float* ng = a.hgrn_norm_g + j * 128;
#pragma unroll
    for (int et = 0; et < 4; ++et)
#pragma unroll
        for (int qd = 0; qd < 4; ++qd) { const int e0 = 32 * et + 8 * qd + 4 * h; const v2u gw2 = *(const v2u*)(Z + (size_t)tok * NZ + ZG + hh * 128 + e0); const f32x4 n4 = *(const f32x4*)(ng + e0);
            const float g0 = bflo(gw2.x), g1 = bfhi(gw2.x), g2 = bflo(gw2.y), g3 = bfhi(gw2.y);
            const float y0 = acc[et][4 * qd] * rstd * n4[0] * silu_f(g0), y1 = acc[et][4 * qd + 1] * rstd * n4[1] * silu_f(g1), y2 = acc[et][4 * qd + 2] * rstd * n4[2] * silu_f(g2), y3 = acc[et][4 * qd + 3] * rstd * n4[3] * silu_f(g3);
            v2u w; w.x = cvtpk(y0, y1); w.y = cvtpk(y2, y3); *(v2u*)(OB + (size_t)tok * 1024 + hh * 128 + e0) = w; }
}

constexpr int HC_PITCH = 272, HC_BUF = 32 * HC_PITCH, HC_WAVE = 2 * HC_BUF;
static_assert(8 * HC_WAVE <= MISC_OFF, "HGRN level C v4 LDS map");
__device__ __forceinline__ void hgrn_c_wave4(const Args& a, int wu, int j, LAS unsigned char* lds, int wave_s) {
    int tid_ = tid_from_wave(wave_s); asm volatile("" : "+v"(tid_)); const int lane = tid_ & 63, l31 = lane & 31, h = lane >> 5;
    const int tile = wu >> 2, hh = wu & 3, tok = tile * 32 + l31, sc = (tile * 32) >> 9;
    const bf16* Z = (const bf16*)(a.ws + WS_Z); const bf16* OP = (const bf16*)a.out; const bf16* QTg = (const bf16*)(a.ws + WS_QT); const bf16* SIN = (const bf16*)(a.ws + WS_SIN); bf16* OB = (bf16*)(a.ws + WS_OB);
    LAS unsigned char* b0 = lds + wave_s * HC_WAVE; LAS unsigned char* b1 = b0 + HC_BUF;
    const int cch = lane & 15, rsub = lane >> 4;
    const int lco = rsub * HC_PITCH + cch * 16, lmf = l31 * HC_PITCH + 8 * h;
    const f32x16 zero16 = (f32x16){0.f, 0.f, 0.f, 0.f, 0.f, 0.f, 0.f, 0.f, 0.f, 0.f, 0.f, 0.f, 0.f, 0.f, 0.f, 0.f};
    f32x16 acc[4] = {zero16, zero16, zero16, zero16};
    v4u pa[8], pb[8], pgt[8];
    { const bf16* o0 = OP + ((size_t)tile * 32 + rsub) * 512 + hh * 128 + 8 * cch; const bf16* o1 = o0 + (size_t)M * 512; const bf16* g0p = Z + ((size_t)tile * 32 + rsub) * NZ + ZG + hh * 128 + 8 * cch;
#pragma unroll
      for (int it = 0; it < 8; ++it) { pa[it] = *(const v4u*)(o0 + (size_t)(4 * it) * 512); pb[it] = *(const v4u*)(o1 + (size_t)(4 * it) * 512); pgt[it] = *(const v4u*)(g0p + (size_t)(4 * it) * NZ); } }
    __builtin_amdgcn_sched_barrier(0);
    if (tile * 32 >= MP) {
#pragma unroll
    for (int dir = 0; dir < 2; ++dir) {
        const bf16* sin = SIN + ((size_t)sc * 8 + hh * 2 + dir) * 16384 + (size_t)lane * 8; const bf16* qt = QTg + ((size_t)dir * M + tok) * 512 + hh * 128 + 8 * h;
#pragma unroll
        for (int kh = 0; kh < 4; ++kh) {
            bf16x8 af[2][4], bq[2];
#pragma unroll
            for (int k2 = 0; k2 < 2; ++k2) { bq[k2] = *(const bf16x8*)(qt + 16 * (2 * kh + k2));
#pragma unroll
                for (int et = 0; et < 4; ++et) af[k2][et] = *(const bf16x8*)(sin + (size_t)((et * 8 + 2 * kh + k2) * 64) * 8); }
#pragma unroll
            for (int k2 = 0; k2 < 2; ++k2)
#pragma unroll
                for (int et = 0; et < 4; ++et) acc[et] = __builtin_amdgcn_mfma_f32_32x32x16_bf16(af[k2][et], bq[k2], acc[et], 0, 0, 0);
        }
    }
    }
    __builtin_amdgcn_sched_barrier(0);
#pragma unroll
    for (int it = 0; it < 8; ++it) { *(LAS v4u*)(b0 + lco + it * 4 * HC_PITCH) = pa[it]; *(LAS v4u*)(b1 + lco + it * 4 * HC_PITCH) = pb[it]; }
    LDS_WAIT();
    float ss = 0.f;
#pragma unroll
    for (int et = 0; et < 4; ++et)
#pragma unroll
        for (int qd = 0; qd < 4; ++qd) { const v2u p0 = *(const LAS v2u*)(b0 + lmf + (32 * et + 8 * qd) * 2), p1 = *(const LAS v2u*)(b1 + lmf + (32 * et + 8 * qd) * 2);
            acc[et][4 * qd] += bflo(p0.x) + bflo(p1.x); acc[et][4 * qd + 1] += bfhi(p0.x) + bfhi(p1.x); acc[et][4 * qd + 2] += bflo(p0.y) + bflo(p1.y); acc[et][4 * qd + 3] += bfhi(p0.y) + bfhi(p1.y);
            ss += (acc[et][4 * qd] * acc[et][4 * qd] + acc[et][4 * qd + 1] * acc[et][4 * qd + 1]) + (acc[et][4 * qd + 2] * acc[et][4 * qd + 2] + acc[et][4 * qd + 3] * acc[et][4 * qd + 3]); }
    ss = sum_xor32(ss);
    const float rstd = 1.0f / sqrtf(ss * (1.0f / 128.0f) + RMS_EPS);
    LDS_WAIT();
#pragma unroll
    for (int it = 0; it < 8; ++it) *(LAS v4u*)(b0 + lco + it * 4 * HC_PITCH) = pgt[it];
    LDS_WAIT();
    const float* ng = a.hgrn_norm_g + j * 128;
#pragma unroll
    for (int et = 0; et < 4; ++et)
#pragma unroll
        for (int qd = 0; qd < 4; ++qd) { const int e0 = 32 * et + 8 * qd + 4 * h; const v2u gw2 = *(const LAS v2u*)(b0 + lmf + (32 * et + 8 * qd) * 2); const f32x4 n4 = *(const f32x4*)(ng + e0);
            const float g0 = bflo(gw2.x), g1 = bfhi(gw2.x), g2 = bflo(gw2.y), g3 = bfhi(gw2.y);
            const float y0 = acc[et][4 * qd] * rstd * n4[0] * silu_f(g0), y1 = acc[et][4 * qd + 1] * rstd * n4[1] * silu_f(g1), y2 = acc[et][4 * qd + 2] * rstd * n4[2] * silu_f(g2), y3 = acc[et][4 * qd + 3] * rstd * n4[3] * silu_f(g3);
            v2u w; w.x = cvtpk(y0, y1); w.y = cvtpk(y2, y3); *(LAS v2u*)(b1 + lmf + (32 * et + 8 * qd) * 2) = w; }
    LDS_WAIT();
    { bf16* ob = OB + ((size_t)tile * 32 + rsub) * 1024 + hh * 128 + 8 * cch;
#pragma unroll
      for (int it = 0; it < 8; ++it) *(v4u*)(ob + (size_t)(4 * it) * 1024) = *(const LAS v4u*)(b1 + lco + it * 4 * HC_PITCH); }
    LDS_WAIT();
}

__device__ __forceinline__ Args load_args() {
#if defined(__HIP_DEVICE_COMPILE__)
    unsigned long long p = (unsigned long long)__builtin_amdgcn_kernarg_segment_ptr(); asm volatile("" : "+s"(p)); return *(const __attribute__((address_space(4))) Args*)p;
#else
    return Args{};
#endif
}
#define PH_ARGS() const Args a = load_args(); unsigned char* const ws = a.ws; float* const smallf = (float*)(ws + WS_SMALL); bf16* const Wb = (bf16*)(ws + WS_W); bf16* const XB = (bf16*)(ws + WS_XB); bf16* const Zb = (bf16*)(ws + WS_Z); \
    bf16* const OB = (bf16*)(ws + WS_OB); float* const stat_mix = (float*)(ws + WS_STATMIX); float* const stat_ffn = (float*)(ws + WS_STATFFN); float* const vstat = (float*)(ws + WS_VSTAT); \
    (void)smallf; (void)Wb; (void)XB; (void)Zb; (void)OB; (void)stat_mix; (void)stat_ffn; (void)vstat
#define PH_TID() int tid_ = tid_from_wave(wave_s); asm volatile("" : "+v"(tid_)); const int tid = tid_, lane = tid & 63, wave = __builtin_amdgcn_readfirstlane(tid >> 6), gw = vcu * NWAVES + wave; (void)lane; (void)gw

__global__ void __launch_bounds__(NTHR, 2) fwd_kernel(Args a_unused) {
    extern __shared__ __attribute__((aligned(16))) unsigned char lds_raw[];
    LAS unsigned char* lds = (LAS unsigned char*)lds_raw;
    volatile LAS unsigned* MISC = (volatile LAS unsigned*)(lds + MISC_OFF);
    constexpr int G = 256, NGW = G * NWAVES;
    const int bx = blockIdx.x; __builtin_assume(bx >= 0 && bx < 256);
    const int vcu = (bx & 7) * (G / 8) + (bx >> 3);
    const int wave_s = __builtin_amdgcn_readfirstlane((int)threadIdx.x >> 6);
    if (threadIdx.x < 64) MISC[threadIdx.x] = 0u;
    __syncthreads();
    { const Args a = load_args(); (void)xcd_barrier_post((unsigned*)(a.ws + WS_CTL), MISC + 8, tid_from_wave(wave_s) == 0); }
#define GRID_BAR() do { const Args a_ = load_args(); XcdBarrier b_; b_.bar = (unsigned*)(a_.ws + WS_CTL); b_.x = xb_xcc_id(); b_.st = MISC + 8; int t_ = tid_from_wave(wave_s); asm volatile("" : "+v"(t_)); xcd_barrier(b_, t_ == 0); } while (0)

    {
        PH_ARGS(); PH_TID();
        LAS float* scr = (LAS float*)(lds + wave * 16640);
        constexpr int I_INAB = (D / 64) * (NZ / 64), I_OUTAB = (D / 64) * (D / 64), I_INC = (D / 64) * (4096 / 64), I_OUTC = (CW / 64) * (D / 64), I_GU = (D / 64) * (FF / 64), I_DN = (FF / 64) * (D / 64);
        float* const PF = (float*)(ws + WS_PF);
        constexpr int NITEMS = 2 * I_INAB + 2 * I_OUTAB + 2 * I_INC + 2 * I_OUTC + 8 * I_GU + 4 * I_DN;
        for (int it = gw; it < NITEMS; it += NGW) {
            int r = it;
            if (r < 2 * I_INAB) { const int jj = r / I_INAB; p0_transpose_item(a.w_in_ab + (size_t)jj * D * NZ, D, NZ, Wb + W_INAB + (size_t)jj * NZ * D, 0, jj ? a.ln_ffn_g + 1 * D : nullptr, scr, r % I_INAB, lane, true, jj ? a.ln_ffn_b + 1 * D : nullptr, jj ? PF : nullptr, jj ? PF + (SM_BW_AB1 - SM_GW_AB1) : nullptr); continue; } r -= 2 * I_INAB;
            if (r < 2 * I_OUTAB) { const int jj = r / I_OUTAB; p0_transpose_item(a.w_out_ab + (size_t)jj * D * D, D, D, Wb + W_OUTAB + (size_t)jj * D * D, 0, nullptr, scr, r % I_OUTAB, lane); continue; } r -= 2 * I_OUTAB;
            if (r < 2 * I_INC) { const int jj = r / I_INC; p0_transpose_item(a.w_in_c + (size_t)jj * D * 4096, D, 4096, Wb + W_INC + (size_t)jj * 4096 * D, 0, a.ln_ffn_g + (2 * jj) * D, scr, r % I_INC, lane, true, a.ln_ffn_b + (2 * jj) * D, PF + (SM_GW_C - SM_GW_AB1) + jj * 4096, PF + (SM_BW_C - SM_GW_AB1) + jj * 4096); continue; } r -= 2 * I_INC;
            if (r < 2 * I_OUTC) { const int jj = r / I_OUTC; p0_transpose_item(a.w_out_c + (size_t)jj * CW * D, CW, D, Wb + W_OUTC + (size_t)jj * D * CW, 0, nullptr, scr, r % I_OUTC, lane); continue; } r -= 2 * I_OUTC;
            if (r < 8 * I_GU) { const int L = r / (2 * I_GU), wh = (r / I_GU) & 1; p0_transpose_item((wh ? a.w_up : a.w_gate) + (size_t)L * D * FF, D, FF, Wb + W_GU + (size_t)L * 2 * FF * D, 1 + wh, a.ln_mix_g + L * D, scr, r % I_GU, lane, true, a.ln_mix_b + L * D, PF + (SM_GW_GU - SM_GW_AB1) + L * 5632, PF + (SM_BW_GU - SM_GW_AB1) + L * 5632); continue; } r -= 8 * I_GU;
            { const int L = r / I_DN; p0_transpose_item(a.w_down + (size_t)L * FF * D, FF, D, Wb + W_DN + (size_t)L * D * FF, 0, nullptr, scr, r % I_DN, lane); }
        }
        for (int r = gw; r < 2048; r += NGW) { const float w0 = a.c_ws[(size_t)r * 128 + 2 * lane], w1 = a.c_ws[(size_t)r * 128 + 2 * lane + 1];
            { const int tr = r & 127, sc2 = 2 * lane;
              *(unsigned*)((bf16*)(ws + WS_WSB) + (size_t)(r >> 7) * 16384 + ((((tr >> 5) * 8 + (sc2 >> 4)) * 64) + (tr & 31) + 32 * ((sc2 >> 3) & 1)) * 8 + (sc2 & 7)) = pk2(w0, w1); } const float rs = wave_sum(w0 + w1); if (lane == 0) smallf[SM_RSW + r] = rs; }
        for (int i = bx * NTHR + tid; i < 2048; i += G * NTHR) { const int jj = i >> 10, r = i & 1023; float v = 0.f;
            if (jj == 1) { const float l0 = a.lb_logits[r], l1 = a.lb_logits[1024 + r]; const float mxx = fmaxf(l0, l1), e0 = expf(l0 - mxx), e1 = expf(l1 - mxx); const float p0 = e0 / (e0 + e1), p1 = e1 / (e0 + e1); v = fmaxf((p0 + p1) - p0, 0.f); }
            smallf[SM_LB + i] = v; }
        static_assert(M % (4 * NGW) == 0, "x conversion: 4 rows per wave per step");
        for (int m0 = gw; m0 < M; m0 += 4 * NGW) { f32x4 v[4][4];
#pragma unroll
            for (int q = 0; q < 4; ++q) { const int m = m0 + q * NGW; const float* xr = m < MP ? a.x_prompt + (size_t)m * D : a.x_sample + (size_t)(m - MP) * D; const GAS f32x4* xp = (const GAS f32x4*)xr + lane;
#pragma unroll
                for (int jq = 0; jq < 4; ++jq) v[q][jq] = xp[64 * jq]; }
#pragma unroll
            for (int q = 0; q < 4; ++q) { GAS v2u* o8 = (GAS v2u*)(XB + (size_t)(m0 + q * NGW) * D) + lane;
#pragma unroll
                for (int jq = 0; jq < 4; ++jq) { v2u w; w.x = pk2h(v[q][jq].x, v[q][jq].y); w.y = pk2h(v[q][jq].z, v[q][jq].w); o8[64 * jq] = w; } } }
    }
    GRID_BAR();
    {
        PH_ARGS(); PH_TID(); const float* PF = (const float*)(ws + WS_PF);
        for (int i = bx * NTHR + tid; i < FOLD_N; i += G * NTHR) { float acc = 0.f;
#pragma unroll
            for (int kb = 0; kb < 16; ++kb) acc += PF[(size_t)kb * FOLD_N + i];
            smallf[SM_GW_AB1 + i] = acc; }
    }

    for (int L = 0; L < 4; ++L) {
        const int j = L >> 1;
        if ((L & 1) == 0) {
            { PH_ARGS(); pg8::Gemm g{XB, Wb + W_INAB + (size_t)j * NZ * D, M, NZ, D}; pg8::StaticOrder S; S.init(M, NZ, G, bx);
              pg8::EpiZ E{Zb, NZ, L == 0 ? nullptr : stat_ffn, smallf + SM_GW_AB1, smallf + SM_BW_AB1};
              for (int rep = 0; rep < REP_G; ++rep) pg8::gemm_phase<pg8::EpiZ, pg8::StaticOrder, true, true, true>(lds, g, S, E, wave_s); }
            GRID_BAR();
            { PH_ARGS();
#if NAIVE_HGRN
              for (int u = bx; u < 66; u += G) naive_hgrn_unit(a, u, j, lds, wave_s);
#else
#ifndef SKIP_HA
              for (int rep = 0; rep < REP_HA; ++rep) for (int u = bx; u < 512; u += G) hgrn_a_unit2(a, u, j, lds, wave_s);
#endif
#endif
#if NAIVE_ATTN
              for (int u = bx; u < M / 64; u += G) naive_attn_unit(a, u, j, wave_s);
#else
              for (int rep = 0; rep < REP_ATT; ++rep) for (int u = bx; u < (M / 128) * 2; u += G) attn_unit(a, u, j, lds, wave_s);
#endif
            }
            GRID_BAR();
            { PH_ARGS();
#if NAIVE_HGRN
              naive_hgrn_finish(a, j, vcu, NGW, wave_s);
#else
#ifndef SKIP_HB
              for (int rep = 0; rep < REP_HBC; ++rep) for (int it = bx; it < 256; it += G) hgrn_b_item(a, it, wave_s);
#endif
#endif
            }
            GRID_BAR();
#if !NAIVE_HGRN
            { PH_ARGS();
#ifndef SKIP_HC
              for (int rep = 0; rep < REP_HBC; ++rep) for (int i = 0; i < 5; ++i) hgrn_c_wave4(a, i < 4 ? (bx * 4 + i) * 8 + wave_s : 8192 + bx * 8 + wave_s, j, lds, wave_s);
#endif
            }
            GRID_BAR();
#endif
            { PH_ARGS(); pg8::Gemm g{OB, Wb + W_OUTAB + (size_t)j * D * D, M, D, D}; pg8::StaticOrder S; S.init(M, D, G, bx);
              if (L == 0) { pg8::EpiResid<true> E{nullptr, nullptr, nullptr, XB, stat_mix, nullptr, nullptr, nullptr, ALPHA};
                  pg8::gemm_phase<pg8::EpiResid<true>, pg8::StaticOrder, true, true>(lds, g, S, E, wave_s); }
              else { pg8::EpiResid<false> E{nullptr, nullptr, nullptr, XB, stat_mix, stat_ffn, a.ln_ffn_g + (L - 1) * D, a.ln_ffn_b + (L - 1) * D, ALPHA};
                  pg8::gemm_phase<pg8::EpiResid<false>, pg8::StaticOrder, true, true>(lds, g, S, E, wave_s); } }
            GRID_BAR();
        } else {
            { PH_ARGS(); pg8::Gemm g{XB, Wb + W_INC + (size_t)j * 4096 * D, M, 4096, D}; pg8::StaticOrder S; S.init(M, 4096, G, bx);
              pg8::EpiGeluUV E{Zb, (bf16*)(ws + WS_R1), vstat, stat_ffn, smallf + SM_GW_C + j * 4096, smallf + SM_BW_C + j * 4096};
              for (int rep = 0; rep < REP_G; ++rep) pg8::gemm_phase<pg8::EpiGeluUV, pg8::StaticOrder, true, true, true>(lds, g, S, E, wave_s); }
            GRID_BAR();
            { PH_ARGS();
#if NAIVE_SGU
              for (int u = bx; u < (M / 128) * 8; u += G) naive_sgu_unit(a, u, j, lds, wave_s);
#else
              for (int i5 = 0; i5 < 5; ++i5) {
                  const int pmi = 40 * ((bx >> 2) & 7) + 8 * (4 - i5) + (bx >> 5); sgu_unit4(a, (2 * pmi + ((bx >> 1) & 1)) * 2 + (bx & 1), j, lds, wave_s); }
#endif
            }
            GRID_BAR();
            { PH_ARGS(); pg8::Gemm g{Zb, Wb + W_OUTC + (size_t)j * D * CW, M, D, CW}; pg8::StaticOrder S; S.init(M, D, G, bx);
              pg8::EpiResid<false> E{nullptr, nullptr, nullptr, XB, stat_mix, stat_ffn, a.ln_ffn_g + (L - 1) * D, a.ln_ffn_b + (L - 1) * D, ALPHA};
              pg8::gemm_phase<pg8::EpiResid<false>, pg8::StaticOrder, true, true>(lds, g, S, E, wave_s); }
            GRID_BAR();
        }
        { PH_ARGS(); pg8::Gemm g{XB, Wb + W_GU + (size_t)L * 2 * FF * D, M, 2 * FF, D}; pg8::StaticOrder S; S.init(M, 2 * FF, G, bx);
          pg8::EpiSwiglu E{Zb, stat_mix, smallf + SM_GW_GU + L * 5632, smallf + SM_BW_GU + L * 5632};
          for (int rep = 0; rep < REP_G; ++rep) pg8::gemm_phase<pg8::EpiSwiglu, pg8::StaticOrder, true, true, true>(lds, g, S, E, wave_s); }
        GRID_BAR();
        { PH_ARGS(); pg8::Gemm g{Zb, Wb + W_DN + (size_t)L * D * FF, M, D, FF}; pg8::StaticOrder S; S.init(M, D, G, bx, true);
          pg8::EpiResid<false> E{nullptr, nullptr, nullptr, XB, stat_ffn, stat_mix, a.ln_mix_g + L * D, a.ln_mix_b + L * D, ALPHA};
          pg8::gemm_phase<pg8::EpiResid<false>, pg8::StaticOrder, true, true>(lds, g, S, E, wave_s); }
        GRID_BAR();
    }
    { PH_ARGS(); PH_TID();
      f32x4 gq[4], bq[4];
#pragma unroll
      for (int jq = 0; jq < 4; ++jq) { gq[jq] = *((const f32x4*)(a.ln_ffn_g + 3 * D) + lane + 64 * jq); bq[jq] = *((const f32x4*)(a.ln_ffn_b + 3 * D) + lane + 64 * jq); }
      static_assert(M % (2 * NGW) == 0, "final LayerNorm: two rows per wave per step");
      for (int m0 = gw; m0 < M; m0 += 2 * NGW) {
          v2u xw[2][4]; f32x4 sv[2][8];
#pragma unroll
          for (int rr = 0; rr < 2; ++rr) { const int m = m0 + rr * NGW; const GAS v2u* xq = (const GAS v2u*)(XB + (size_t)m * D) + lane; const f32x4* sp = (const f32x4*)(stat_ffn + (size_t)m * 32);
#pragma unroll
              for (int jq = 0; jq < 4; ++jq) xw[rr][jq] = xq[64 * jq];
#pragma unroll
              for (int i8 = 0; i8 < 8; ++i8) sv[rr][i8] = sp[i8]; }
          __builtin_amdgcn_sched_barrier(0);
#pragma unroll
          for (int rr = 0; rr < 2; ++rr) { const int m = m0 + rr * NGW; float ms = 0.f;
#pragma unroll
              for (int i8 = 0; i8 < 8; ++i8) ms += sv[rr][i8][0] + sv[rr][i8][2];
              const float mu = ms * (1.0f / 16.0f); float q = 0.f;
#pragma unroll
              for (int i8 = 0; i8 < 8; ++i8) { const float d0 = sv[rr][i8][0] - mu, d1 = sv[rr][i8][2] - mu; q += (sv[rr][i8][1] + sv[rr][i8][3]) + 64.0f * (d0 * d0 + d1 * d1); }
              const float rstd = __builtin_amdgcn_rsqf(q * (1.0f / 1024.0f) + pg8::LN_EPS);
              GAS f32x4* op = (GAS f32x4*)(a.out + (size_t)m * D) + lane;
#pragma unroll
              for (int jq = 0; jq < 4; ++jq) { pg8::u32x2 w2; w2.x = xw[rr][jq].x; w2.y = xw[rr][jq].y; const f32x4 v = pg8::f16x4_to_f32(w2); op[64 * jq] = (v - mu) * rstd * gq[jq] + bq[jq]; } } } }
}

extern "C" void kernel_launch(void* const* d_in, const int* in_sizes, int n_in, void* d_out, int out_size, void* d_ws, size_t ws_size, hipStream_t stream) {
    static int grid = 0;
    if (grid == 0) {
        if (n_in != 20 || out_size != M * D || ws_size < WS_END) { fprintf(stderr, "kernel_launch: unexpected shapes (n_in %d out %d ws %zu)\n", n_in, out_size, ws_size); grid = -1; return; }
        int dev = 0, cus = 0, per_cu = 0;
        if (hipGetDevice(&dev) != hipSuccess || hipDeviceGetAttribute(&cus, hipDeviceAttributeMultiprocessorCount, dev) != hipSuccess) { grid = -1; return; }
        if (hipFuncSetAttribute((const void*)fwd_kernel, hipFuncAttributeMaxDynamicSharedMemorySize, LDS_BYTES) != hipSuccess) { fprintf(stderr, "kernel_launch: hipFuncSetAttribute failed\n"); grid = -1; return; }
        if (hipOccupancyMaxActiveBlocksPerMultiprocessor(&per_cu, (const void*)fwd_kernel, NTHR, LDS_BYTES) != hipSuccess || per_cu < 1) fprintf(stderr, "kernel_launch: occupancy query says %d\n", per_cu);
        (void)hipGetLastError();
        if (cus < 256) { fprintf(stderr, "kernel_launch: needs 256 CUs, device has %d\n", cus); grid = -1; return; }
        grid = 256;
    }
    if (grid < 0) return;
    (void)hipMemsetAsync((char*)d_ws + WS_CTL, 0, CTL_ZERO_BYTES, stream);
    Args a{};
    a.x_prompt = (const float*)d_in[0]; a.x_sample = (const float*)d_in[1]; a.w_in_ab = (const float*)d_in[2]; a.lb_logits = (const float*)d_in[3]; a.hgrn_norm_g = (const float*)d_in[4];
    a.attn_sink = (const float*)d_in[5]; a.w_out_ab = (const float*)d_in[6]; a.w_in_c = (const float*)d_in[7]; a.c_ln_g = (const float*)d_in[8]; a.c_ln_b = (const float*)d_in[9];
    a.c_ws = (const float*)d_in[10]; a.c_bs = (const float*)d_in[11]; a.w_out_c = (const float*)d_in[12]; a.w_gate = (const float*)d_in[13]; a.w_up = (const float*)d_in[14];
    a.w_down = (const float*)d_in[15]; a.ln_mix_g = (const float*)d_in[16]; a.ln_mix_b = (const float*)d_in[17]; a.ln_ffn_g = (const float*)d_in[18]; a.ln_ffn_b = (const float*)d_in[19];
    a.out = (float*)d_out; a.ws = (unsigned char*)d_ws;
    hipLaunchKernelGGL(fwd_kernel, dim3(grid), dim3(NTHR), LDS_BYTES, stream, a);
}
```

```cpp
#include <hip/hip_runtime.h>
#include <cstdio>
#include <cstdint>

#ifndef NAIVE_HGRN
#define NAIVE_HGRN 0
#endif
#ifndef NAIVE_ATTN
#define NAIVE_ATTN 0
#endif
#ifndef REP_G
#define REP_G 1
#endif
#ifndef REP_HA
#define REP_HA 1
#endif
#ifndef REP_ATT
#define REP_ATT 1
#endif
#ifndef REP_HBC
#define REP_HBC 1
#endif
#ifndef NAIVE_SGU
#define NAIVE_SGU 0
#endif

__device__ __forceinline__ int tid_from_wave(int wave_s) { return wave_s * 64 + (int)__builtin_amdgcn_mbcnt_hi(~0u, __builtin_amdgcn_mbcnt_lo(~0u, 0u)); }
namespace pg8 {
#define PG8_LAS __attribute__((address_space(3)))
typedef unsigned short bf16_t;
typedef short bf16x8 __attribute__((ext_vector_type(8)));
typedef _Float16 f16x8 __attribute__((ext_vector_type(8)));
typedef _Float16 f16x2 __attribute__((ext_vector_type(2)));
typedef float f32x4 __attribute__((ext_vector_type(4)));
typedef float f32x2 __attribute__((ext_vector_type(2)));
typedef unsigned u32x4 __attribute__((ext_vector_type(4)));
typedef unsigned u32x2 __attribute__((ext_vector_type(2)));
constexpr int BM = 256, BK = 64, HALF = 128, HTB = HALF * BK * 2, STAGE_BYTES = 8 * HTB, NXCD = 8, WGM = 8;

__host__ __device__ __forceinline__ int lds_byte(int r, int c) { const int st = (r >> 4) * 2 + (c >> 5), rr = r & 15, cc = c & 31, ob = rr * 64 + cc * 2; return st * 1024 + (ob ^ (((ob >> 9) & 1) << 5)); }
__host__ __device__ __forceinline__ void stage_rc(int b, int& R, int& C) { const int st = b / 1024, sb = b % 1024, swz = sb ^ (((sb >> 9) & 1) << 5); R = (st >> 1) * 16 + swz / 64; C = (st & 1) * 32 + (swz % 64) / 2; }
__host__ __device__ __forceinline__ int perm32(int rho) { const int n = rho >> 4, i = rho & 15; return 8 * (i >> 2) + 4 * n + (i & 3); }

struct Unit { int pm, pn; };
struct Gemm { const bf16_t* A; const bf16_t* Bt; int M, N, K; };

struct StaticOrder {
    int nM, nN, nwg, G, c; bool rev;
    __host__ __device__ void init(int M, int N, int G_, int c_, bool rev_ = false) { nM = M / BM; nN = N / BM; nwg = nM * nN; G = G_; c = c_; rev = rev_; }
    __host__ __device__ bool next(int i, Unit& u) const {
        const long L = (long)i * G + c; if (L >= nwg) return false;
        int wgid = (int)L; { const int q = nwg / NXCD, r = nwg % NXCD, xcd = wgid % NXCD, off = wgid / NXCD, cnt = xcd < r ? q + 1 : q; wgid = (xcd < r ? xcd * (q + 1) : r * (q + 1) + (xcd - r) * q) + (rev ? cnt - 1 - off : off); }
        const int nig = WGM * nN, gid = wgid / nig, fm = gid * WGM, gsz = (nM - fm) < WGM ? (nM - fm) : WGM;
        u.pm = fm + ((wgid % nig) % gsz); u.pn = (wgid % nig) / gsz; return true;
    }
    __device__ __forceinline__ void a_ready(const Unit&) const {}
    __device__ __forceinline__ void done(const Unit&) const {}
};

typedef __bf16 bf16x2_t __attribute__((ext_vector_type(2)));
__device__ __forceinline__ unsigned cvt_pk_bf16(float lo, float hi) { bf16x2_t v = {(__bf16)lo, (__bf16)hi}; return __builtin_bit_cast(unsigned, v); }
__device__ __forceinline__ f32x2 gelu_pk(f32x2 v) {
    const f32x2 av = __builtin_elementwise_abs(v), d = av * 0.2316418882f + 1.0f;
    f32x2 t; t.x = __builtin_amdgcn_rcpf(d.x); t.y = __builtin_amdgcn_rcpf(d.y);
    f32x2 q = t * 0.5307027145f + (-0.7265760135f); q = q * t + 0.7107068705f; q = q * t + (-0.142248368f); q = q * t + 0.127414796f; q = q * t;
    const f32x2 s = (v * v) * (-0.72134752044f);
    f32x2 e; e.x = __builtin_amdgcn_exp2f(s.x); e.y = __builtin_amdgcn_exp2f(s.y);
    const f32x2 m = v * (q * e), r = v - m;
    f32x2 o; o.x = v.x < 0.f ? m.x : r.x; o.y = v.y < 0.f ? m.y : r.y; return o;
}

constexpr float LN_EPS = 1e-5f;
__device__ __forceinline__ void row_mu_rstd(const float* stat, int row, float& mu, float& rstd) {
    const f32x4* p = (const f32x4*)(stat + (size_t)row * 32);
    f32x4 v[8]; float ms = 0.f;
#pragma unroll
    for (int i = 0; i < 8; ++i) { v[i] = p[i]; ms += v[i][0] + v[i][2]; }
    const float mean = ms * (1.0f / 16.0f); float q = 0.f;
#pragma unroll
    for (int i = 0; i < 8; ++i) { const float d0 = v[i][0] - mean, d1 = v[i][2] - mean; q += (v[i][1] + v[i][3]) + 64.0f * (d0 * d0 + d1 * d1); }
    mu = mean; rstd = __builtin_amdgcn_rsqf(q * (1.0f / 1024.0f) + LN_EPS);
}

constexpr int STAT_TAB_OFF = STAGE_BYTES;
__device__ __forceinline__ float lane_xor1(float x) { return __builtin_bit_cast(float, __builtin_amdgcn_update_dpp(0, __builtin_bit_cast(int, x), 0xB1, 0xF, 0xF, false)); }
__device__ __forceinline__ void stat_tab_build(PG8_LAS unsigned char* lds, const float* stat, int pm, int wr, int wc, int lane) {
    const int lrow = (wc >> 1) * HALF + wr * 64 + (wc & 1) * 32 + (lane >> 1);
    const f32x4* p = (const f32x4*)(stat + (size_t)(pm * BM + lrow) * 32 + (lane & 1) * 16);
    const f32x4 v0 = p[0], v1 = p[1], v2 = p[2], v3 = p[3];
    float ms = ((v0[0] + v0[2]) + (v1[0] + v1[2])) + ((v2[0] + v2[2]) + (v3[0] + v3[2])); ms += lane_xor1(ms);
    const float mean = ms * (1.0f / 16.0f);
    const float d0 = v0[0] - mean, d1 = v0[2] - mean, d2 = v1[0] - mean, d3 = v1[2] - mean, d4 = v2[0] - mean, d5 = v2[2] - mean, d6 = v3[0] - mean, d7 = v3[2] - mean;
    float q = (((v0[1] + v0[3]) + (v1[1] + v1[3])) + ((v2[1] + v2[3]) + (v3[1] + v3[3]))) + 64.0f * (((d0 * d0 + d1 * d1) + (d2 * d2 + d3 * d3)) + ((d4 * d4 + d5 * d5) + (d6 * d6 + d7 * d7)));
    q += lane_xor1(q);
    const float rstd = __builtin_amdgcn_rsqf(q * (1.0f / 1024.0f) + LN_EPS);
    if ((lane & 1) == 0) *(PG8_LAS f32x2*)(lds + STAT_TAB_OFF + lrow * 8) = (f32x2){mean, rstd};
    asm volatile("s_waitcnt lgkmcnt(0)" ::: "memory");
    __builtin_amdgcn_s_barrier();
}
__device__ __forceinline__ void stat_tab_get(PG8_LAS unsigned char* lds, int lrow, float& mu, float& rstd) { const f32x2 t = *(const PG8_LAS f32x2*)(lds + STAT_TAB_OFF + lrow * 8); mu = t.x; rstd = t.y; }
#define RG_ROW(rg) (row0 + ((rg) >> 2) * HALF + ((rg) & 3) * 16)

struct EpiZ {
    static constexpr bool PERM = true, AFTER_DRAIN = false;
    bf16_t* O; int ldc; const float* stat; const float* gW; const float* bW;
    __device__ __forceinline__ void operator()(const f32x4 (&acc)[2][2][4][2], const Unit& u, int wr, int wc, int fr, int fq, PG8_LAS unsigned char* lds, bool tab_valid) const {
        const int row0 = u.pm * BM + wr * 64 + fr, col0 = u.pn * BM + wc * 32 + 8 * fq;
        f32x4 gv[2][2], bv[2][2];
#pragma unroll
        for (int bj = 0; bj < 2; ++bj)
#pragma unroll
            for (int n = 0; n < 2; ++n) { gv[bj][n] = stat ? *(const f32x4*)(gW + col0 + bj * HALF + 4 * n) : (f32x4){0.f, 0.f, 0.f, 0.f}; bv[bj][n] = stat ? *(const f32x4*)(bW + col0 + bj * HALF + 4 * n) : (f32x4){0.f, 0.f, 0.f, 0.f}; }
        if (stat && !tab_valid) stat_tab_build(lds, stat, u.pm, wr, wc, fr + 16 * fq);
#pragma unroll
        for (int rg = 0; rg < 8; ++rg) { const int ai = rg >> 2, m = rg & 3; const int row = RG_ROW(rg); bf16_t* rowp = O + (size_t)row * ldc + col0;
                float mu = 0.f, rstd = 1.f; if (stat) stat_tab_get(lds, row - u.pm * BM, mu, rstd);
#pragma unroll
                for (int bj = 0; bj < 2; ++bj) { const f32x4 v0 = (acc[ai][bj][m][0] - mu * gv[bj][0]) * rstd + bv[bj][0], v1 = (acc[ai][bj][m][1] - mu * gv[bj][1]) * rstd + bv[bj][1];
                    u32x4 w; w.x = cvt_pk_bf16(v0[0], v0[1]); w.y = cvt_pk_bf16(v0[2], v0[3]); w.z = cvt_pk_bf16(v1[0], v1[1]); w.w = cvt_pk_bf16(v1[2], v1[3]);
                    *(u32x4*)(rowp + bj * HALF) = w; }
                asm volatile("" ::: "memory"); }
    }
};
struct EpiGeluUV {
    static constexpr bool PERM = true, AFTER_DRAIN = false;
    bf16_t* U; bf16_t* V; float* vstat; const float* stat; const float* gW; const float* bW;
    __device__ __forceinline__ void operator()(const f32x4 (&acc)[2][2][4][2], const Unit& u, int wr, int wc, int fr, int fq, PG8_LAS unsigned char* lds, bool tab_valid) const {
        const int row0 = u.pm * BM + wr * 64 + fr, col0 = u.pn * BM + wc * 32 + 8 * fq;
        const bool isv = u.pn >= 8; bf16_t* base = isv ? V : U; const int ocol0 = col0 - (isv ? 2048 : 0);
        f32x4 gv[2][2], bv[2][2];
#pragma unroll
        for (int bj = 0; bj < 2; ++bj)
#pragma unroll
            for (int n = 0; n < 2; ++n) { gv[bj][n] = *(const f32x4*)(gW + col0 + bj * HALF + 4 * n); bv[bj][n] = *(const f32x4*)(bW + col0 + bj * HALF + 4 * n); }
        if (!tab_valid) stat_tab_build(lds, stat, u.pm, wr, wc, fr + 16 * fq);
#pragma unroll
        for (int rg = 0; rg < 8; ++rg) { const int ai = rg >> 2, m = rg & 3; const int row = RG_ROW(rg); bf16_t* rowp = base + (size_t)row * 2048 + ocol0;
                float mu, rstd; stat_tab_get(lds, row - u.pm * BM, mu, rstd);
                f32x4 y[2][2];
#pragma unroll
                for (int bj = 0; bj < 2; ++bj) {
#pragma unroll
                    for (int n = 0; n < 2; ++n) { const f32x4 z = (acc[ai][bj][m][n] - mu * gv[bj][n]) * rstd + bv[bj][n];
                        const f32x2 a = gelu_pk((f32x2){z[0], z[1]}), b = gelu_pk((f32x2){z[2], z[3]}); y[bj][n] = (f32x4){a.x, a.y, b.x, b.y}; }
                    u32x4 w; w.x = cvt_pk_bf16(y[bj][0][0], y[bj][0][1]); w.y = cvt_pk_bf16(y[bj][0][2], y[bj][0][3]); w.z = cvt_pk_bf16(y[bj][1][0], y[bj][1][1]); w.w = cvt_pk_bf16(y[bj][1][2], y[bj][1][3]);
                    *(u32x4*)(rowp + bj * HALF) = w; }
                if (isv) {
                    float s = 0.f;
#pragma unroll
                    for (int bj = 0; bj < 2; ++bj)
#pragma unroll
                        for (int n = 0; n < 2; ++n) s += (y[bj][n][0] + y[bj][n][1]) + (y[bj][n][2] + y[bj][n][3]);
                    s += __shfl_xor(s, 16); s += __shfl_xor(s, 32);
                    const float mw = s * (1.0f / 64.0f); float q = 0.f;
#pragma unroll
                    for (int bj = 0; bj < 2; ++bj)
#pragma unroll
                        for (int n = 0; n < 2; ++n) { const f32x4 d = y[bj][n] - mw; q += (d[0] * d[0] + d[1] * d[1]) + (d[2] * d[2] + d[3] * d[3]); }
                    q += __shfl_xor(q, 16); q += __shfl_xor(q, 32);
                    if (fq == 0) *(f32x2*)(vstat + ((size_t)row * 32 + (u.pn - 8) * 4 + wc) * 2) = (f32x2){mw, q};
                }
                asm volatile("" ::: "memory"); }
    }
};
__device__ __forceinline__ float silu_e(float x) { return x * __builtin_amdgcn_rcpf(1.0f + __expf(-x)); }
struct EpiSwiglu {
    static constexpr bool PERM = true, AFTER_DRAIN = false;
    bf16_t* H; const float* stat; const float* gW; const float* bW;
    __device__ __forceinline__ void operator()(const f32x4 (&acc)[2][2][4][2], const Unit& u, int wr, int wc, int fr, int fq, PG8_LAS unsigned char* lds, bool tab_valid) const {
        const int row0 = u.pm * BM + wr * 64 + fr, col0 = u.pn * BM + wc * 32 + 8 * fq, hcol0 = u.pn * HALF + wc * 32 + 8 * fq;
        f32x4 gv[2][2], bv[2][2];
#pragma unroll
        for (int bj = 0; bj < 2; ++bj)
#pragma unroll
            for (int n = 0; n < 2; ++n) { gv[bj][n] = *(const f32x4*)(gW + col0 + bj * HALF + 4 * n); bv[bj][n] = *(const f32x4*)(bW + col0 + bj * HALF + 4 * n); }
        if (!tab_valid) stat_tab_build(lds, stat, u.pm, wr, wc, fr + 16 * fq);
#pragma unroll
        for (int rg = 0; rg < 8; ++rg) { const int ai = rg >> 2, m = rg & 3; const int row = RG_ROW(rg);
                float mu, rstd; stat_tab_get(lds, row - u.pm * BM, mu, rstd);
                f32x4 h[2];
#pragma unroll
                for (int n = 0; n < 2; ++n) { const f32x4 g = (acc[ai][0][m][n] - mu * gv[0][n]) * rstd + bv[0][n], up = (acc[ai][1][m][n] - mu * gv[1][n]) * rstd + bv[1][n];
#pragma unroll
                    for (int j = 0; j < 4; ++j) h[n][j] = silu_e(g[j]) * up[j]; }
                u32x4 w; w.x = cvt_pk_bf16(h[0][0], h[0][1]); w.y = cvt_pk_bf16(h[0][2], h[0][3]); w.z = cvt_pk_bf16(h[1][0], h[1][1]); w.w = cvt_pk_bf16(h[1][2], h[1][3]);
                *(u32x4*)(H + (size_t)row * 2816 + hcol0) = w;
                asm volatile("" ::: "memory"); }
    }
};
__device__ __forceinline__ f32x4 f16x4_to_f32(const u32x2 w) { const unsigned wx = w.x, wy = w.y;
    const f16x2 a = __builtin_bit_cast(f16x2, wx), b = __builtin_bit_cast(f16x2, wy); return (f32x4){(float)a.x, (float)a.y, (float)b.x, (float)b.y}; }
__device__ __forceinline__ unsigned cvt_pk_f16(float lo, float hi) { f16x2 t; t.x = (_Float16)lo; t.y = (_Float16)hi; return __builtin_bit_cast(unsigned, t); }
template <bool F32IN>
struct EpiResid {
    static constexpr bool PERM = true, AFTER_DRAIN = false;
    const float* Xa; const float* Xb; float* out; bf16_t* xb; float* statOut; const float* stat; const float* lg; const float* lb; float alpha;
    __device__ __forceinline__ void operator()(const f32x4 (&acc)[2][2][4][2], const Unit& u, int wr, int wc, int fr, int fq, PG8_LAS unsigned char* lds, bool tab_valid) const {
        const int row0 = u.pm * BM + wr * 64 + fr, col0 = u.pn * BM + wc * 32 + 8 * fq;
        f32x4 gv[2][2], bv[2][2];
        if constexpr (!F32IN) {
#pragma unroll
            for (int bj = 0; bj < 2; ++bj)
#pragma unroll
                for (int n = 0; n < 2; ++n) { gv[bj][n] = *(const f32x4*)(lg + col0 + bj * HALF + 4 * n); bv[bj][n] = *(const f32x4*)(lb + col0 + bj * HALF + 4 * n); }
        }
        const bf16_t* qbase = xb + (size_t)row0 * 1024 + col0;
        u32x4 xq[2][2];
#pragma unroll
        for (int bj = 0; bj < 2; ++bj) xq[0][bj] = *(const u32x4*)(qbase + bj * HALF);
        if constexpr (!F32IN) { if (!tab_valid) stat_tab_build(lds, stat, u.pm, wr, wc, fr + 16 * fq); }
#pragma unroll
        for (int rg = 0; rg < 8; ++rg) { const int ai = rg >> 2, m = rg & 3; const int row = RG_ROW(rg);
                if (rg < 7) { const size_t ro = (size_t)((((rg + 1) >> 2) * HALF + ((rg + 1) & 3) * 16)) * 1024;
#pragma unroll
                    for (int bj = 0; bj < 2; ++bj) xq[(rg + 1) & 1][bj] = *(const u32x4*)(qbase + ro + bj * HALF); }
                float mu = 0.f, rstd = 1.f; if constexpr (!F32IN) stat_tab_get(lds, row - u.pm * BM, mu, rstd);
                f32x4 y[2][2]; float s = 0.f;
#pragma unroll
                for (int bj = 0; bj < 2; ++bj)
#pragma unroll
                    for (int n = 0; n < 2; ++n) { f32x4 xin;
                        { const u32x4 w4 = xq[rg & 1][bj]; u32x2 w2; w2.x = n ? w4.z : w4.x; w2.y = n ? w4.w : w4.y; xin = f16x4_to_f32(w2); if constexpr (!F32IN) xin = (xin - mu) * rstd * gv[bj][n] + bv[bj][n]; }
                        y[bj][n] = alpha * xin + acc[ai][bj][m][n]; s += (y[bj][n][0] + y[bj][n][1]) + (y[bj][n][2] + y[bj][n][3]); }
                s += __shfl_xor(s, 16); s += __shfl_xor(s, 32);
                const float mw = s * (1.0f / 64.0f); float q = 0.f;
#pragma unroll
                for (int bj = 0; bj < 2; ++bj) {
#pragma unroll
                    for (int n = 0; n < 2; ++n) { const f32x4 d = y[bj][n] - mw; q += (d[0] * d[0] + d[1] * d[1]) + (d[2] * d[2] + d[3] * d[3]);
                        if (out) *(f32x4*)(out + (size_t)row * 1024 + col0 + bj * HALF + 4 * n) = y[bj][n]; }
                    u32x4 w; w.x = cvt_pk_f16(y[bj][0][0], y[bj][0][1]); w.y = cvt_pk_f16(y[bj][0][2], y[bj][0][3]); w.z = cvt_pk_f16(y[bj][1][0], y[bj][1][1]); w.w = cvt_pk_f16(y[bj][1][2], y[bj][1][3]);
                    *(u32x4*)(xb + (size_t)row * 1024 + col0 + bj * HALF) = w; }
                q += __shfl_xor(q, 16); q += __shfl_xor(q, 32);
                if (fq == 0) *(f32x2*)(statOut + ((size_t)row * 16 + u.pn * 4 + wc) * 2) = (f32x2){mw, q};
                asm volatile("" ::: "memory"); }
    }
};

template <class Epi, class Sched, bool ALIGN_EPI = false, bool SP2 = false, bool F16 = false>
__device__ __forceinline__ void gemm_phase(PG8_LAS unsigned char* lds, const Gemm g, const Sched& S, const Epi& E, int wave_s) {
    int tid_ = tid_from_wave(wave_s); asm volatile("" : "+v"(tid_));
    const int tid = tid_, wid = __builtin_amdgcn_readfirstlane(tid >> 6), lane = tid & 63, wr = wid >> 2, wc = wid & 3, fr = lane & 15, fq = lane >> 4;
    const int K = g.K, nt = K / BK;
    unsigned voffA[2], voffB[2];
#pragma unroll
    for (int i = 0; i < 2; ++i) { int R, C; stage_rc(tid * 16 + i * 8192, R, C); const int Rb = Epi::PERM ? ((R & ~31) + perm32(R & 31)) : R;
        voffA[i] = (unsigned)(R * K + C) * 2u; voffB[i] = (unsigned)(Rb * K + C) * 2u; }
    const size_t kstep = (size_t)(BK * 2);
    const size_t hstep = (size_t)HALF * K * 2;
    const size_t tstep = 2 * hstep;
    const unsigned ldsw = (unsigned)wid * 1024u;
    const int aoff = lds_byte(wr * 64 + fr, fq * 8), boff = lds_byte(wc * 32 + fr, fq * 8);
#define PG8_SA(b, h) (((b) * 2 + (h)) * HTB)
#define PG8_SB(b, h) ((4 + (b) * 2 + (h)) * HTB)
#define PG8_STAGE(bufoff, gbase, voff) do { _Pragma("unroll") for (int _i = 0; _i < 2; ++_i) \
        __builtin_amdgcn_global_load_lds((const unsigned*)((const char*)(gbase) + (voff)[_i]), (PG8_LAS unsigned*)(lds + (bufoff) + ldsw + _i * 8192), 16, 0, 0); } while (0)
#define PG8_LDA(dst, b, h) do { _Pragma("unroll") for (int m = 0; m < 4; ++m) _Pragma("unroll") for (int k = 0; k < 2; ++k) dst[m][k] = *(const PG8_LAS bf16x8*)(lds + PG8_SA(b, h) + aoff + m * 2048 + k * 1024); } while (0)
#define PG8_LDB(dst, b, h) do { _Pragma("unroll") for (int n = 0; n < 2; ++n) _Pragma("unroll") for (int k = 0; k < 2; ++k) dst[n][k] = *(const PG8_LAS bf16x8*)(lds + PG8_SB(b, h) + boff + n * 2048 + k * 1024); } while (0)
#define PG8_MMA(ai, bj, At, Bt) do { __builtin_amdgcn_s_setprio(1); _Pragma("unroll") for (int m = 0; m < 4; ++m) _Pragma("unroll") for (int n = 0; n < 2; ++n) _Pragma("unroll") for (int k = 0; k < 2; ++k) \
        { if constexpr (F16) acc[ai][bj][m][n] = __builtin_amdgcn_mfma_f32_16x16x32_f16(__builtin_bit_cast(f16x8, Bt[n][k]), __builtin_bit_cast(f16x8, At[m][k]), acc[ai][bj][m][n], 0, 0, 0); \
          else acc[ai][bj][m][n] = __builtin_amdgcn_mfma_f32_16x16x32_bf16(Bt[n][k], At[m][k], acc[ai][bj][m][n], 0, 0, 0); } __builtin_amdgcn_s_setprio(0); } while (0)
#define PG8_WAIT_V(n) asm volatile("s_waitcnt vmcnt(" #n ")" ::: "memory")
#define PG8_WAIT_L(n) asm volatile("s_waitcnt lgkmcnt(" #n ")" ::: "memory")
#define PG8_BAR __builtin_amdgcn_s_barrier()
#define PG8_SCHED __builtin_amdgcn_sched_barrier(0)
    Unit cur, nxt; int ui = 0, tab_pm = -1;
    if (!S.next(0, cur)) return;
    f32x4 acc[2][2][4][2];
#pragma unroll
    for (int a = 0; a < 2; ++a)
#pragma unroll
        for (int b = 0; b < 2; ++b)
#pragma unroll
            for (int m = 0; m < 4; ++m)
#pragma unroll
                for (int n = 0; n < 2; ++n) acc[a][b][m][n] = (f32x4){0.f, 0.f, 0.f, 0.f};
    bf16x8 At[4][2], B0[2][2], B1[2][2];
    const char* cA = (const char*)g.A + (size_t)cur.pm * tstep; const char* cB = (const char*)g.Bt + (size_t)cur.pn * tstep;
    S.a_ready(cur);
    if constexpr (SP2) {
        PG8_STAGE(PG8_SB(0, 0), cB, voffB); PG8_STAGE(PG8_SB(0, 1), cB + hstep, voffB); PG8_STAGE(PG8_SA(0, 0), cA, voffA); PG8_STAGE(PG8_SA(0, 1), cA + hstep, voffA);
        if (wr == 1) PG8_BAR;
        PG8_WAIT_V(2); PG8_BAR;
        PG8_STAGE(PG8_SB(1, 0), cB + kstep, voffB); PG8_STAGE(PG8_SA(1, 0), cA + kstep, voffA); PG8_STAGE(PG8_SB(1, 1), cB + hstep + kstep, voffB);
        PG8_WAIT_V(6); PG8_BAR;
    } else {
        PG8_STAGE(PG8_SB(0, 0), cB, voffB); PG8_STAGE(PG8_SA(0, 0), cA, voffA); PG8_STAGE(PG8_SB(0, 1), cB + hstep, voffB); PG8_STAGE(PG8_SA(0, 1), cA + hstep, voffA);
        if (wr == 1) PG8_BAR;
        PG8_WAIT_V(4); PG8_BAR;
        PG8_STAGE(PG8_SB(1, 0), cB + kstep, voffB); PG8_STAGE(PG8_SA(1, 0), cA + kstep, voffA); PG8_STAGE(PG8_SB(1, 1), cB + hstep + kstep, voffB);
        PG8_WAIT_V(6); PG8_BAR;
    }
    for (;;) {
        const bool has_next = S.next(ui + 1, nxt);
        const char* nA = has_next ? (const char*)g.A + (size_t)nxt.pm * tstep : cA; const char* nB = has_next ? (const char*)g.Bt + (size_t)nxt.pn * tstep : cB;
        for (int t = 0; t < nt; t += 2) {
            const bool last = (t == nt - 2);
            const char* a1 = cA + (size_t)(t + 1) * kstep;
            const char* a2 = last ? nA : cA + (size_t)(t + 2) * kstep; const char* b2 = last ? nB : cB + (size_t)(t + 2) * kstep;
            const char* a3 = a2 + kstep; const char* b3 = b2 + kstep;
            if (last && has_next) S.a_ready(nxt);
            if constexpr (SP2) {
            PG8_LDB(B0, 0, 0); PG8_LDB(B1, 0, 1); PG8_SCHED; PG8_LDA(At, 0, 0); PG8_STAGE(PG8_SA(1, 1), a1 + hstep, voffA);
            PG8_WAIT_V(8); PG8_WAIT_L(0); PG8_BAR; PG8_MMA(0, 0, At, B0); PG8_MMA(0, 1, At, B1); PG8_BAR; PG8_SCHED;
            PG8_LDA(At, 0, 1); PG8_STAGE(PG8_SB(0, 0), b2, voffB); PG8_STAGE(PG8_SB(0, 1), b2 + hstep, voffB); PG8_STAGE(PG8_SA(0, 0), a2, voffA);
            PG8_WAIT_V(8); PG8_WAIT_L(0); PG8_BAR; PG8_MMA(1, 0, At, B0); PG8_MMA(1, 1, At, B1); PG8_BAR; PG8_SCHED;
            PG8_LDB(B0, 1, 0); PG8_LDB(B1, 1, 1); PG8_SCHED; PG8_LDA(At, 1, 0); PG8_STAGE(PG8_SA(0, 1), a2 + hstep, voffA);
            PG8_WAIT_V(8); PG8_WAIT_L(0); PG8_BAR; PG8_MMA(0, 0, At, B0); PG8_MMA(0, 1, At, B1); PG8_BAR; PG8_SCHED;
            PG8_LDA(At, 1, 1); PG8_STAGE(PG8_SB(1, 0), b3, voffB); PG8_STAGE(PG8_SB(1, 1), b3 + hstep, voffB); PG8_STAGE(PG8_SA(1, 0), a3, voffA);
            PG8_WAIT_V(8); PG8_WAIT_L(0); PG8_BAR; PG8_MMA(1, 0, At, B0); PG8_MMA(1, 1, At, B1); PG8_BAR; PG8_SCHED;
            } else {
            PG8_LDB(B0, 0, 0); PG8_SCHED; PG8_LDA(At, 0, 0); PG8_STAGE(PG8_SA(1, 1), a1 + hstep, voffA);
            PG8_WAIT_L(8); PG8_BAR; PG8_WAIT_L(0); PG8_MMA(0, 0, At, B0); PG8_BAR; PG8_SCHED;
            PG8_LDB(B1, 0, 1); PG8_STAGE(PG8_SB(0, 0), b2, voffB);
            PG8_BAR; PG8_WAIT_L(0); PG8_MMA(0, 1, At, B1); PG8_BAR;
            PG8_LDA(At, 0, 1); PG8_STAGE(PG8_SA(0, 0), a2, voffA);
            PG8_BAR; PG8_WAIT_L(0); PG8_MMA(1, 0, At, B0); PG8_BAR; PG8_SCHED;
            PG8_STAGE(PG8_SB(0, 1), b2 + hstep, voffB);
            PG8_WAIT_V(6); PG8_BAR; PG8_MMA(1, 1, At, B1); PG8_BAR;
            PG8_LDB(B0, 1, 0); PG8_SCHED; PG8_LDA(At, 1, 0); PG8_STAGE(PG8_SA(0, 1), a2 + hstep, voffA);
            PG8_WAIT_L(8); PG8_BAR; PG8_WAIT_L(0); PG8_MMA(0, 0, At, B0); PG8_BAR; PG8_SCHED;
            PG8_LDB(B1, 1, 1); PG8_STAGE(PG8_SB(1, 0), b3, voffB);
            PG8_BAR; PG8_WAIT_L(0); PG8_MMA(0, 1, At, B1); PG8_BAR;
            PG8_LDA(At, 1, 1); PG8_STAGE(PG8_SA(1, 0), a3, voffA);
            PG8_BAR; PG8_WAIT_L(0); PG8_MMA(1, 0, At, B0); PG8_BAR; PG8_SCHED;
            PG8_STAGE(PG8_SB(1, 1), b3 + hstep, voffB);
            PG8_WAIT_V(6); PG8_BAR; PG8_MMA(1, 1, At, B1); PG8_BAR;
            }
        }
        if constexpr (ALIGN_EPI) { if (wr == 0) PG8_BAR; }
        if constexpr (!Epi::AFTER_DRAIN) { E(acc, cur, wr, wc, fr, fq, lds, cur.pm == tab_pm); tab_pm = cur.pm; S.done(cur); }
        if (!has_next) break;
#pragma unroll
        for (int a = 0; a < 2; ++a)
#pragma unroll
            for (int b = 0; b < 2; ++b)
#pragma unroll
                for (int m = 0; m < 4; ++m)
#pragma unroll
                    for (int n = 0; n < 2; ++n) acc[a][b][m][n] = (f32x4){0.f, 0.f, 0.f, 0.f};
        cur = nxt; cA = nA; cB = nB; ++ui;
        if constexpr (ALIGN_EPI) { if (wr == 1) PG8_BAR; }
    }
    PG8_WAIT_V(0);
    if constexpr (!ALIGN_EPI) { if (wr == 0) PG8_BAR; }
    PG8_BAR;
#undef PG8_SA
#undef PG8_SB
#undef PG8_STAGE
#undef PG8_LDA
#undef PG8_LDB
#undef PG8_MMA
#undef PG8_WAIT_V
#undef PG8_WAIT_L
#undef PG8_BAR
#undef PG8_SCHED
}
}

__device__ __forceinline__ float silu_f(float x) { return x * __builtin_amdgcn_rcpf(1.0f + __expf(-x)); }
constexpr int NWAVES = 8, NTHR = 512;
constexpr int D = 1024, MP = 65536, MS = 16384, M = MP + MS;
constexpr int AW = 512, NZ = 3328, FF = 2816, CW = 2048;
constexpr int ZQ = 0, ZFF = 512, ZFB = 1024, ZI = 1536, ZG = 2048, ZQB = 2560, ZKB = 3072, ZVB = 3200;
constexpr float ALPHA = 1.681792830507429f, RMS_EPS = 1e-6f;
__device__ __forceinline__ int seq_start(int t) { return t < MP ? (t & ~2047) : MP; }
__device__ __forceinline__ int seq_end(int t) { return t < MP ? (t & ~2047) + 2048 : M; }

constexpr size_t MiB = 1u << 20;
constexpr size_t WS_CTL = 0, CTL_ZERO_BYTES = 64 * 1024;
constexpr size_t WS_SMALL = 1 * MiB;
constexpr size_t SM_LB = 0;
constexpr size_t SM_GW_AB1 = 4096, SM_BW_AB1 = SM_GW_AB1 + 3328;
constexpr size_t SM_GW_C = SM_BW_AB1 + 3328;
constexpr size_t SM_BW_C = SM_GW_C + 2 * 4096;
constexpr size_t SM_GW_GU = SM_BW_C + 2 * 4096;
constexpr size_t SM_BW_GU = SM_GW_GU + 4 * 5632;
constexpr size_t SM_RSW = SM_BW_GU + 4 * 5632;
constexpr size_t SM_TDEC = SM_RSW + 2048;
constexpr size_t SM_END = SM_TDEC + 1280 * 128;
constexpr int FOLD_N = (int)(SM_RSW - SM_GW_AB1);
constexpr size_t WS_PF = 3 * MiB + 512 * 1024;
static_assert(WS_PF + 16ull * FOLD_N * 4 <= 8 * MiB, "fold partials");
static_assert(SM_END * 4 <= 2 * MiB, "small region");
constexpr size_t WS_WSB = 3 * MiB;
constexpr size_t WS_STATMIX = 8 * MiB, WS_STATFFN = 18 * MiB, WS_VSTAT = 28 * MiB;
constexpr size_t WS_W = 48 * MiB;
constexpr size_t W_INAB = 0, W_OUTAB = W_INAB + 2ull * NZ * D, W_INC = W_OUTAB + 2ull * D * D, W_OUTC = W_INC + 2ull * 4096 * D, W_GU = W_OUTC + 2ull * D * CW, W_DN = W_GU + 4ull * 2 * FF * D, W_END = W_DN + 4ull * D * FF;
static_assert(W_END * 2 <= 108 * MiB, "weights");
constexpr size_t WS_XB = 156 * MiB;
constexpr size_t WS_Z = 316 * MiB;
constexpr size_t WS_R1 = 836 * MiB;
constexpr size_t WS_OB = WS_R1, WS_QT = WS_R1 + 160 * MiB;
constexpr size_t WS_F = 1156 * MiB, WS_SIN = 1236 * MiB, WS_END = 1276 * MiB;

constexpr int LDS_BYTES = 163840;
constexpr int MISC_OFF = 163840 - 256;

#define GAS __attribute__((address_space(1)))
#define LAS __attribute__((address_space(3)))
typedef unsigned short bf16;
typedef unsigned v4u __attribute__((ext_vector_type(4)));
typedef unsigned v2u __attribute__((ext_vector_type(2)));
typedef float f32x4 __attribute__((ext_vector_type(4)));
typedef short bf16x8 __attribute__((ext_vector_type(8)));
typedef GAS unsigned gu32;
#define RLX_AGENT __ATOMIC_RELAXED, __HIP_MEMORY_SCOPE_AGENT
#define LDS_WAIT() asm volatile("s_waitcnt lgkmcnt(0)" ::: "memory")
#define LDS_SYNC() do { asm volatile("s_waitcnt lgkmcnt(0)" ::: "memory"); __builtin_amdgcn_s_barrier(); asm volatile("" ::: "memory"); } while (0)
#define VM_WAIT() asm volatile("s_waitcnt vmcnt(0)" ::: "memory")
__device__ __forceinline__ unsigned f2bf(float f) { unsigned u = __builtin_bit_cast(unsigned, f); return (u + 0x7fffu + ((u >> 16) & 1u)) >> 16; }
__device__ __forceinline__ unsigned pk2(float lo, float hi) { return f2bf(lo) | (f2bf(hi) << 16); }
__device__ __forceinline__ unsigned pk2h(float lo, float hi) { pg8::f16x2 t; t.x = (_Float16)lo; t.y = (_Float16)hi; return __builtin_bit_cast(unsigned, t); }
__device__ __forceinline__ float bf2f(unsigned short b) { return __builtin_bit_cast(float, (unsigned)b << 16); }
__device__ __forceinline__ float bflo(unsigned w) { return __builtin_bit_cast(float, w << 16); }
__device__ __forceinline__ float bfhi(unsigned w) { return __builtin_bit_cast(float, w & 0xffff0000u); }

#define XB_TMO      128
#define XB_XCNT(j)  (256  + 64 * (j))
#define XB_XSUB(j)  (1280 + 64 * (j))
#define XB_XGEN(j)  (2304 + 64 * (j))
#define XB_TOP      3328
#define XB_TOPGEN   3392
#define XCD_BAR_WORDS 3456
#define XB_SPIN_CAP (1u << 22)
__device__ __forceinline__ unsigned xb_ld(unsigned* p)              { return __hip_atomic_load(p, __ATOMIC_RELAXED, __HIP_MEMORY_SCOPE_AGENT); }
__device__ __forceinline__ unsigned xb_add(unsigned* p, unsigned v) { return __hip_atomic_fetch_add(p, v, __ATOMIC_RELAXED, __HIP_MEMORY_SCOPE_AGENT); }
__device__ __forceinline__ unsigned xb_xcc_id() { return (unsigned)__builtin_amdgcn_s_getreg((3 << 11) | 20) & 0xFu; }
#define XB_SPIN(cond, bar) do { unsigned _sp = 0; while (cond) { __builtin_amdgcn_s_sleep(1); \
    if ((++_sp & 255u) == 0u) { if (xb_ld(&(bar)[XB_TMO])) break; if (_sp > XB_SPIN_CAP) { atomicAdd(&(bar)[XB_TMO], 1u); break; } } } } while (0)
struct XcdBarrier { unsigned* bar; unsigned x; volatile LAS unsigned* st; };
__device__ __forceinline__ XcdBarrier xcd_barrier_post(unsigned* bar, volatile LAS unsigned* st, bool is_t0) {
    XcdBarrier b; b.bar = bar; b.x = xb_xcc_id(); b.st = st;
    if (is_t0) (void)xb_add(&bar[XB_XCNT(b.x)], 1u);
    return b;
}
__device__ __forceinline__ void xcd_barrier_complete(unsigned* bar, unsigned x, unsigned& nloc, unsigned& nx) {
    const unsigned G = gridDim.x * gridDim.y * gridDim.z;
    unsigned sum, cnt, mine, sp = 0u;
    for (;;) {
        sum = 0u; cnt = 0u; mine = 0u;
#pragma unroll
        for (unsigned j = 0; j < 16; ++j) { const unsigned c = xb_ld(&bar[XB_XCNT(j)]); sum += c; cnt += (c > 0u) ? 1u : 0u; mine = (j == x) ? c : mine; }
        if (sum == G) break;
        __builtin_amdgcn_s_sleep(1);
        if ((++sp & 255u) == 0u) { if (xb_ld(&bar[XB_TMO])) break; if (sp > XB_SPIN_CAP) { atomicAdd(&bar[XB_TMO], 1u); break; } }
    }
    nloc = mine > 0u ? mine : 1u; nx = cnt > 0u ? cnt : 1u;
}
__device__ __forceinline__ void xcd_barrier(const XcdBarrier& b, bool is_t0) {
    asm volatile("s_waitcnt vmcnt(0)" ::: "memory");
    __syncthreads();
    if (is_t0) {
        unsigned* bar = b.bar;
        __builtin_amdgcn_s_waitcnt(0);
        unsigned nloc = b.st[0], nx = b.st[1];
        if (nloc == 0u) { xcd_barrier_complete(bar, b.x, nloc, nx); b.st[0] = nloc; b.st[1] = nx; }
        const unsigned old = xb_add(&bar[XB_XSUB(b.x)], 1u);
        const unsigned gen = old / nloc;
        if (old + 1u == (gen + 1u) * nloc) {
            __builtin_amdgcn_fence(__ATOMIC_RELEASE, "agent");
            asm volatile("s_waitcnt vmcnt(0)" ::: "memory");
            const unsigned og = xb_add(&bar[XB_TOP], 1u);
            const unsigned tg = og / nx;
            if (og + 1u == (tg + 1u) * nx) xb_add(&bar[XB_TOPGEN], 1u);
            else XB_SPIN(xb_ld(&bar[XB_TOPGEN]) == tg, bar);
            __builtin_amdgcn_fence(__ATOMIC_ACQUIRE, "agent");
            xb_add(&bar[XB_XGEN(b.x)], 1u);
            asm volatile("s_waitcnt vmcnt(0)" ::: "memory");
        } else {
            XB_SPIN(xb_ld(&bar[XB_XGEN(b.x)]) == gen, bar);
            __builtin_amdgcn_fence(__ATOMIC_ACQUIRE, "agent");
            asm volatile("s_waitcnt vmcnt(0)" ::: "memory");
        }
    }
    __syncthreads();
}

struct Args {
    const float* x_prompt; const float* x_sample; const float* w_in_ab; const float* lb_logits; const float* hgrn_norm_g; const float* attn_sink; const float* w_out_ab;
    const float* w_in_c; const float* c_ln_g; const float* c_ln_b; const float* c_ws; const float* c_bs; const float* w_out_c;
    const float* w_gate; const float* w_up; const float* w_down; const float* ln_mix_g; const float* ln_mix_b; const float* ln_ffn_g; const float* ln_ffn_b;
    float* out; unsigned char* ws;
};

__device__ __forceinline__ float wave_sum(float v) {
#pragma unroll
    for (int o = 1; o < 64; o <<= 1) v += __shfl_xor(v, o);
    return v;
}

__device__ __forceinline__ int rowmap(int n, int mode) { return mode == 0 ? n : (256 * (n >> 7) + (n & 127) + (mode == 2 ? 128 : 0)); }
__device__ __forceinline__ void p0_transpose_item(const float* W, int K, int N, bf16* WT, int mode, const float* scale, LAS float* scr, int item, int lane, bool f16 = false, const float* bvec = nullptr, float* pg = nullptr, float* pb = nullptr) {
    const int nblk = N / 64, kb = item / nblk, nb = item % nblk, k0 = 64 * kb, n0 = 64 * nb;
    float sg = 0.f, sb = 0.f;
    const float scv = scale ? scale[k0 + lane] : 1.0f, bvv = bvec ? bvec[k0 + lane] : 0.0f;
    float wv[64];
#pragma unroll
    for (int kk = 0; kk < 64; ++kk) wv[kk] = W[(size_t)(k0 + kk) * N + n0 + lane];
    __builtin_amdgcn_sched_barrier(0);
#pragma unroll
    for (int kk = 0; kk < 64; ++kk) { const float sc = __builtin_bit_cast(float, __builtin_amdgcn_readlane(__builtin_bit_cast(int, scv), kk)); const float w = wv[kk]; scr[kk * 65 + lane] = w * sc;
        if (pg) { sg += w * sc; sb += w * __builtin_bit_cast(float, __builtin_amdgcn_readlane(__builtin_bit_cast(int, bvv), kk)); } }
    if (pg) { const size_t o = (size_t)kb * FOLD_N + rowmap(n0 + lane, mode); pg[o] = sg; pb[o] = sb; }
    LDS_WAIT(); asm volatile("" ::: "memory");
    const int c = lane & 7;
#pragma unroll
    for (int j = 0; j < 8; ++j) { const int n = (lane >> 3) + 8 * j; const LAS float* s = scr + (8 * c) * 65 + n;
        v4u o; if (f16) { o.x = pk2h(s[0 * 65], s[1 * 65]); o.y = pk2h(s[2 * 65], s[3 * 65]); o.z = pk2h(s[4 * 65], s[5 * 65]); o.w = pk2h(s[6 * 65], s[7 * 65]); }
        else { o.x = pk2(s[0 * 65], s[1 * 65]); o.y = pk2(s[2 * 65], s[3 * 65]); o.z = pk2(s[4 * 65], s[5 * 65]); o.w = pk2(s[6 * 65], s[7 * 65]); }
        *(GAS v4u*)(WT + (size_t)rowmap(n0 + n, mode) * K + k0 + 8 * c) = o; }
    LDS_WAIT(); asm volatile("" ::: "memory");
}
__device__ __forceinline__ void p0_fold_item(const float* W, int N, const float* g, const float* b, float* gW, float* bW, int mode, int item, int lane) {
    const int n = item * 64 + lane; float sg = 0.f, sb = 0.f;
#pragma unroll 32
    for (int k = 0; k < 1024; ++k) { const float w = W[(size_t)k * N + n]; sg += g[k] * w; sb += b[k] * w; }
    gW[rowmap(n, mode)] = sg; bW[rowmap(n, mode)] = sb;
}

__device__ __forceinline__ void naive_hgrn_unit(const Args& a, int unit, int j, LAS unsigned char* lds, int wave_s) {
    const bf16* Z = (const bf16*)(a.ws + WS_Z); bf16* OP = (bf16*)a.out; const float* lbv = (const float*)(a.ws + WS_SMALL) + SM_LB + (size_t)j * 1024;
    int tid_ = tid_from_wave(wave_s); asm volatile("" : "+v"(tid_)); const int tid = tid_, grp = tid >> 7, e = tid & 127;
    int seq, h, dir;
    if (unit < 64) { const int ch = unit * 4 + grp; seq = ch >> 3; h = (ch >> 1) & 3; dir = ch & 1; } else { const int ch = (unit - 64) * 4 + grp; seq = 32; h = ch >> 1; dir = ch & 1; }
    const int t0 = seq < 32 ? seq * 2048 : MP, len = seq < 32 ? 2048 : MS;
    const float lb = lbv[dir * 512 + h * 128 + e], oml = 1.0f - lb;
    LAS float* sq = (LAS float*)lds + grp * (3 * 16 * 128); LAS float* sf = sq + 16 * 128; LAS float* sk = sf + 16 * 128;
    float S[128];
#pragma unroll
    for (int i = 0; i < 128; ++i) S[i] = 0.f;
    for (int tb = 0; tb < len; tb += 16) {
        float v[16];
#pragma unroll
        for (int i = 0; i < 16; ++i) { const int tok = dir == 0 ? t0 + tb + i : t0 + len - 1 - tb - i; const bf16* zr = Z + (size_t)tok * NZ + h * 128 + e;
            const float qr = bf2f(zr[ZQ]), fr = bf2f(zr[dir == 0 ? ZFF : ZFB]); v[i] = bf2f(zr[ZI]);
            const float sg = 1.0f / (1.0f + expf(-fr));
            sq[i * 128 + e] = qr / (1.0f + expf(-qr)); sf[i * 128 + e] = lb + oml * sg; sk[i * 128 + e] = oml * (1.0f - sg); }
        __syncthreads();
        for (int i = 0; i < 16; ++i) { const int tok = dir == 0 ? t0 + tb + i : t0 + len - 1 - tb - i; float o = 0.f; const float vi = v[0];
#pragma unroll
            for (int d4 = 0; d4 < 32; ++d4) { const f32x4 q4 = *(const LAS f32x4*)(sq + i * 128 + d4 * 4), f4 = *(const LAS f32x4*)(sf + i * 128 + d4 * 4), k4 = *(const LAS f32x4*)(sk + i * 128 + d4 * 4);
#pragma unroll
                for (int jj = 0; jj < 4; ++jj) { S[d4 * 4 + jj] = f4[jj] * S[d4 * 4 + jj] + k4[jj] * vi; o += q4[jj] * S[d4 * 4 + jj]; } }
            OP[((size_t)dir * M + tok) * 512 + h * 128 + e] = (bf16)f2bf(o);
#pragma unroll
            for (int s = 0; s < 15; ++s) v[s] = v[s + 1]; }
        __syncthreads();
    }
}
__device__ __forceinline__ void naive_hgrn_finish(const Args& a, int j, int vcu, int ngw, int wave_s) {
    int tid_ = tid_from_wave(wave_s); asm volatile("" : "+v"(tid_)); const int lane = tid_ & 63, gw = vcu * NWAVES + __builtin_amdgcn_readfirstlane(tid_ >> 6);
    const bf16* Z = (const bf16*)(a.ws + WS_Z); const bf16* OP = (const bf16*)a.out; bf16* OB = (bf16*)(a.ws + WS_OB); const float* ng = a.hgrn_norm_g + j * 128;
    for (int it = gw; it < M * 4; it += ngw) { const int tok = it >> 2, h = it & 3; const size_t o0 = (size_t)tok * 512 + h * 128 + 2 * lane;
        const unsigned w0 = *(const unsigned*)(OP + o0), w1 = *(const unsigned*)(OP + (size_t)M * 512 + o0);
        const float x0 = bflo(w0) + bflo(w1), x1 = bfhi(w0) + bfhi(w1);
        const float ss = wave_sum(x0 * x0 + x1 * x1); const float r = 1.0f / sqrtf(ss * (1.0f / 128.0f) + RMS_EPS);
        const unsigned gw2 = *(const unsigned*)(Z + (size_t)tok * NZ + ZG + h * 128 + 2 * lane); const float g0 = bflo(gw2), g1 = bfhi(gw2);
        const float y0 = x0 * r * ng[2 * lane] * (g0 / (1.0f + expf(-g0))), y1 = x1 * r * ng[2 * lane + 1] * (g1 / (1.0f + expf(-g1)));
        *(unsigned*)(OB + (size_t)tok * 1024 + h * 128 + 2 * lane) = pk2(y0, y1); }
}
__device__ __forceinline__ void naive_attn_unit(const Args& a, int unit, int j, int wave_s) {
    const bf16* Z = (const bf16*)(a.ws + WS_Z); bf16* OB = (bf16*)(a.ws + WS_OB);
    int tid_ = tid_from_wave(wave_s); asm volatile("" : "+v"(tid_)); const int tid = tid_, hq = tid & 7, t = unit * 64 + (tid >> 3), kvh = hq >> 2;
    const float slope = exp2f(-(float)(hq + 1)), sink = a.attn_sink[j * 8 + hq];
    float q[64], o[64];
    { const v4u* qp = (const v4u*)(Z + (size_t)t * NZ + ZQB + hq * 64);
#pragma unroll
      for (int i = 0; i < 8; ++i) { const v4u w = qp[i]; q[8 * i] = bflo(w.x); q[8 * i + 1] = bfhi(w.x); q[8 * i + 2] = bflo(w.y); q[8 * i + 3] = bfhi(w.y); q[8 * i + 4] = bflo(w.z); q[8 * i + 5] = bfhi(w.z); q[8 * i + 6] = bflo(w.w); q[8 * i + 7] = bfhi(w.w); } }
#pragma unroll
    for (int i = 0; i < 64; ++i) o[i] = 0.f;
    float mx = sink, l = 1.0f;
    const int s0 = seq_start(t), s1 = seq_end(t);
    for (int dlt = -128; dlt <= 128; ++dlt) { const int s = t + dlt; if (s < s0 || s >= s1) continue;
        const v4u* kp = (const v4u*)(Z + (size_t)s * NZ + ZKB + kvh * 64); float sc = 0.f;
#pragma unroll
        for (int i = 0; i < 8; ++i) { const v4u w = kp[i]; sc += q[8 * i] * bflo(w.x) + q[8 * i + 1] * bfhi(w.x) + q[8 * i + 2] * bflo(w.y) + q[8 * i + 3] * bfhi(w.y) + q[8 * i + 4] * bflo(w.z) + q[8 * i + 5] * bfhi(w.z) + q[8 * i + 6] * bflo(w.w) + q[8 * i + 7] * bfhi(w.w); }
        sc = sc * 0.125f - slope * fabsf((float)dlt);
        const float mn = fmaxf(mx, sc), cf = expf(mx - mn), p = expf(sc - mn); l = l * cf + p; mx = mn;
        const v4u* vp = (const v4u*)(Z + (size_t)s * NZ + ZVB + kvh * 64);
#pragma unroll
        for (int i = 0; i < 8; ++i) { const v4u w = vp[i]; o[8 * i] = o[8 * i] * cf + p * bflo(w.x); o[8 * i + 1] = o[8 * i + 1] * cf + p * bfhi(w.x); o[8 * i + 2] = o[8 * i + 2] * cf + p * bflo(w.y); o[8 * i + 3] = o[8 * i + 3] * cf + p * bfhi(w.y);
            o[8 * i + 4] = o[8 * i + 4] * cf + p * bflo(w.z); o[8 * i + 5] = o[8 * i + 5] * cf + p * bfhi(w.z); o[8 * i + 6] = o[8 * i + 6] * cf + p * bflo(w.w); o[8 * i + 7] = o[8 * i + 7] * cf + p * bfhi(w.w); } }
    const float inv = 1.0f / l; v4u* op = (v4u*)(OB + (size_t)t * 1024 + 512 + hq * 64);
#pragma unroll
    for (int i = 0; i < 8; ++i) { v4u w; w.x = pk2(o[8 * i] * inv, o[8 * i + 1] * inv); w.y = pk2(o[8 * i + 2] * inv, o[8 * i + 3] * inv); w.z = pk2(o[8 * i + 4] * inv, o[8 * i + 5] * inv); w.w = pk2(o[8 * i + 6] * inv, o[8 * i + 7] * inv); op[i] = w; }
}
__device__ __forceinline__ void vrow_mu_rstd(const float* vstat, int row, float& mu, float& rstd) {
    const f32x4* p = (const f32x4*)(vstat + (size_t)row * 64); float ms = 0.f; f32x4 v[16];
#pragma unroll
    for (int i = 0; i < 16; ++i) v[i] = p[i];
    __builtin_amdgcn_sched_barrier(0);
#pragma unroll
    for (int i = 0; i < 16; ++i) ms += v[i][0] + v[i][2];
    const float mean = ms * (1.0f / 32.0f); float q = 0.f;
#pragma unroll
    for (int i = 0; i < 16; ++i) { const float d0 = v[i][0] - mean, d1 = v[i][2] - mean; q += (v[i][1] + v[i][3]) + 64.0f * (d0 * d0 + d1 * d1); }
    mu = mean; rstd = 1.0f / sqrtf(q * (1.0f / 2048.0f) + pg8::LN_EPS);
}
__device__ __forceinline__ void naive_sgu_unit(const Args& a, int unit, int j, LAS unsigned char* lds, int wave_s) {
    int tid_ = tid_from_wave(wave_s); asm volatile("" : "+v"(tid_)); const int chunk = unit >> 3, g = unit & 7, tid = tid_, ch = tid & 255, half = tid >> 8;
    bf16* U = (bf16*)(a.ws + WS_Z); const bf16* V = (const bf16*)(a.ws + WS_R1); const float* vstat = (const float*)(a.ws + WS_VSTAT);
    LAS float* vn = (LAS float*)lds; LAS float* st = vn + 128 * 256;
    const int tok0 = chunk * 128;
    __syncthreads();
    if (tid < 128) { float mu, rstd; vrow_mu_rstd(vstat, tok0 + tid, mu, rstd); st[2 * tid] = mu; st[2 * tid + 1] = rstd; }
    __syncthreads();
    const float cg = a.c_ln_g[j * 2048 + g * 256 + ch], cb = a.c_ln_b[j * 2048 + g * 256 + ch];
    for (int s = half; s < 128; s += 2) vn[s * 256 + ch] = (bf2f(V[(size_t)(tok0 + s) * 2048 + g * 256 + ch]) - st[2 * s]) * st[2 * s + 1] * cg + cb;
    __syncthreads();
    const float* Wg = a.c_ws + ((size_t)(j * 8 + g) * 128) * 128;
    for (int t = half * 64; t < half * 64 + 64; ++t) { float acc = 0.f; const float* wr = Wg + (size_t)t * 128;
#pragma unroll 8
        for (int s = 0; s < 128; ++s) acc += wr[s] * vn[s * 256 + ch];
        acc += a.c_bs[(j * 8 + g) * 128 + t];
        bf16* up = U + (size_t)(tok0 + t) * 2048 + g * 256 + ch; *up = (bf16)f2bf(bf2f(*up) * acc); }
}


typedef float f32x16 __attribute__((ext_vector_type(16)));
__device__ __forceinline__ unsigned cvtpk(float lo, float hi) { return pg8::cvt_pk_bf16(lo, hi); }
__device__ __forceinline__ float max_xor32(float x) { const unsigned xi = __builtin_bit_cast(unsigned, x); const auto r = __builtin_amdgcn_permlane32_swap(xi, xi, false, false); const unsigned a = r[0], b = r[1]; return fmaxf(__builtin_bit_cast(float, a), __builtin_bit_cast(float, b)); }
__device__ __forceinline__ float sum_xor32(float x) { const unsigned xi = __builtin_bit_cast(unsigned, x); const auto r = __builtin_amdgcn_permlane32_swap(xi, xi, false, false); const unsigned a = r[0], b = r[1]; return __builtin_bit_cast(float, a) + __builtin_bit_cast(float, b); }
__device__ __forceinline__ v4u widen_pair(v2u a, v2u b) {
    const auto r0 = __builtin_amdgcn_permlane32_swap(a.x, b.x, false, false); const auto r1 = __builtin_amdgcn_permlane32_swap(a.y, b.y, false, false);
    const unsigned ax = r0[0], bx = r0[1], ay = r1[0], by = r1[1];
    return (v4u){ax, ay, bx, by};
}

__device__ __forceinline__ void sgu_unit(const Args& a, int unit, int j, LAS unsigned char* lds, int wave_s) {
    int tid_ = tid_from_wave(wave_s); asm volatile("" : "+v"(tid_)); const int tid = tid_, lane = tid & 63, wave = __builtin_amdgcn_readfirstlane(tid >> 6), l31 = lane & 31, h = lane >> 5;
    const int chunk = unit >> 3, g = unit & 7, tok0 = chunk * 128;
    bf16* U = (bf16*)(a.ws + WS_Z); const bf16* V = (const bf16*)(a.ws + WS_R1); const float* vstat = (const float*)(a.ws + WS_VSTAT);
    const bf16* Wsb = (const bf16*)(a.ws + WS_WSB) + (size_t)(j * 8 + g) * 128 * 128;
    const float* rsw = (const float*)(a.ws + WS_SMALL) + SM_RSW + (j * 8 + g) * 128; const float* bs = a.c_bs + (j * 8 + g) * 128;
    LAS float* st = (LAS float*)(lds + 65536);
    __syncthreads();
    if (tid < 128) { float mu, rstd; vrow_mu_rstd(vstat, tok0 + tid, mu, rstd); st[2 * tid] = mu; st[2 * tid + 1] = rstd; }
    __syncthreads();
#pragma unroll
    for (int it = 0; it < 8; ++it) { const int p = tid & 7, sl = (it >> 2) * 64 + (tid >> 3), c0 = (it & 3) * 64 + 8 * p;
        const v4u w = *(const v4u*)(V + (size_t)(tok0 + sl) * 2048 + g * 256 + c0); const float mu = st[2 * sl], rstd = st[2 * sl + 1];
        const unsigned ww[4] = {w.x, w.y, w.z, w.w};
#pragma unroll
        for (int i = 0; i < 8; ++i) { const int c = c0 + i; const float x = (i & 1) ? bfhi(ww[i >> 1]) : bflo(ww[i >> 1]);
            const unsigned short ob = (unsigned short)f2bf((x - mu) * rstd);
            *(LAS unsigned short*)(lds + c * 256 + ((((sl >> 3) ^ ((c ^ (c >> 3)) & 15))) << 4) + (sl & 7) * 2) = ob; } }
    __syncthreads();
    const int tt = wave & 3, cq = wave >> 2, t = 32 * tt + l31;
    bf16x8 bw[8];
#pragma unroll
    for (int kk = 0; kk < 8; ++kk) bw[kk] = *(const bf16x8*)(Wsb + (size_t)t * 128 + 16 * kk + 8 * h);
    f32x16 acc[4];
#pragma unroll
    for (int i = 0; i < 4; ++i) { acc[i] = (f32x16){0.f, 0.f, 0.f, 0.f, 0.f, 0.f, 0.f, 0.f, 0.f, 0.f, 0.f, 0.f, 0.f, 0.f, 0.f, 0.f};
        const int c = 32 * (4 * cq + i) + l31, sw = (c ^ (c >> 3)) & 15;
#pragma unroll
        for (int kk = 0; kk < 8; ++kk) { const bf16x8 af = *(const LAS bf16x8*)(lds + c * 256 + (((2 * kk + h) ^ sw) << 4));
            acc[i] = __builtin_amdgcn_mfma_f32_32x32x16_bf16(af, bw[kk], acc[i], 0, 0, 0); } }
    const float rswt = rsw[t], bst = bs[t];
    bf16* urow = U + (size_t)(tok0 + t) * 2048 + g * 256; const float* cgp = a.c_ln_g + j * 2048 + g * 256; const float* cbp = a.c_ln_b + j * 2048 + g * 256;
#pragma unroll
    for (int i = 0; i < 4; ++i)
#pragma unroll
        for (int qd = 0; qd < 4; ++qd) { const int c = 32 * (4 * cq + i) + 8 * qd + 4 * h;
            const v2u uw = *(const v2u*)(urow + c); const f32x4 cg4 = *(const f32x4*)(cgp + c), cb4 = *(const f32x4*)(cbp + c);
            const float o0 = bflo(uw.x) * (cg4[0] * acc[i][4 * qd + 0] + cb4[0] * rswt + bst), o1 = bfhi(uw.x) * (cg4[1] * acc[i][4 * qd + 1] + cb4[1] * rswt + bst);
            const float o2 = bflo(uw.y) * (cg4[2] * acc[i][4 * qd + 2] + cb4[2] * rswt + bst), o3 = bfhi(uw.y) * (cg4[3] * acc[i][4 * qd + 3] + cb4[3] * rswt + bst);
            v2u ow; ow.x = cvtpk(o0, o1); ow.y = cvtpk(o2, o3); *(v2u*)(urow + c) = ow; }
}

__device__ __forceinline__ void sgu_unit2(const Args& a, int unit, int j, LAS unsigned char* lds, int wave_s) {
    int tid_ = tid_from_wave(wave_s); asm volatile("" : "+v"(tid_)); const int tid = tid_, lane = tid & 63, wave = __builtin_amdgcn_readfirstlane(tid >> 6), l31 = lane & 31, h = lane >> 5;
    const int chunk = unit >> 1, g0 = (unit & 1) * 4, tok0 = chunk * 128;
    bf16* U = (bf16*)(a.ws + WS_Z); const bf16* V = (const bf16*)(a.ws + WS_R1); const float* vstat = (const float*)(a.ws + WS_VSTAT);
    LAS float* st = (LAS float*)(lds + 131072);
    __syncthreads();
    if (tid < 128) { float mu, rstd; vrow_mu_rstd(vstat, tok0 + tid, mu, rstd); st[2 * tid] = mu; st[2 * tid + 1] = rstd; }
    const int tt = wave & 3, cq = wave >> 2, t = 32 * tt + l31;
    v4u vreg[8];
#pragma unroll
    for (int it = 0; it < 8; ++it) { const int sl = (it >> 2) * 64 + (tid >> 3), c0 = (it & 3) * 64 + 8 * (tid & 7); vreg[it] = *(const v4u*)(V + (size_t)(tok0 + sl) * 2048 + g0 * 256 + c0); }
    __syncthreads();
    for (int k = 0; k < 4; ++k) {
        const int g = g0 + k; LAS unsigned char* buf = lds + (k & 1) * 65536;
        const float* cgp = a.c_ln_g + j * 2048 + g * 256; const float* cbp = a.c_ln_b + j * 2048 + g * 256;
        int tk = tid; asm volatile("" : "+v"(tk)); const int p = tk & 7;
#pragma unroll
        for (int it = 0; it < 8; ++it) { const int sl = (it >> 2) * 64 + (tk >> 3), c0 = (it & 3) * 64 + 8 * p; const float mu = st[2 * sl], rstd = st[2 * sl + 1];
            const f32x4 ga = *(const f32x4*)(cgp + c0), gb = *(const f32x4*)(cgp + c0 + 4); const float gg[8] = {ga[0], ga[1], ga[2], ga[3], gb[0], gb[1], gb[2], gb[3]};
            const unsigned ww[4] = {vreg[it].x, vreg[it].y, vreg[it].z, vreg[it].w};
#pragma unroll
            for (int i = 0; i < 8; ++i) { const int c = c0 + i; const float x = (i & 1) ? bfhi(ww[i >> 1]) : bflo(ww[i >> 1]);
                *(LAS unsigned short*)(buf + c * 256 + ((((sl >> 3) ^ ((c ^ (c >> 3)) & 15))) << 4) + (sl & 7) * 2) = (unsigned short)f2bf((x - mu) * rstd * gg[i]); } }
        __syncthreads();
        const bf16* Wsb = (const bf16*)(a.ws + WS_WSB) + (size_t)(j * 8 + g) * 128 * 128;
        bf16x8 bw[8];
#pragma unroll
        for (int kk = 0; kk < 8; ++kk) bw[kk] = *(const bf16x8*)(Wsb + (size_t)t * 128 + 16 * kk + 8 * h);
        f32x16 acc[4];
#pragma unroll
        for (int i = 0; i < 4; ++i) { acc[i] = (f32x16){0.f, 0.f, 0.f, 0.f, 0.f, 0.f, 0.f, 0.f, 0.f, 0.f, 0.f, 0.f, 0.f, 0.f, 0.f, 0.f};
            const int c = 32 * (4 * cq + i) + l31, sw = (c ^ (c >> 3)) & 15;
#pragma unroll
            for (int kk = 0; kk < 8; ++kk) { const bf16x8 af = *(const LAS bf16x8*)(buf + c * 256 + (((2 * kk + h) ^ sw) << 4));
                acc[i] = __builtin_amdgcn_mfma_f32_32x32x16_bf16(af, bw[kk], acc[i], 0, 0, 0); } }
        if (k < 3) {
#pragma unroll
            for (int it = 0; it < 8; ++it) { const int sl = (it >> 2) * 64 + (tk >> 3), c0 = (it & 3) * 64 + 8 * p; vreg[it] = *(const v4u*)(V + (size_t)(tok0 + sl) * 2048 + (g + 1) * 256 + c0); } }
        const float rswt = ((const float*)(a.ws + WS_SMALL))[SM_RSW + (j * 8 + g) * 128 + t], bst = a.c_bs[(j * 8 + g) * 128 + t];
        bf16* urow = U + (size_t)(tok0 + t) * 2048 + g * 256;
#pragma unroll
        for (int i = 0; i < 4; ++i)
#pragma unroll
            for (int qd = 0; qd < 4; ++qd) { const int c = 32 * (4 * cq + i) + 8 * qd + 4 * h;
                const v2u uw = *(const v2u*)(urow + c); const f32x4 cb4 = *(const f32x4*)(cbp + c);
                const float o0 = bflo(uw.x) * (acc[i][4 * qd + 0] + cb4[0] * rswt + bst), o1 = bfhi(uw.x) * (acc[i][4 * qd + 1] + cb4[1] * rswt + bst);
                const float o2 = bflo(uw.y) * (acc[i][4 * qd + 2] + cb4[2] * rswt + bst), o3 = bfhi(uw.y) * (acc[i][4 * qd + 3] + cb4[3] * rswt + bst);
                v2u ow; ow.x = cvtpk(o0, o1); ow.y = cvtpk(o2, o3); *(v2u*)(urow + c) = ow; }
    }
}

typedef short s16x4 __attribute__((ext_vector_type(4)));
__device__ __forceinline__ unsigned sgu_off_b(unsigned row, unsigned ch) { return 256u * row + 16u * (ch ^ (((row & 3) << 2) | ((row >> 2) & 3))); }
__device__ __forceinline__ s16x4 sgu_tr(const LAS unsigned char* p) { return __builtin_amdgcn_ds_read_tr16_b64_v4i16((LAS s16x4*)p); }
__device__ __forceinline__ void sgu_unit3(const Args& a, int unit, int j, LAS unsigned char* lds, int wave_s) {
    int tid_ = tid_from_wave(wave_s); asm volatile("" : "+v"(tid_)); const int tid = tid_, lane = tid & 63, wave = __builtin_amdgcn_readfirstlane(tid >> 6), l31 = lane & 31, h = lane >> 5;
    const int chunk = unit >> 1, g0 = (unit & 1) * 4, tok0 = chunk * 128;
    bf16* U = (bf16*)(a.ws + WS_Z); const bf16* V = (const bf16*)(a.ws + WS_R1); const float* vstat = (const float*)(a.ws + WS_VSTAT);
    LAS float* st = (LAS float*)(lds + 131072);
    __syncthreads();
    if (tid < 128) { float mu, rstd; vrow_mu_rstd(vstat, tok0 + tid, mu, rstd); st[2 * tid] = mu; st[2 * tid + 1] = rstd; }
    const int tt = wave & 3, cq = wave >> 2, t = 32 * tt + l31;
    v4u vreg[8];
#pragma unroll
    for (int it = 0; it < 8; ++it) { const int sl = (it >> 2) * 64 + (tid >> 3), c0 = (it & 3) * 64 + 8 * (tid & 7); vreg[it] = *(const v4u*)(V + (size_t)(tok0 + sl) * 2048 + g0 * 256 + c0); }
    __syncthreads();
    for (int k = 0; k < 4; ++k) {
        const int g = g0 + k; LAS unsigned char* buf = lds + (k & 1) * 65536;
        const float* cgp = a.c_ln_g + j * 2048 + g * 256; const float* cbp = a.c_ln_b + j * 2048 + g * 256;
        int tk = tid; asm volatile("" : "+v"(tk)); const int p = tk & 7;
#pragma unroll
        for (int it = 0; it < 8; ++it) { const int sl = (it >> 2) * 64 + (tk >> 3), c0 = (it & 3) * 64 + 8 * p; const float mu = st[2 * sl], rstd = st[2 * sl + 1];
            const f32x4 ga = *(const f32x4*)(cgp + c0), gb = *(const f32x4*)(cgp + c0 + 4);
            const unsigned w0 = vreg[it].x, w1 = vreg[it].y, w2 = vreg[it].z, w3 = vreg[it].w;
            v4u o; o.x = cvtpk((bflo(w0) - mu) * rstd * ga[0], (bfhi(w0) - mu) * rstd * ga[1]); o.y = cvtpk((bflo(w1) - mu) * rstd * ga[2], (bfhi(w1) - mu) * rstd * ga[3]);
            o.z = cvtpk((bflo(w2) - mu) * rstd * gb[0], (bfhi(w2) - mu) * rstd * gb[1]); o.w = cvtpk((bflo(w3) - mu) * rstd * gb[2], (bfhi(w3) - mu) * rstd * gb[3]);
            *(LAS v4u*)(buf + ((it & 3) >> 1) * 32768 + sgu_off_b((unsigned)sl, (unsigned)((it & 1) * 8 + p))) = o; }
        __syncthreads();
        const bf16* Wsb = (const bf16*)(a.ws + WS_WSB) + (size_t)(j * 8 + g) * 128 * 128;
        bf16x8 bw[8];
#pragma unroll
        for (int kk = 0; kk < 8; ++kk) bw[kk] = *(const bf16x8*)(Wsb + (size_t)t * 128 + 16 * kk + 8 * h);
        f32x16 acc[4];
#pragma unroll
        for (int i = 0; i < 4; ++i) { acc[i] = (f32x16){0.f, 0.f, 0.f, 0.f, 0.f, 0.f, 0.f, 0.f, 0.f, 0.f, 0.f, 0.f, 0.f, 0.f, 0.f, 0.f};
            const int ct = 4 * cq + i; const unsigned lq = (unsigned)(lane & 15) >> 2, lp = (unsigned)lane & 3, lblk = ((unsigned)lane >> 4) & 1;
            const LAS unsigned char* ib = buf + (ct >> 2) * 32768;
            const unsigned a0 = sgu_off_b(8u * h + lq, 4u * (ct & 3) + 2u * lblk + (lp >> 1)) + 8u * (lp & 1), a1 = sgu_off_b(8u * h + 4u + lq, 4u * (ct & 3) + 2u * lblk + (lp >> 1)) + 8u * (lp & 1);
#pragma unroll
            for (int kk = 0; kk < 8; ++kk) { const s16x4 lo = sgu_tr(ib + a0 + kk * 4096), hi = sgu_tr(ib + a1 + kk * 4096);
                const bf16x8 af = __builtin_shufflevector(lo, hi, 0, 1, 2, 3, 4, 5, 6, 7);
                acc[i] = __builtin_amdgcn_mfma_f32_32x32x16_bf16(af, bw[kk], acc[i], 0, 0, 0); } }
        if (k < 3) {
#pragma unroll
            for (int it = 0; it < 8; ++it) { const int sl = (it >> 2) * 64 + (tk >> 3), c0 = (it & 3) * 64 + 8 * p; vreg[it] = *(const v4u*)(V + (size_t)(tok0 + sl) * 2048 + (g + 1) * 256 + c0); } }
        const float rswt = ((const float*)(a.ws + WS_SMALL))[SM_RSW + (j * 8 + g) * 128 + t], bst = a.c_bs[(j * 8 + g) * 128 + t];
        bf16* urow = U + (size_t)(tok0 + t) * 2048 + g * 256;
#pragma unroll
        for (int i = 0; i < 4; ++i)
#pragma unroll
            for (int qd = 0; qd < 4; ++qd) { const int c = 32 * (4 * cq + i) + 8 * qd + 4 * h;
                const v2u uw = *(const v2u*)(urow + c); const f32x4 cb4 = *(const f32x4*)(cbp + c);
                const float o0 = bflo(uw.x) * (acc[i][4 * qd + 0] + cb4[0] * rswt + bst), o1 = bfhi(uw.x) * (acc[i][4 * qd + 1] + cb4[1] * rswt + bst);
                const float o2 = bflo(uw.y) * (acc[i][4 * qd + 2] + cb4[2] * rswt + bst), o3 = bfhi(uw.y) * (acc[i][4 * qd + 3] + cb4[3] * rswt + bst);
                v2u ow; ow.x = cvtpk(o0, o1); ow.y = cvtpk(o2, o3); *(v2u*)(urow + c) = ow; }
    }
}

__device__ __forceinline__ void sgu_unit4(const Args& a, int unit, int j, LAS unsigned char* lds, int wave_s) {
    int tid_ = tid_from_wave(wave_s); asm volatile("" : "+v"(tid_)); const int tid = tid_, lane = tid & 63, wave = __builtin_amdgcn_readfirstlane(tid >> 6), l31 = lane & 31, h = lane >> 5;
    const int chunk = unit >> 1, g0 = (unit & 1) * 4, tok0 = chunk * 128;
    bf16* U = (bf16*)(a.ws + WS_Z); const bf16* V = (const bf16*)(a.ws + WS_R1); const float* vstat = (const float*)(a.ws + WS_VSTAT);
    LAS float* st = (LAS float*)(lds + 131072);
    __syncthreads();
    const int tt = wave & 3, cq = wave >> 2, t = 32 * tt + l31;
    v4u vreg[8];
#pragma unroll
    for (int it = 0; it < 8; ++it) { const int sl = (it >> 2) * 64 + (tid >> 3), c0 = (it & 3) * 64 + 8 * (tid & 7); vreg[it] = *(const v4u*)(V + (size_t)(tok0 + sl) * 2048 + g0 * 256 + c0); }
    if (tid < 128) { float mu, rstd; vrow_mu_rstd(vstat, tok0 + tid, mu, rstd); st[2 * tid] = mu; st[2 * tid + 1] = rstd; }
    __syncthreads();
    for (int k = 0; k < 4; ++k) {
        const int g = g0 + k; LAS unsigned char* buf = lds + (k & 1) * 65536;
        const float* cgp = a.c_ln_g + j * 2048 + g * 256; const float* cbp = a.c_ln_b + j * 2048 + g * 256;
        bf16* ubase = U + (size_t)(tok0 + 32 * tt + 4 * h) * 2048 + g * 256 + 128 * cq + 2 * l31;
        unsigned uwv[16][2];
#pragma unroll
        for (int r = 0; r < 16; ++r)
#pragma unroll
            for (int u = 0; u < 2; ++u) uwv[r][u] = *(const unsigned*)(ubase + (size_t)(8 * (r >> 2) + (r & 3)) * 2048 + 64 * u);
        int tk = tid; asm volatile("" : "+v"(tk)); const int p = tk & 7;
#pragma unroll
        for (int it = 0; it < 8; ++it) { const int sl = (it >> 2) * 64 + (tk >> 3), c0 = (it & 3) * 64 + 8 * p; const float mu = st[2 * sl], rstd = st[2 * sl + 1];
            const f32x4 ga = *(const f32x4*)(cgp + c0), gb = *(const f32x4*)(cgp + c0 + 4);
            const unsigned w0 = vreg[it].x, w1 = vreg[it].y, w2 = vreg[it].z, w3 = vreg[it].w;
            const float e0 = (bflo(w0) - mu) * rstd * ga[0], e1 = (bfhi(w0) - mu) * rstd * ga[1], e2 = (bflo(w1) - mu) * rstd * ga[2], e3 = (bfhi(w1) - mu) * rstd * ga[3];
            const float e4 = (bflo(w2) - mu) * rstd * gb[0], e5 = (bfhi(w2) - mu) * rstd * gb[1], e6 = (bflo(w3) - mu) * rstd * gb[2], e7 = (bfhi(w3) - mu) * rstd * gb[3];
            v2u ev, od; ev.x = cvtpk(e0, e2); ev.y = cvtpk(e4, e6); od.x = cvtpk(e1, e3); od.y = cvtpk(e5, e7);
            LAS unsigned char* ib = buf + ((it & 3) >> 1) * 32768 + 8 * (p & 1);
            *(LAS v2u*)(ib + sgu_off_b((unsigned)sl, (unsigned)((it & 1) * 8 + (p >> 1)))) = ev; *(LAS v2u*)(ib + sgu_off_b((unsigned)sl, (unsigned)((it & 1) * 8 + 4 + (p >> 1)))) = od; }
        const bf16* Wsb = (const bf16*)(a.ws + WS_WSB) + (size_t)(j * 8 + g) * 128 * 128;
        bf16x8 bw[8];
#pragma unroll
        for (int kk = 0; kk < 8; ++kk) bw[kk] = *(const bf16x8*)(Wsb + (size_t)((tt * 8 + kk) * 64 + lane) * 8);
        if (k < 3) {
#pragma unroll
            for (int it = 0; it < 8; ++it) { const int sl = (it >> 2) * 64 + (tk >> 3), c0 = (it & 3) * 64 + 8 * p; vreg[it] = *(const v4u*)(V + (size_t)(tok0 + sl) * 2048 + (g + 1) * 256 + c0); } }
        LDS_SYNC();
        f32x16 acc[4];
#pragma unroll
        for (int i = 0; i < 4; ++i) { acc[i] = (f32x16){0.f, 0.f, 0.f, 0.f, 0.f, 0.f, 0.f, 0.f, 0.f, 0.f, 0.f, 0.f, 0.f, 0.f, 0.f, 0.f};
            const int ct = 4 * cq + i; const unsigned lq = (unsigned)(lane & 15) >> 2, lp = (unsigned)lane & 3, lblk = ((unsigned)lane >> 4) & 1;
            const LAS unsigned char* ib = buf + (ct >> 2) * 32768;
            const unsigned a0 = sgu_off_b(8u * h + lq, 4u * (ct & 3) + 2u * lblk + (lp >> 1)) + 8u * (lp & 1), a1 = sgu_off_b(8u * h + 4u + lq, 4u * (ct & 3) + 2u * lblk + (lp >> 1)) + 8u * (lp & 1);
#pragma unroll
            for (int kk = 0; kk < 8; ++kk) { const s16x4 lo = sgu_tr(ib + a0 + kk * 4096), hi = sgu_tr(ib + a1 + kk * 4096);
                const bf16x8 af = __builtin_shufflevector(lo, hi, 0, 1, 2, 3, 4, 5, 6, 7);
                acc[i] = __builtin_amdgcn_mfma_f32_32x32x16_bf16(bw[kk], af, acc[i], 0, 0, 0); } }
        const float* rswp = (const float*)(a.ws + WS_SMALL) + SM_RSW + (j * 8 + g) * 128 + 32 * tt + 4 * h; const float* bsp = a.c_bs + (j * 8 + g) * 128 + 32 * tt + 4 * h;
        pg8::f32x2 cb2[2];
#pragma unroll
        for (int u = 0; u < 2; ++u) cb2[u] = *(const pg8::f32x2*)(cbp + 64 * (2 * cq + u) + 2 * l31);
#pragma unroll
        for (int rq = 0; rq < 4; ++rq) { const f32x4 rs4 = *(const f32x4*)(rswp + 8 * rq), bs4 = *(const f32x4*)(bsp + 8 * rq);
#pragma unroll
            for (int rr = 0; rr < 4; ++rr)
#pragma unroll
                for (int u = 0; u < 2; ++u) { unsigned* up = (unsigned*)(ubase + (size_t)(8 * rq + rr) * 2048 + 64 * u); const unsigned uw = uwv[4 * rq + rr][u];
                    const float o0 = bflo(uw) * (acc[2 * u][4 * rq + rr] + cb2[u].x * rs4[rr] + bs4[rr]), o1 = bfhi(uw) * (acc[2 * u + 1][4 * rq + rr] + cb2[u].y * rs4[rr] + bs4[rr]);
                    *up = cvtpk(o0, o1); } }
    }
}

constexpr int ATT_VT_OFF = 49152, ATT_VT_PITCH = 776;
__device__ __forceinline__ void attn_unit(const Args& a, int unit, int j, LAS unsigned char* lds, int wave_s) {
    int tid_ = tid_from_wave(wave_s); asm volatile("" : "+v"(tid_)); const int tid = tid_, lane = tid & 63, wave = __builtin_amdgcn_readfirstlane(tid >> 6), l31 = lane & 31, h = lane >> 5;
    const bf16* Z = (const bf16*)(a.ws + WS_Z); bf16* OB = (bf16*)(a.ws + WS_OB);
    const int blk = unit >> 1, kvh = unit & 1, t0 = blk * 128, ss = seq_start(t0), se = seq_end(t0), kbase = t0 - 128;
    __syncthreads();
    v4u kwv[6], vwv[6];
#pragma unroll
    for (int it = 0; it < 6; ++it) { const int idx = it * 512 + tid, row = idx >> 3, q = idx & 7; int sr = kbase + row; sr = sr < ss ? ss : sr; sr = sr > se - 1 ? se - 1 : sr;
        kwv[it] = *(const v4u*)(Z + (size_t)sr * NZ + ZKB + kvh * 64 + 8 * q); vwv[it] = *(const v4u*)(Z + (size_t)sr * NZ + ZVB + kvh * 64 + 8 * q); }
    bf16x8 qfa[2][4];
#pragma unroll
    for (int qi = 0; qi < 2; ++qi) { const int qt = wave * 2 + qi, hq = kvh * 4 + (qt >> 2), tq = t0 + 32 * (qt & 3) + l31;
#pragma unroll
        for (int kk = 0; kk < 4; ++kk) qfa[qi][kk] = *(const bf16x8*)(Z + (size_t)tq * NZ + ZQB + hq * 64 + 16 * kk + 8 * h); }
    __builtin_amdgcn_sched_barrier(0);
#pragma unroll
    for (int it = 0; it < 6; ++it) { const int idx = it * 512 + tid, row = idx >> 3, q = idx & 7, sx = kbase + row; const bool ok = sx >= ss && sx < se;
        const v4u zero4 = (v4u){0u, 0u, 0u, 0u}; const v4u kw = ok ? kwv[it] : zero4, vw = ok ? vwv[it] : zero4;
        *(LAS v4u*)(lds + row * 128 + ((q ^ ((row >> 1) & 7)) << 4)) = kw;
        const unsigned ww[4] = {vw.x, vw.y, vw.z, vw.w};
#pragma unroll
        for (int i = 0; i < 8; ++i) *(LAS unsigned short*)(lds + ATT_VT_OFF + (8 * q + i) * ATT_VT_PITCH + row * 2) = (unsigned short)((i & 1) ? (ww[i >> 1] >> 16) : (ww[i >> 1] & 0xffffu)); }
    __syncthreads();
    const float ninf = -__builtin_inff(); const bool edge = !(kbase >= ss && kbase + 384 <= se);
    for (int qi = 0; qi < 2; ++qi) {
        const int qt = wave * 2 + qi, g = qt >> 2, sb = qt & 3, hq = kvh * 4 + g, tq = t0 + 32 * sb + l31;
        const float slope = exp2f(-(float)(hq + 1)), sink = a.attn_sink[j * 8 + hq];
        bf16x8 qf[4];
#pragma unroll
        for (int kk = 0; kk < 4; ++kk) qf[kk] = qi ? qfa[1][kk] : qfa[0][kk];
        float m = sink, lsum = h == 0 ? 1.0f : 0.0f;
        f32x16 o0 = (f32x16){0.f, 0.f, 0.f, 0.f, 0.f, 0.f, 0.f, 0.f, 0.f, 0.f, 0.f, 0.f, 0.f, 0.f, 0.f, 0.f}, o1 = o0;
        for (int kt = sb; kt < sb + 9; ++kt) {
            f32x16 sc = (f32x16){0.f, 0.f, 0.f, 0.f, 0.f, 0.f, 0.f, 0.f, 0.f, 0.f, 0.f, 0.f, 0.f, 0.f, 0.f, 0.f};
            const int row = 32 * kt + l31, rsw = (row >> 1) & 7;
#pragma unroll
            for (int kk = 0; kk < 4; ++kk) { const bf16x8 kf = *(const LAS bf16x8*)(lds + row * 128 + (((2 * kk + h) ^ rsw) << 4)); sc = __builtin_amdgcn_mfma_f32_32x32x16_bf16(kf, qf[kk], sc, 0, 0, 0); }
            float mx = m;
            if (edge || kt == sb || kt == sb + 8) {
#pragma unroll
                for (int r = 0; r < 16; ++r) { const int s = kbase + 32 * kt + (r & 3) + 8 * (r >> 2) + 4 * h; const int dd = tq - s, dist = dd < 0 ? -dd : dd;
                    const bool ok = dist <= 128 && s >= ss && s < se; const float v = ok ? sc[r] * 0.125f - slope * (float)dist : ninf; sc[r] = v; mx = fmaxf(mx, v); }
            } else {
                const float fd = (float)(tq - (kbase + 32 * kt) - 4 * h);
#pragma unroll
                for (int r = 0; r < 16; ++r) { const float v = sc[r] * 0.125f - slope * fabsf(fd - (float)((r & 3) + 8 * (r >> 2))); sc[r] = v; mx = fmaxf(mx, v); }
            }
            mx = max_xor32(mx);
            const float cf = __expf(m - mx); m = mx; lsum *= cf; o0 = o0 * cf; o1 = o1 * cf;
#pragma unroll
            for (int r = 0; r < 16; ++r) { sc[r] = __expf(sc[r] - m); lsum += sc[r]; }
            bf16x8 pf[2];
#pragma unroll
            for (int sp = 0; sp < 2; ++sp) { v4u w; w.x = cvtpk(sc[8 * sp + 0], sc[8 * sp + 1]); w.y = cvtpk(sc[8 * sp + 2], sc[8 * sp + 3]); w.z = cvtpk(sc[8 * sp + 4], sc[8 * sp + 5]); w.w = cvtpk(sc[8 * sp + 6], sc[8 * sp + 7]); pf[sp] = __builtin_bit_cast(bf16x8, w); }
#pragma unroll
            for (int sp = 0; sp < 2; ++sp) {
                const int ko = (32 * kt + 16 * sp + 4 * h) * 2;
                { const LAS unsigned char* vp = lds + ATT_VT_OFF + l31 * ATT_VT_PITCH + ko; const v2u lo = *(const LAS v2u*)vp, hi = *(const LAS v2u*)(vp + 16); const v4u w = (v4u){lo.x, lo.y, hi.x, hi.y};
                  o0 = __builtin_amdgcn_mfma_f32_32x32x16_bf16(__builtin_bit_cast(bf16x8, w), pf[sp], o0, 0, 0, 0); }
                { const LAS unsigned char* vp = lds + ATT_VT_OFF + (32 + l31) * ATT_VT_PITCH + ko; const v2u lo = *(const LAS v2u*)vp, hi = *(const LAS v2u*)(vp + 16); const v4u w = (v4u){lo.x, lo.y, hi.x, hi.y};
                  o1 = __builtin_amdgcn_mfma_f32_32x32x16_bf16(__builtin_bit_cast(bf16x8, w), pf[sp], o1, 0, 0, 0); } }
        }
        lsum = sum_xor32(lsum); const float inv = 1.0f / lsum;
        bf16* orow = OB + (size_t)tq * 1024 + 512 + hq * 64;
#pragma unroll
        for (int qp = 0; qp < 2; ++qp) { v2u a0, a1, b0, b1;
            a0.x = cvtpk(o0[8 * qp] * inv, o0[8 * qp + 1] * inv); a0.y = cvtpk(o0[8 * qp + 2] * inv, o0[8 * qp + 3] * inv); a1.x = cvtpk(o0[8 * qp + 4] * inv, o0[8 * qp + 5] * inv); a1.y = cvtpk(o0[8 * qp + 6] * inv, o0[8 * qp + 7] * inv);
            b0.x = cvtpk(o1[8 * qp] * inv, o1[8 * qp + 1] * inv); b0.y = cvtpk(o1[8 * qp + 2] * inv, o1[8 * qp + 3] * inv); b1.x = cvtpk(o1[8 * qp + 4] * inv, o1[8 * qp + 5] * inv); b1.y = cvtpk(o1[8 * qp + 6] * inv, o1[8 * qp + 7] * inv);
            *(v4u*)(orow + 16 * qp + 8 * h) = widen_pair(a0, a1); *(v4u*)(orow + 32 + 16 * qp + 8 * h) = widen_pair(b0, b1); }
    }
}


constexpr int HA_G = 0, HA_T = 32768, HA_QT = 34816, HA_KT = HA_QT + 17408, HA_QF = HA_KT + 17408, HA_KE = HA_QF + 17408, HA_VT = HA_KE + 17408, HA_ST = HA_VT + 17408, HA_END = HA_ST + 34816;
static_assert(HA_END <= MISC_OFF, "HGRN level A LDS map");
__device__ __forceinline__ void hgrn_a_unit(const Args& a, int unit, int j, LAS unsigned char* lds, int wave_s) {
    int tid_ = tid_from_wave(wave_s); asm volatile("" : "+v"(tid_)); const int tid = tid_, lane = tid & 63, wave = __builtin_amdgcn_readfirstlane(tid >> 6), l31 = lane & 31, h = lane >> 5;
    const int sc = unit >> 3, hh = (unit >> 1) & 3, dir = unit & 1, scbase = sc * 512;
    const bf16* Z = (const bf16*)(a.ws + WS_Z); bf16* OP = (bf16*)a.out + (size_t)dir * M * 512; bf16* QTg = (bf16*)(a.ws + WS_QT) + (size_t)dir * M * 512;
    float* Fo = (float*)(a.ws + WS_F) + (size_t)unit * 16384; float* Td = (float*)(a.ws + WS_SMALL) + SM_TDEC + (size_t)unit * 128;
    const float* lbv = (const float*)(a.ws + WS_SMALL) + SM_LB + (size_t)j * 1024 + dir * 512 + hh * 128;
    const int ri = tid >> 3, d0 = (tid & 7) * 16, cd = tid & 127, rg = tid >> 7, ti = wave >> 2, ej = wave & 3;
    LAS float* Gm = (LAS float*)(lds + HA_G); LAS float* Tm = (LAS float*)(lds + HA_T);
    float lb16[16], Bc[16];
#pragma unroll
    for (int e = 0; e < 16; ++e) { lb16[e] = lbv[d0 + e]; Bc[e] = 0.f; }
    const f32x16 zero16 = (f32x16){0.f, 0.f, 0.f, 0.f, 0.f, 0.f, 0.f, 0.f, 0.f, 0.f, 0.f, 0.f, 0.f, 0.f, 0.f, 0.f};
    f32x16 sacc0 = zero16, sacc1 = zero16;
    __syncthreads();
    for (int i = tid; i < 34816 / 16; i += NTHR) *(LAS v4u*)(lds + HA_ST + 16 * i) = (v4u){0u, 0u, 0u, 0u};
    __syncthreads();
    for (int cc = 0; cc < 8; ++cc) {
        const int tok = dir == 0 ? scbase + 64 * cc + ri : scbase + 511 - 64 * cc - ri;
        float q[16], kk[16]; unsigned vraw[8];
        {
            const bf16* zr = Z + (size_t)tok * NZ + hh * 128 + d0;
            const v4u qa = *(const v4u*)(zr + ZQ), qb = *(const v4u*)(zr + ZQ + 8), fa = *(const v4u*)(zr + (dir == 0 ? ZFF : ZFB)), fb = *(const v4u*)(zr + (dir == 0 ? ZFF : ZFB) + 8), va = *(const v4u*)(zr + ZI), vb = *(const v4u*)(zr + ZI + 8);
            const unsigned qw[8] = {qa.x, qa.y, qa.z, qa.w, qb.x, qb.y, qb.z, qb.w}, fw[8] = {fa.x, fa.y, fa.z, fa.w, fb.x, fb.y, fb.z, fb.w};
            vraw[0] = va.x; vraw[1] = va.y; vraw[2] = va.z; vraw[3] = va.w; vraw[4] = vb.x; vraw[5] = vb.y; vraw[6] = vb.z; vraw[7] = vb.w;
            float lf[16];
#pragma unroll
            for (int e = 0; e < 16; ++e) { const float qr = (e & 1) ? bfhi(qw[e >> 1]) : bflo(qw[e >> 1]), fr = (e & 1) ? bfhi(fw[e >> 1]) : bflo(fw[e >> 1]);
                q[e] = qr * __builtin_amdgcn_rcpf(1.0f + __expf(-qr));
                const float ea = __expf(-fabsf(fr)), rc = __builtin_amdgcn_rcpf(1.0f + ea), sg = fr >= 0.f ? rc : ea * rc;
                const float lb = lb16[e], oml = 1.0f - lb;
                kk[e] = oml * (1.0f - sg);
                lf[e] = lb == 0.f ? (fminf(fr, 0.f) - __logf(1.0f + ea)) : __logf(lb + oml * sg); }
#pragma unroll
            for (int c4 = 0; c4 < 4; ++c4) *(LAS f32x4*)(Gm + ri * 128 + d0 + 4 * c4) = (f32x4){lf[4 * c4], lf[4 * c4 + 1], lf[4 * c4 + 2], lf[4 * c4 + 3]};
        }
        __syncthreads();
        {
            float pre[16]; float run = 0.f;
#pragma unroll
            for (int k = 0; k < 16; ++k) { run += Gm[(16 * rg + k) * 128 + cd]; pre[k] = run; }
            Tm[rg * 128 + cd] = run;
            __syncthreads();
            float off = 0.f;
#pragma unroll
            for (int r2 = 0; r2 < 3; ++r2) off += (r2 < rg) ? Tm[r2 * 128 + cd] : 0.f;
#pragma unroll
            for (int k = 0; k < 16; ++k) Gm[(16 * rg + k) * 128 + cd] = pre[k] + off;
        }
        __syncthreads();
        {
            float b[16], rr[16], bl[16];
#pragma unroll
            for (int c4 = 0; c4 < 4; ++c4) { const f32x4 x = *(const LAS f32x4*)(Gm + ri * 128 + d0 + 4 * c4), y = *(const LAS f32x4*)(Gm + 31 * 128 + d0 + 4 * c4), z = *(const LAS f32x4*)(Gm + 63 * 128 + d0 + 4 * c4);
#pragma unroll
                for (int i = 0; i < 4; ++i) { b[4 * c4 + i] = x[i]; rr[4 * c4 + i] = y[i]; bl[4 * c4 + i] = z[i]; } }
            unsigned wqt[8], wkt[8], wqf[8], wqg[8]; unsigned short ke[16];
#pragma unroll
            for (int e2 = 0; e2 < 8; ++e2) { float qt2[2], kt2[2], qf2[2], qg2[2];
#pragma unroll
                for (int x = 0; x < 2; ++x) { const int e = 2 * e2 + x; const float ex = __expf(b[e] - rr[e]), er = __expf(rr[e]), elr = __expf(bl[e] - rr[e]), ebc = __expf(Bc[e]);
                    qt2[x] = q[e] * ex; kt2[x] = kk[e] * __builtin_amdgcn_rcpf(ex); qf2[x] = qt2[x] * er; qg2[x] = qf2[x] * ebc; ke[e] = (unsigned short)f2bf(kt2[x] * elr); }
                wqt[e2] = cvtpk(qt2[0], qt2[1]); wkt[e2] = cvtpk(kt2[0], kt2[1]); wqf[e2] = cvtpk(qf2[0], qf2[1]); wqg[e2] = cvtpk(qg2[0], qg2[1]); }
            *(LAS v4u*)(lds + HA_QT + ri * 272 + d0 * 2) = (v4u){wqt[0], wqt[1], wqt[2], wqt[3]}; *(LAS v4u*)(lds + HA_QT + ri * 272 + d0 * 2 + 16) = (v4u){wqt[4], wqt[5], wqt[6], wqt[7]};
            *(LAS v4u*)(lds + HA_KT + ri * 272 + d0 * 2) = (v4u){wkt[0], wkt[1], wkt[2], wkt[3]}; *(LAS v4u*)(lds + HA_KT + ri * 272 + d0 * 2 + 16) = (v4u){wkt[4], wkt[5], wkt[6], wkt[7]};
            *(LAS v4u*)(lds + HA_QF + ri * 272 + d0 * 2) = (v4u){wqf[0], wqf[1], wqf[2], wqf[3]}; *(LAS v4u*)(lds + HA_QF + ri * 272 + d0 * 2 + 16) = (v4u){wqf[4], wqf[5], wqf[6], wqf[7]};
            *(v4u*)(QTg + (size_t)tok * 512 + hh * 128 + d0) = (v4u){wqg[0], wqg[1], wqg[2], wqg[3]}; *(v4u*)(QTg + (size_t)tok * 512 + hh * 128 + d0 + 8) = (v4u){wqg[4], wqg[5], wqg[6], wqg[7]};
#pragma unroll
            for (int e = 0; e < 16; ++e) { *(LAS unsigned short*)(lds + HA_KE + (d0 + e) * 136 + ri * 2) = ke[e];
                *(LAS unsigned short*)(lds + HA_VT + (d0 + e) * 136 + ri * 2) = (unsigned short)((e & 1) ? (vraw[e >> 1] >> 16) : (vraw[e >> 1] & 0xffffu)); Bc[e] += bl[e]; }
        }
        __syncthreads();
        bf16x8 vf[2][2]; float dec0, dec1;
        {
            bf16x8 pf[2][2];
#pragma unroll
            for (int sj = 0; sj < 2; ++sj) {
                if (sj <= ti) {
                    f32x16 pt = zero16;
#pragma unroll
                    for (int k8 = 0; k8 < 8; ++k8) { const bf16x8 af = *(const LAS bf16x8*)(lds + HA_KT + (32 * sj + l31) * 272 + (16 * k8 + 8 * h) * 2), bq = *(const LAS bf16x8*)(lds + HA_QT + (32 * ti + l31) * 272 + (16 * k8 + 8 * h) * 2);
                        pt = __builtin_amdgcn_mfma_f32_32x32x16_bf16(af, bq, pt, 0, 0, 0); }
#pragma unroll
                    for (int r = 0; r < 16; ++r) { const int sl = 32 * sj + (r & 3) + 8 * (r >> 2) + 4 * h, tl = 32 * ti + l31; pt[r] = sl <= tl ? pt[r] : 0.f; }
#pragma unroll
                    for (int sp = 0; sp < 2; ++sp) { v4u w; w.x = cvtpk(pt[8 * sp + 0], pt[8 * sp + 1]); w.y = cvtpk(pt[8 * sp + 2], pt[8 * sp + 3]); w.z = cvtpk(pt[8 * sp + 4], pt[8 * sp + 5]); w.w = cvtpk(pt[8 * sp + 6], pt[8 * sp + 7]); pf[sj][sp] = __builtin_bit_cast(bf16x8, w); }
                } else { pf[sj][0] = (bf16x8){0, 0, 0, 0, 0, 0, 0, 0}; pf[sj][1] = pf[sj][0]; }
            }
            f32x16 ot = zero16;
#pragma unroll
            for (int k8 = 0; k8 < 8; ++k8) { const bf16x8 af = *(const LAS bf16x8*)(lds + HA_ST + (32 * ej + l31) * 272 + (16 * k8 + 8 * h) * 2), bq = *(const LAS bf16x8*)(lds + HA_QF + (32 * ti + l31) * 272 + (16 * k8 + 8 * h) * 2);
                ot = __builtin_amdgcn_mfma_f32_32x32x16_bf16(af, bq, ot, 0, 0, 0); }
#pragma unroll
            for (int sj = 0; sj < 2; ++sj)
#pragma unroll
                for (int sp = 0; sp < 2; ++sp) { const LAS unsigned char* vp = lds + HA_VT + (32 * ej + l31) * 136 + (32 * sj + 16 * sp + 4 * h) * 2; const v2u lo = *(const LAS v2u*)vp, hi = *(const LAS v2u*)(vp + 16);
                    vf[sj][sp] = __builtin_bit_cast(bf16x8, ((v4u){lo.x, lo.y, hi.x, hi.y})); }
#pragma unroll
            for (int sj = 0; sj < 2; ++sj)
#pragma unroll
                for (int sp = 0; sp < 2; ++sp) ot = __builtin_amdgcn_mfma_f32_32x32x16_bf16(vf[sj][sp], pf[sj][sp], ot, 0, 0, 0);
            dec0 = __expf(Gm[63 * 128 + 32 * (2 * ti) + l31]); dec1 = __expf(Gm[63 * 128 + 32 * (2 * ti + 1) + l31]);
            const int tl = 32 * ti + l31, tokc = dir == 0 ? scbase + 64 * cc + tl : scbase + 511 - 64 * cc - tl;
            bf16* orow = OP + (size_t)tokc * 512 + hh * 128 + 32 * ej + 4 * h;
#pragma unroll
            for (int qd = 0; qd < 4; ++qd) { v2u w; w.x = cvtpk(ot[4 * qd], ot[4 * qd + 1]); w.y = cvtpk(ot[4 * qd + 2], ot[4 * qd + 3]); *(v2u*)(orow + 8 * qd) = w; }
        }
        __syncthreads();
        {
            sacc0 = sacc0 * dec0; sacc1 = sacc1 * dec1;
#pragma unroll
            for (int sj = 0; sj < 2; ++sj)
#pragma unroll
                for (int sp = 0; sp < 2; ++sp) {
                    { const LAS unsigned char* kp = lds + HA_KE + (32 * (2 * ti) + l31) * 136 + (32 * sj + 16 * sp + 4 * h) * 2; const v2u lo = *(const LAS v2u*)kp, hi = *(const LAS v2u*)(kp + 16);
                      sacc0 = __builtin_amdgcn_mfma_f32_32x32x16_bf16(vf[sj][sp], __builtin_bit_cast(bf16x8, ((v4u){lo.x, lo.y, hi.x, hi.y})), sacc0, 0, 0, 0); }
                    { const LAS unsigned char* kp = lds + HA_KE + (32 * (2 * ti + 1) + l31) * 136 + (32 * sj + 16 * sp + 4 * h) * 2; const v2u lo = *(const LAS v2u*)kp, hi = *(const LAS v2u*)(kp + 16);
                      sacc1 = __builtin_amdgcn_mfma_f32_32x32x16_bf16(vf[sj][sp], __builtin_bit_cast(bf16x8, ((v4u){lo.x, lo.y, hi.x, hi.y})), sacc1, 0, 0, 0); } }
#pragma unroll
            for (int r = 0; r < 16; ++r) { const int e = 32 * ej + (r & 3) + 8 * (r >> 2) + 4 * h;
                *(LAS unsigned short*)(lds + HA_ST + e * 272 + (32 * (2 * ti) + l31) * 2) = (unsigned short)f2bf(sacc0[r]);
                *(LAS unsigned short*)(lds + HA_ST + e * 272 + (32 * (2 * ti + 1) + l31) * 2) = (unsigned short)f2bf(sacc1[r]); }
        }
    }
#pragma unroll
    for (int r = 0; r < 16; ++r) { const int e = 32 * ej + (r & 3) + 8 * (r >> 2) + 4 * h; Fo[(size_t)e * 128 + 32 * (2 * ti) + l31] = sacc0[r]; Fo[(size_t)e * 128 + 32 * (2 * ti + 1) + l31] = sacc1[r]; }
    if (ri == 0) {
#pragma unroll
        for (int e = 0; e < 16; ++e) Td[d0 + e] = __expf(Bc[e]); }
}
constexpr int HB_T = 0, HB_BL = 4096, HB_QT = 8192, HB_KT = HB_QT + 17408, HB_QF = HB_KT + 17408, HB_KE = HB_QF + 17408, HB_VT = HB_KE + 17408, HB_ST = HB_VT + 17408, HB_END = HB_ST + 34816;
static_assert(HB_END <= MISC_OFF, "HGRN level A v2 LDS map");
__device__ __forceinline__ void hgrn_a_unit2(const Args& a, int unit, int j, LAS unsigned char* lds, int wave_s) {
    int tid_ = tid_from_wave(wave_s); asm volatile("" : "+v"(tid_)); const int tid = tid_, lane = tid & 63, wave = __builtin_amdgcn_readfirstlane(tid >> 6), l31 = lane & 31, h = lane >> 5;
    const bool smp = unit >= 256; const int uv = smp ? unit - 256 : unit, hh = (uv >> 1) & 3, dir = uv & 1;
    const int scbase = smp ? MP + (uv >> 3) * 512 : (uv >> 3) * 2048, nch = smp ? 8 : 32, lastt = 64 * nch - 1;
    const int funit = smp ? (MP / 512 + (uv >> 3)) * 8 + hh * 2 + dir : 0;
    const bf16* Z = (const bf16*)(a.ws + WS_Z); bf16* OP = (bf16*)a.out + (size_t)dir * M * 512; bf16* QTg = (bf16*)(a.ws + WS_QT) + (size_t)dir * M * 512;
    float* Fo = (float*)(a.ws + WS_F) + (size_t)funit * 16384; float* Td = (float*)(a.ws + WS_SMALL) + SM_TDEC + (size_t)funit * 128;
    const float* lbv = (const float*)(a.ws + WS_SMALL) + SM_LB + (size_t)j * 1024 + dir * 512 + hh * 128;
    const int c0 = 2 * lane, rg = wave, ti = wave >> 2, ej = wave & 3, zf = dir == 0 ? ZFF : ZFB;
    LAS float* Tm = (LAS float*)(lds + HB_T); LAS float* BLm = (LAS float*)(lds + HB_BL);
    const float lb0 = lbv[c0], lb1 = lbv[c0 + 1];
    float Bc0 = 0.f, Bc1 = 0.f;
    const f32x16 zero16 = (f32x16){0.f, 0.f, 0.f, 0.f, 0.f, 0.f, 0.f, 0.f, 0.f, 0.f, 0.f, 0.f, 0.f, 0.f, 0.f, 0.f};
    f32x16 sacc0 = zero16, sacc1 = zero16;
    unsigned rq[8], rf[8], rv[8];
#pragma unroll
    for (int r = 0; r < 8; ++r) { const int tok = dir == 0 ? scbase + 8 * rg + r : scbase + lastt - 8 * rg - r; const bf16* zr = Z + (size_t)tok * NZ + hh * 128 + c0;
        rq[r] = *(const unsigned*)(zr + ZQ); rf[r] = *(const unsigned*)(zr + zf); rv[r] = *(const unsigned*)(zr + ZI); }
    __syncthreads();
    for (int i = tid; i < 34816 / 16; i += NTHR) *(LAS v4u*)(lds + HB_ST + 16 * i) = (v4u){0u, 0u, 0u, 0u};
    for (int cc = 0; cc < nch; ++cc) {
        float q[8][2], kk[8][2], pre[8][2]; unsigned vw[8];
        {
            float run0 = 0.f, run1 = 0.f;
#pragma unroll
            for (int r = 0; r < 8; ++r) { vw[r] = rv[r];
#pragma unroll
                for (int x = 0; x < 2; ++x) { const float qr = x ? bfhi(rq[r]) : bflo(rq[r]), fr = x ? bfhi(rf[r]) : bflo(rf[r]), lb = x ? lb1 : lb0, oml = 1.0f - lb;
                    q[r][x] = qr * __builtin_amdgcn_rcpf(1.0f + __expf(-qr));
                    const float ea = __expf(-fabsf(fr)), rc = __builtin_amdgcn_rcpf(1.0f + ea), sg = fr >= 0.f ? rc : ea * rc;
                    kk[r][x] = oml * (1.0f - sg);
                    const float lf = lb == 0.f ? (fminf(fr, 0.f) - __logf(1.0f + ea)) : __logf(lb + oml * sg);
                    if (x) { run1 += lf; pre[r][1] = run1; } else { run0 += lf; pre[r][0] = run0; } } }
            *(LAS pg8::f32x2*)(Tm + rg * 128 + c0) = (pg8::f32x2){run0, run1};
        }
        __syncthreads();
        {
            float off0 = 0.f, off1 = 0.f, r310 = 0.f, r311 = 0.f, bl0 = 0.f, bl1 = 0.f;
#pragma unroll
            for (int r2 = 0; r2 < 8; ++r2) { const pg8::f32x2 tv = *(const LAS pg8::f32x2*)(Tm + r2 * 128 + c0); if (r2 < rg) { off0 += tv[0]; off1 += tv[1]; } if (r2 < 4) { r310 += tv[0]; r311 += tv[1]; } bl0 += tv[0]; bl1 += tv[1]; }
            const float er0 = __expf(r310), er1 = __expf(r311), elr0 = __expf(bl0 - r310), elr1 = __expf(bl1 - r311), ebc0 = __expf(Bc0), ebc1 = __expf(Bc1);
            float ke[8][2];
#pragma unroll
            for (int r = 0; r < 8; ++r) { const int row = 8 * rg + r, tok = dir == 0 ? scbase + 64 * cc + row : scbase + lastt - 64 * cc - row;
                const float ex0 = __expf(pre[r][0] + off0 - r310), ex1 = __expf(pre[r][1] + off1 - r311);
                const float qt0 = q[r][0] * ex0, qt1 = q[r][1] * ex1, kt0 = kk[r][0] * __builtin_amdgcn_rcpf(ex0), kt1 = kk[r][1] * __builtin_amdgcn_rcpf(ex1);
                const float qf0 = qt0 * er0, qf1 = qt1 * er1; ke[r][0] = kt0 * elr0; ke[r][1] = kt1 * elr1;
                *(LAS unsigned*)(lds + HB_QT + row * 272 + c0 * 2) = cvtpk(qt0, qt1);
                *(LAS unsigned*)(lds + HB_KT + row * 272 + c0 * 2) = cvtpk(kt0, kt1);
                *(LAS unsigned*)(lds + HB_QF + row * 272 + c0 * 2) = cvtpk(qf0, qf1);
                if (smp) *(unsigned*)(QTg + (size_t)tok * 512 + hh * 128 + c0) = cvtpk(qf0 * ebc0, qf1 * ebc1); }
#pragma unroll
            for (int x = 0; x < 2; ++x) { LAS unsigned char* kp = lds + HB_KE + (c0 + x) * 136 + 16 * rg; LAS unsigned char* vp = lds + HB_VT + (c0 + x) * 136 + 16 * rg;
                *(LAS v2u*)kp = (v2u){cvtpk(ke[0][x], ke[1][x]), cvtpk(ke[2][x], ke[3][x])}; *(LAS v2u*)(kp + 8) = (v2u){cvtpk(ke[4][x], ke[5][x]), cvtpk(ke[6][x], ke[7][x])};
                unsigned vv[4];
#pragma unroll
                for (int r2 = 0; r2 < 4; ++r2) vv[r2] = x ? ((vw[2 * r2] >> 16) | (vw[2 * r2 + 1] & 0xffff0000u)) : ((vw[2 * r2] & 0xffffu) | (vw[2 * r2 + 1] << 16));
                *(LAS v2u*)vp = (v2u){vv[0], vv[1]}; *(LAS v2u*)(vp + 8) = (v2u){vv[2], vv[3]}; }
            if (rg == 0) *(LAS pg8::f32x2*)(BLm + c0) = (pg8::f32x2){bl0, bl1};
            Bc0 += bl0; Bc1 += bl1;
            if (cc < nch - 1) {
#pragma unroll
                for (int r = 0; r < 8; ++r) { const int row = 8 * rg + r, tok = dir == 0 ? scbase + 64 * (cc + 1) + row : scbase + lastt - 64 * (cc + 1) - row; const bf16* zr = Z + (size_t)tok * NZ + hh * 128 + c0;
                    rq[r] = *(const unsigned*)(zr + ZQ); rf[r] = *(const unsigned*)(zr + zf); rv[r] = *(const unsigned*)(zr + ZI); } }
        }
        __syncthreads();
        bf16x8 vf[2][2]; float dec0, dec1;
        {
            bf16x8 pf[2][2];
            bf16x8 bqv[8];
#pragma unroll
            for (int k8 = 0; k8 < 8; ++k8) bqv[k8] = *(const LAS bf16x8*)(lds + HB_QT + (32 * ti + l31) * 272 + (16 * k8 + 8 * h) * 2);
#pragma unroll
            for (int sj = 0; sj < 2; ++sj) {
                if (sj <= ti) {
                    f32x16 pt = zero16; bf16x8 afv[8];
#pragma unroll
                    for (int k8 = 0; k8 < 8; ++k8) afv[k8] = *(const LAS bf16x8*)(lds + HB_KT + (32 * sj + l31) * 272 + (16 * k8 + 8 * h) * 2);
                    __builtin_amdgcn_sched_barrier(0);
#pragma unroll
                    for (int k8 = 0; k8 < 8; ++k8) pt = __builtin_amdgcn_mfma_f32_32x32x16_bf16(afv[k8], bqv[k8], pt, 0, 0, 0);
                    __builtin_amdgcn_sched_barrier(0);
#pragma unroll
                    for (int r = 0; r < 16; ++r) { const int sl = 32 * sj + (r & 3) + 8 * (r >> 2) + 4 * h, tl = 32 * ti + l31; pt[r] = sl <= tl ? pt[r] : 0.f; }
#pragma unroll
                    for (int sp = 0; sp < 2; ++sp) { v4u w; w.x = cvtpk(pt[8 * sp + 0], pt[8 * sp + 1]); w.y = cvtpk(pt[8 * sp + 2], pt[8 * sp + 3]); w.z = cvtpk(pt[8 * sp + 4], pt[8 * sp + 5]); w.w = cvtpk(pt[8 * sp + 6], pt[8 * sp + 7]); pf[sj][sp] = __builtin_bit_cast(bf16x8, w); }
                } else { pf[sj][0] = (bf16x8){0, 0, 0, 0, 0, 0, 0, 0}; pf[sj][1] = pf[sj][0]; }
            }
            f32x16 ot = zero16;
            { bf16x8 sfv[8], qfv[8];
#pragma unroll
              for (int k8 = 0; k8 < 8; ++k8) { sfv[k8] = *(const LAS bf16x8*)(lds + HB_ST + (32 * ej + l31) * 272 + (16 * k8 + 8 * h) * 2); qfv[k8] = *(const LAS bf16x8*)(lds + HB_QF + (32 * ti + l31) * 272 + (16 * k8 + 8 * h) * 2); }
#pragma unroll
              for (int sj = 0; sj < 2; ++sj)
#pragma unroll
                  for (int sp = 0; sp < 2; ++sp) { const LAS unsigned char* vp = lds + HB_VT + (32 * ej + l31) * 136 + (32 * sj + 16 * sp + 4 * h) * 2; const v2u lo = *(const LAS v2u*)vp, hi = *(const LAS v2u*)(vp + 16);
                      vf[sj][sp] = __builtin_bit_cast(bf16x8, ((v4u){lo.x, lo.y, hi.x, hi.y})); }
              __builtin_amdgcn_sched_barrier(0);
#pragma unroll
              for (int k8 = 0; k8 < 8; ++k8) ot = __builtin_amdgcn_mfma_f32_32x32x16_bf16(sfv[k8], qfv[k8], ot, 0, 0, 0); }
#pragma unroll
            for (int sj = 0; sj < 2; ++sj)
#pragma unroll
                for (int sp = 0; sp < 2; ++sp) ot = __builtin_amdgcn_mfma_f32_32x32x16_bf16(vf[sj][sp], pf[sj][sp], ot, 0, 0, 0);
            __builtin_amdgcn_sched_barrier(0);
            dec0 = __expf(BLm[32 * (2 * ti) + l31]); dec1 = __expf(BLm[32 * (2 * ti + 1) + l31]);
            const int tl = 32 * ti + l31, tokc = dir == 0 ? scbase + 64 * cc + tl : scbase + lastt - 64 * cc - tl;
            bf16* orow = OP + (size_t)tokc * 512 + hh * 128 + 32 * ej + 8 * h;
#pragma unroll
            for (int qp = 0; qp < 2; ++qp) { v2u w0, w1; w0.x = cvtpk(ot[8 * qp], ot[8 * qp + 1]); w0.y = cvtpk(ot[8 * qp + 2], ot[8 * qp + 3]); w1.x = cvtpk(ot[8 * qp + 4], ot[8 * qp + 5]); w1.y = cvtpk(ot[8 * qp + 6], ot[8 * qp + 7]);
                *(v4u*)(orow + 16 * qp) = widen_pair(w0, w1); }
        }
        __syncthreads();
        {
            sacc0 = sacc0 * dec0; sacc1 = sacc1 * dec1;
            bf16x8 ke0[2][2], ke1[2][2];
#pragma unroll
            for (int sj = 0; sj < 2; ++sj)
#pragma unroll
                for (int sp = 0; sp < 2; ++sp) {
                    { const LAS unsigned char* kp = lds + HB_KE + (32 * (2 * ti) + l31) * 136 + (32 * sj + 16 * sp + 4 * h) * 2; const v2u lo = *(const LAS v2u*)kp, hi = *(const LAS v2u*)(kp + 16); ke0[sj][sp] = __builtin_bit_cast(bf16x8, ((v4u){lo.x, lo.y, hi.x, hi.y})); }
                    { const LAS unsigned char* kp = lds + HB_KE + (32 * (2 * ti + 1) + l31) * 136 + (32 * sj + 16 * sp + 4 * h) * 2; const v2u lo = *(const LAS v2u*)kp, hi = *(const LAS v2u*)(kp + 16); ke1[sj][sp] = __builtin_bit_cast(bf16x8, ((v4u){lo.x, lo.y, hi.x, hi.y})); } }
            __builtin_amdgcn_sched_barrier(0);
#pragma unroll
            for (int sj = 0; sj < 2; ++sj)
#pragma unroll
                for (int sp = 0; sp < 2; ++sp) { sacc0 = __builtin_amdgcn_mfma_f32_32x32x16_bf16(vf[sj][sp], ke0[sj][sp], sacc0, 0, 0, 0); sacc1 = __builtin_amdgcn_mfma_f32_32x32x16_bf16(vf[sj][sp], ke1[sj][sp], sacc1, 0, 0, 0); }
            __builtin_amdgcn_sched_barrier(0);
#pragma unroll
            for (int r = 0; r < 16; ++r) { const int e = 32 * ej + (r & 3) + 8 * (r >> 2) + 4 * h;
                *(LAS unsigned short*)(lds + HB_ST + e * 272 + (32 * (2 * ti) + l31) * 2) = (unsigned short)f2bf(sacc0[r]);
                *(LAS unsigned short*)(lds + HB_ST + e * 272 + (32 * (2 * ti + 1) + l31) * 2) = (unsigned short)f2bf(sacc1[r]); }
        }
    }
    if (smp) {
#pragma unroll
    for (int r = 0; r < 16; ++r) { const int e = 32 * ej + (r & 3) + 8 * (r >> 2) + 4 * h; Fo[(size_t)e * 128 + 32 * (2 * ti) + l31] = sacc0[r]; Fo[(size_t)e * 128 + 32 * (2 * ti + 1) + l31] = sacc1[r]; }
    if (rg == 0) *(pg8::f32x2*)(Td + c0) = (pg8::f32x2){__expf(Bc0), __expf(Bc1)}; }
}
__device__ __forceinline__ int sin_frag_off(int e4) { const int e = e4 >> 7, dk = e4 & 127; return ((((e >> 5) * 8 + (dk >> 4)) * 64) + (e & 31) + 32 * ((dk >> 3) & 1)) * 8 + (dk & 7); }
template <int NB>
__device__ __forceinline__ void hgrn_b_chain(const float* Fo, const float* Td, bf16* SIN, int sc0, int nsc, int hh, int dir, int e4, f32x4& carry) {
    const int dk = e4 & 127;
    for (int k0 = 0; k0 < nsc; k0 += NB) {
        f32x4 f[NB], t[NB];
#pragma unroll
        for (int i = 0; i < NB; ++i) { const int sc = dir == 0 ? sc0 + k0 + i : sc0 + nsc - 1 - (k0 + i); const size_t unit = (size_t)sc * 8 + hh * 2 + dir;
            f[i] = *(const f32x4*)(Fo + unit * 16384 + e4); t[i] = *(const f32x4*)(Td + unit * 128 + dk); }
#pragma unroll
        for (int i = 0; i < NB; ++i) { const int sc = dir == 0 ? sc0 + k0 + i : sc0 + nsc - 1 - (k0 + i); const size_t unit = (size_t)sc * 8 + hh * 2 + dir;
            v2u w; w.x = cvtpk(carry[0], carry[1]); w.y = cvtpk(carry[2], carry[3]); *(v2u*)(SIN + unit * 16384 + sin_frag_off(e4)) = w; carry = t[i] * carry + f[i]; }
    }
}
__device__ __forceinline__ void hgrn_b_item(const Args& a, int it, int wave_s) {
    int tid_ = tid_from_wave(wave_s); asm volatile("" : "+v"(tid_)); const int tid = tid_;
    const float* Fo = (const float*)(a.ws + WS_F); const float* Td = (const float*)(a.ws + WS_SMALL) + SM_TDEC; bf16* SIN = (bf16*)(a.ws + WS_SIN);
    f32x4 carry = (f32x4){0.f, 0.f, 0.f, 0.f};
    if (it < 256) { if (tid < 128) { const int ch = it >> 5; hgrn_b_chain<8>(Fo, Td, SIN, MP / 512, MS / 512, ch >> 1, ch & 1, (it & 31) * 512 + tid * 4, carry); } }
    else { const int r = it - 256, pc = r >> 3; hgrn_b_chain<4>(Fo, Td, SIN, (pc >> 3) * 4, 4, (pc >> 1) & 3, pc & 1, (r & 7) * 2048 + tid * 4, carry); }
}
__device__ __forceinline__ void hgrn_c_unit(const Args& a, int unit, int j, LAS unsigned char* lds, int wave_s) {
    int tid_ = tid_from_wave(wave_s); asm volatile("" : "+v"(tid_)); const int tid = tid_, lane = tid & 63, wave = __builtin_amdgcn_readfirstlane(tid >> 6), l31 = lane & 31, h = lane >> 5;
    const int tt = unit >> 2, hh = unit & 3, ti = wave >> 2, ej = wave & 3, tok = tt * 64 + 32 * ti + l31, sc = (tt * 64) >> 9;
    const bf16* Z = (const bf16*)(a.ws + WS_Z); const bf16* OP = (const bf16*)a.out; const bf16* QTg = (const bf16*)(a.ws + WS_QT); const bf16* SIN = (const bf16*)(a.ws + WS_SIN); bf16* OB = (bf16*)(a.ws + WS_OB);
    f32x16 acc = (f32x16){0.f, 0.f, 0.f, 0.f, 0.f, 0.f, 0.f, 0.f, 0.f, 0.f, 0.f, 0.f, 0.f, 0.f, 0.f, 0.f};
#pragma unroll
    for (int dir = 0; dir < 2; ++dir) { const bf16* sin = SIN + ((size_t)sc * 8 + hh * 2 + dir) * 16384 + (size_t)(32 * ej + l31) * 128 + 8 * h; const bf16* qt = QTg + ((size_t)dir * M + tok) * 512 + hh * 128 + 8 * h;
        bf16x8 af[8], bq[8];
#pragma unroll
        for (int k8 = 0; k8 < 8; ++k8) { af[k8] = *(const bf16x8*)(sin + 16 * k8); bq[k8] = *(const bf16x8*)(qt + 16 * k8); }
#pragma unroll
        for (int k8 = 0; k8 < 8; ++k8) acc = __builtin_amdgcn_mfma_f32_32x32x16_bf16(af[k8], bq[k8], acc, 0, 0, 0); }
    float ss = 0.f;
#pragma unroll
    for (int qd = 0; qd < 4; ++qd) { const int e0 = 32 * ej + 8 * qd + 4 * h; const v2u p0 = *(const v2u*)(OP + (size_t)tok * 512 + hh * 128 + e0), p1 = *(const v2u*)(OP + ((size_t)M + tok) * 512 + hh * 128 + e0);
        acc[4 * qd] += bflo(p0.x) + bflo(p1.x); acc[4 * qd + 1] += bfhi(p0.x) + bfhi(p1.x); acc[4 * qd + 2] += bflo(p0.y) + bflo(p1.y); acc[4 * qd + 3] += bfhi(p0.y) + bfhi(p1.y);
        ss += (acc[4 * qd] * acc[4 * qd] + acc[4 * qd + 1] * acc[4 * qd + 1]) + (acc[4 * qd + 2] * acc[4 * qd + 2] + acc[4 * qd + 3] * acc[4 * qd + 3]); }
    ss += __shfl_xor(ss, 32);
    LAS float* sq = (LAS float*)lds;
    __syncthreads();
    if (h == 0) sq[(ti * 4 + ej) * 32 + l31] = ss;
    __syncthreads();
    const float tot = (sq[(ti * 4 + 0) * 32 + l31] + sq[(ti * 4 + 1) * 32 + l31]) + (sq[(ti * 4 + 2) * 32 + l31] + sq[(ti * 4 + 3) * 32 + l31]);
    const float rstd = 1.0f / sqrtf(tot * (1.0f / 128.0f) + RMS_EPS);
    const float* ng = a.hgrn_norm_g + j * 128;
#pragma unroll
    for (int qd = 0; qd < 4; ++qd) { const int e0 = 32 * ej + 8 * qd + 4 * h; const v2u gw2 = *(const v2u*)(Z + (size_t)tok * NZ + ZG + hh * 128 + e0); const f32x4 n4 = *(const f32x4*)(ng + e0);
        const float g0 = bflo(gw2.x), g1 = bfhi(gw2.x), g2 = bflo(gw2.y), g3 = bfhi(gw2.y);
        const float y0 = acc[4 * qd] * rstd * n4[0] * silu_f(g0), y1 = acc[4 * qd + 1] * rstd * n4[1] * silu_f(g1), y2 = acc[4 * qd + 2] * rstd * n4[2] * silu_f(g2), y3 = acc[4 * qd + 3] * rstd * n4[3] * silu_f(g3);
        v2u w; w.x = cvtpk(y0, y1); w.y = cvtpk(y2, y3); *(v2u*)(OB + (size_t)tok * 1024 + hh * 128 + e0) = w; }
}

__device__ __forceinline__ void hgrn_c_wave(const Args& a, int wu, int j, int wave_s) {
    int tid_ = tid_from_wave(wave_s); asm volatile("" : "+v"(tid_)); const int lane = tid_ & 63, l31 = lane & 31, h = lane >> 5;
    const int tile = wu >> 2, hh = wu & 3, tok = tile * 32 + l31, sc = (tile * 32) >> 9;
    const bf16* Z = (const bf16*)(a.ws + WS_Z); const bf16* OP = (const bf16*)a.out; const bf16* QTg = (const bf16*)(a.ws + WS_QT); const bf16* SIN = (const bf16*)(a.ws + WS_SIN); bf16* OB = (bf16*)(a.ws + WS_OB);
    const f32x16 zero16 = (f32x16){0.f, 0.f, 0.f, 0.f, 0.f, 0.f, 0.f, 0.f, 0.f, 0.f, 0.f, 0.f, 0.f, 0.f, 0.f, 0.f};
    f32x16 acc[4] = {zero16, zero16, zero16, zero16};
#pragma unroll
    for (int dir = 0; dir < 2; ++dir) {
        const bf16* sin = SIN + ((size_t)sc * 8 + hh * 2 + dir) * 16384 + (size_t)l31 * 128 + 8 * h; const bf16* qt = QTg + ((size_t)dir * M + tok) * 512 + hh * 128 + 8 * h;
#pragma unroll
        for (int kh = 0; kh < 2; ++kh) {
            bf16x8 af[4][4], bq[4];
#pragma unroll
            for (int k4 = 0; k4 < 4; ++k4) { bq[k4] = *(const bf16x8*)(qt + 16 * (4 * kh + k4));
#pragma unroll
                for (int et = 0; et < 4; ++et) af[k4][et] = *(const bf16x8*)(sin + (size_t)et * 32 * 128 + 16 * (4 * kh + k4)); }
#pragma unroll
            for (int k4 = 0; k4 < 4; ++k4)
#pragma unroll
                for (int et = 0; et < 4; ++et) acc[et] = __builtin_amdgcn_mfma_f32_32x32x16_bf16(af[k4][et], bq[k4], acc[et], 0, 0, 0);
        }
    }
    float ss = 0.f;
#pragma unroll
    for (int et = 0; et < 4; ++et)
#pragma unroll
        for (int qd = 0; qd < 4; ++qd) { const int e0 = 32 * et + 8 * qd + 4 * h; const v2u p0 = *(const v2u*)(OP + (size_t)tok * 512 + hh * 128 + e0), p1 = *(const v2u*)(OP + ((size_t)M + tok) * 512 + hh * 128 + e0);
            acc[et][4 * qd] += bflo(p0.x) + bflo(p1.x); acc[et][4 * qd + 1] += bfhi(p0.x) + bfhi(p1.x); acc[et][4 * qd + 2] += bflo(p0.y) + bflo(p1.y); acc[et][4 * qd + 3] += bfhi(p0.y) + bfhi(p1.y);
            ss += (acc[et][4 * qd] * acc[et][4 * qd] + acc[et][4 * qd + 1] * acc[et][4 * qd + 1]) + (acc[et][4 * qd + 2] * acc[et][4 * qd + 2] + acc[et][4 * qd + 3] * acc[et][4 * qd + 3]); }
    ss += __shfl_xor(ss, 32);
    const float rstd = 1.0f / sqrtf(ss * (1.0f / 128.0f) + RMS_EPS);
    const float* ng = a.hgrn_norm_g + j * 128;
#pragma unroll
    for (int et = 0; et < 4; ++et)
#pragma unroll
        for (int qd = 0; qd < 4; ++qd) { const int e0 = 32 * et + 8 * qd + 4 * h; const v2u gw2 = *(const v2u*)(Z + (size_t)tok * NZ + ZG + hh * 128 + e0); const f32x4 n4 = *(const f32x4*)(ng + e0);
            const float g0 = bflo(gw2.x), g1 = bfhi(gw2.x), g2 = bflo(gw2.y), g3 = bfhi(gw2.y);
            const float y0 = acc[et][4 * qd] * rstd * n4[0] * silu_f(g0), y1 = acc[et][4 * qd + 1] * rstd * n4[1] * silu_f(g1), y2 = acc[et][4 * qd + 2] * rstd * n4[2] * silu_f(g2), y3 = acc[et][4 * qd + 3] * rstd * n4[3] * silu_f(g3);
            v2u w; w.x = cvtpk(y0, y1); w.y = cvtpk(y2, y3); *(v2u*)(OB + (size_t)tok * 1024 + hh * 128 + e0) = w; }
}

constexpr int HC_PITCH = 272, HC_BUF = 32 * HC_PITCH, HC_WAVE = 2 * HC_BUF;
static_assert(8 * HC_WAVE <= MISC_OFF, "HGRN level C v4 LDS map");
__device__ __forceinline__ void hgrn_c_wave4(const Args& a, int wu, int j, LAS unsigned char* lds, int wave_s) {
    int tid_ = tid_from_wave(wave_s); asm volatile("" : "+v"(tid_)); const int lane = tid_ & 63, l31 = lane & 31, h = lane >> 5;
    const int tile = wu >> 2, hh = wu & 3, tok = tile * 32 + l31, sc = (tile * 32) >> 9;
    const bf16* Z = (const bf16*)(a.ws + WS_Z); const bf16* OP = (const bf16*)a.out; const bf16* QTg = (const bf16*)(a.ws + WS_QT); const bf16* SIN = (const bf16*)(a.ws + WS_SIN); bf16* OB = (bf16*)(a.ws + WS_OB);
    LAS unsigned char* b0 = lds + wave_s * HC_WAVE; LAS unsigned char* b1 = b0 + HC_BUF;
    const int cch = lane & 15, rsub = lane >> 4;
    const int lco = rsub * HC_PITCH + cch * 16, lmf = l31 * HC_PITCH + 8 * h;
    const f32x16 zero16 = (f32x16){0.f, 0.f, 0.f, 0.f, 0.f, 0.f, 0.f, 0.f, 0.f, 0.f, 0.f, 0.f, 0.f, 0.f, 0.f, 0.f};
    f32x16 acc[4] = {zero16, zero16, zero16, zero16};
    v4u pa[8], pb[8];
    { const bf16* o0 = OP + ((size_t)tile * 32 + rsub) * 512 + hh * 128 + 8 * cch; const bf16* o1 = o0 + (size_t)M * 512;
#pragma unroll
      for (int it = 0; it < 8; ++it) { pa[it] = *(const v4u*)(o0 + (size_t)(4 * it) * 512); pb[it] = *(const v4u*)(o1 + (size_t)(4 * it) * 512); } }
    __builtin_amdgcn_sched_barrier(0);
    if (tile * 32 >= MP) {
#pragma unroll
    for (int dir = 0; dir < 2; ++dir) {
        const bf16* sin = SIN + ((size_t)sc * 8 + hh * 2 + dir) * 16384 + (size_t)lane * 8; const bf16* qt = QTg + ((size_t)dir * M + tok) * 512 + hh * 128 + 8 * h;
#pragma unroll
        for (int kh = 0; kh < 4; ++kh) {
            bf16x8 af[2][4], bq[2];
#pragma unroll
            for (int k2 = 0; k2 < 2; ++k2) { bq[k2] = *(const bf16x8*)(qt + 16 * (2 * kh + k2));
#pragma unroll
                for (int et = 0; et < 4; ++et) af[k2][et] = *(const bf16x8*)(sin + (size_t)((et * 8 + 2 * kh + k2) * 64) * 8); }
#pragma unroll
            for (int k2 = 0; k2 < 2; ++k2)
#pragma unroll
                for (int et = 0; et < 4; ++et) acc[et] = __builtin_amdgcn_mfma_f32_32x32x16_bf16(af[k2][et], bq[k2], acc[et], 0, 0, 0);
        }
    }
    }
    __builtin_amdgcn_sched_barrier(0);
#pragma unroll
    for (int it = 0; it < 8; ++it) { *(LAS v4u*)(b0 + lco + it * 4 * HC_PITCH) = pa[it]; *(LAS v4u*)(b1 + lco + it * 4 * HC_PITCH) = pb[it]; }
    { const bf16* g0p = Z + ((size_t)tile * 32 + rsub) * NZ + ZG + hh * 128 + 8 * cch;
#pragma unroll
      for (int it = 0; it < 8; ++it) pa[it] = *(const v4u*)(g0p + (size_t)(4 * it) * NZ); }
    LDS_WAIT();
    float ss = 0.f;
#pragma unroll
    for (int et = 0; et < 4; ++et)
#pragma unroll
        for (int qd = 0; qd < 4; ++qd) { const v2u p0 = *(const LAS v2u*)(b0 + lmf + (32 * et + 8 * qd) * 2), p1 = *(const LAS v2u*)(b1 + lmf + (32 * et + 8 * qd) * 2);
            acc[et][4 * qd] += bflo(p0.x) + bflo(p1.x); acc[et][4 * qd + 1] += bfhi(p0.x) + bfhi(p1.x); acc[et][4 * qd + 2] += bflo(p0.y) + bflo(p1.y); acc[et][4 * qd + 3] += bfhi(p0.y) + bfhi(p1.y);
            ss += (acc[et][4 * qd] * acc[et][4 * qd] + acc[et][4 * qd + 1] * acc[et][4 * qd + 1]) + (acc[et][4 * qd + 2] * acc[et][4 * qd + 2] + acc[et][4 * qd + 3] * acc[et][4 * qd + 3]); }
    ss = sum_xor32(ss);
    const float rstd = 1.0f / sqrtf(ss * (1.0f / 128.0f) + RMS_EPS);
    LDS_WAIT();
#pragma unroll
    for (int it = 0; it < 8; ++it) *(LAS v4u*)(b0 + lco + it * 4 * HC_PITCH) = pa[it];
    LDS_WAIT();
    const float* ng = a.hgrn_norm_g + j * 128;
#pragma unroll
    for (int et = 0; et < 4; ++et)
#pragma unroll
        for (int qd = 0; qd < 4; ++qd) { const int e0 = 32 * et + 8 * qd + 4 * h; const v2u gw2 = *(const LAS v2u*)(b0 + lmf + (32 * et + 8 * qd) * 2); const f32x4 n4 = *(const f32x4*)(ng + e0);
            const float g0 = bflo(gw2.x), g1 = bfhi(gw2.x), g2 = bflo(gw2.y), g3 = bfhi(gw2.y);
            const float y0 = acc[et][4 * qd] * rstd * n4[0] * silu_f(g0), y1 = acc[et][4 * qd + 1] * rstd * n4[1] * silu_f(g1), y2 = acc[et][4 * qd + 2] * rstd * n4[2] * silu_f(g2), y3 = acc[et][4 * qd + 3] * rstd * n4[3] * silu_f(g3);
            v2u w; w.x = cvtpk(y0, y1); w.y = cvtpk(y2, y3); *(LAS v2u*)(b1 + lmf + (32 * et + 8 * qd) * 2) = w; }
    LDS_WAIT();
    { bf16* ob = OB + ((size_t)tile * 32 + rsub) * 1024 + hh * 128 + 8 * cch;
#pragma unroll
      for (int it = 0; it < 8; ++it) *(v4u*)(ob + (size_t)(4 * it) * 1024) = *(const LAS v4u*)(b1 + lco + it * 4 * HC_PITCH); }
    LDS_WAIT();
}

__device__ __forceinline__ Args load_args() {
#if defined(__HIP_DEVICE_COMPILE__)
    unsigned long long p = (unsigned long long)__builtin_amdgcn_kernarg_segment_ptr(); asm volatile("" : "+s"(p)); return *(const __attribute__((address_space(4))) Args*)p;
#else
    return Args{};
#endif
}
#define PH_ARGS() const Args a = load_args(); unsigned char* const ws = a.ws; float* const smallf = (float*)(ws + WS_SMALL); bf16* const Wb = (bf16*)(ws + WS_W); bf16* const XB = (bf16*)(ws + WS_XB); bf16* const Zb = (bf16*)(ws + WS_Z); \
    bf16* const OB = (bf16*)(ws + WS_OB); float* const stat_mix = (float*)(ws + WS_STATMIX); float* const stat_ffn = (float*)(ws + WS_STATFFN); float* const vstat = (float*)(ws + WS_VSTAT); \
    (void)smallf; (void)Wb; (void)XB; (void)Zb; (void)OB; (void)stat_mix; (void)stat_ffn; (void)vstat
#define PH_TID() int tid_ = tid_from_wave(wave_s); asm volatile("" : "+v"(tid_)); const int tid = tid_, lane = tid & 63, wave = __builtin_amdgcn_readfirstlane(tid >> 6), gw = vcu * NWAVES + wave; (void)lane; (void)gw

__global__ void __launch_bounds__(NTHR, 2) fwd_kernel(Args a_unused) {
    extern __shared__ __attribute__((aligned(16))) unsigned char lds_raw[];
    LAS unsigned char* lds = (LAS unsigned char*)lds_raw;
    volatile LAS unsigned* MISC = (volatile LAS unsigned*)(lds + MISC_OFF);
    constexpr int G = 256, NGW = G * NWAVES;
    const int bx = blockIdx.x; __builtin_assume(bx >= 0 && bx < 256);
    const int vcu = (bx & 7) * (G / 8) + (bx >> 3);
    const int wave_s = __builtin_amdgcn_readfirstlane((int)threadIdx.x >> 6);
    if (threadIdx.x < 64) MISC[threadIdx.x] = 0u;
    __syncthreads();
    { const Args a = load_args(); (void)xcd_barrier_post((unsigned*)(a.ws + WS_CTL), MISC + 8, tid_from_wave(wave_s) == 0); }
#define GRID_BAR() do { const Args a_ = load_args(); XcdBarrier b_; b_.bar = (unsigned*)(a_.ws + WS_CTL); b_.x = xb_xcc_id(); b_.st = MISC + 8; int t_ = tid_from_wave(wave_s); asm volatile("" : "+v"(t_)); xcd_barrier(b_, t_ == 0); } while (0)

    {
        PH_ARGS(); PH_TID();
        LAS float* scr = (LAS float*)(lds + wave * 16640);
        constexpr int I_INAB = (D / 64) * (NZ / 64), I_OUTAB = (D / 64) * (D / 64), I_INC = (D / 64) * (4096 / 64), I_OUTC = (CW / 64) * (D / 64), I_GU = (D / 64) * (FF / 64), I_DN = (FF / 64) * (D / 64);
        float* const PF = (float*)(ws + WS_PF);
        constexpr int NITEMS = 2 * I_INAB + 2 * I_OUTAB + 2 * I_INC + 2 * I_OUTC + 8 * I_GU + 4 * I_DN;
        for (int it = gw; it < NITEMS; it += NGW) {
            int r = it;
            if (r < 2 * I_INAB) { const int jj = r / I_INAB; p0_transpose_item(a.w_in_ab + (size_t)jj * D * NZ, D, NZ, Wb + W_INAB + (size_t)jj * NZ * D, 0, jj ? a.ln_ffn_g + 1 * D : nullptr, scr, r % I_INAB, lane, true, jj ? a.ln_ffn_b + 1 * D : nullptr, jj ? PF : nullptr, jj ? PF + (SM_BW_AB1 - SM_GW_AB1) : nullptr); continue; } r -= 2 * I_INAB;
            if (r < 2 * I_OUTAB) { const int jj = r / I_OUTAB; p0_transpose_item(a.w_out_ab + (size_t)jj * D * D, D, D, Wb + W_OUTAB + (size_t)jj * D * D, 0, nullptr, scr, r % I_OUTAB, lane); continue; } r -= 2 * I_OUTAB;
            if (r < 2 * I_INC) { const int jj = r / I_INC; p0_transpose_item(a.w_in_c + (size_t)jj * D * 4096, D, 4096, Wb + W_INC + (size_t)jj * 4096 * D, 0, a.ln_ffn_g + (2 * jj) * D, scr, r % I_INC, lane, true, a.ln_ffn_b + (2 * jj) * D, PF + (SM_GW_C - SM_GW_AB1) + jj * 4096, PF + (SM_BW_C - SM_GW_AB1) + jj * 4096); continue; } r -= 2 * I_INC;
            if (r < 2 * I_OUTC) { const int jj = r / I_OUTC; p0_transpose_item(a.w_out_c + (size_t)jj * CW * D, CW, D, Wb + W_OUTC + (size_t)jj * D * CW, 0, nullptr, scr, r % I_OUTC, lane); continue; } r -= 2 * I_OUTC;
            if (r < 8 * I_GU) { const int L = r / (2 * I_GU), wh = (r / I_GU) & 1; p0_transpose_item((wh ? a.w_up : a.w_gate) + (size_t)L * D * FF, D, FF, Wb + W_GU + (size_t)L * 2 * FF * D, 1 + wh, a.ln_mix_g + L * D, scr, r % I_GU, lane, true, a.ln_mix_b + L * D, PF + (SM_GW_GU - SM_GW_AB1) + L * 5632, PF + (SM_BW_GU - SM_GW_AB1) + L * 5632); continue; } r -= 8 * I_GU;
            { const int L = r / I_DN; p0_transpose_item(a.w_down + (size_t)L * FF * D, FF, D, Wb + W_DN + (size_t)L * D * FF, 0, nullptr, scr, r % I_DN, lane); }
        }
        for (int r = gw; r < 2048; r += NGW) { const float w0 = a.c_ws[(size_t)r * 128 + 2 * lane], w1 = a.c_ws[(size_t)r * 128 + 2 * lane + 1];
            { const int tr = r & 127, sc2 = 2 * lane;
              *(unsigned*)((bf16*)(ws + WS_WSB) + (size_t)(r >> 7) * 16384 + ((((tr >> 5) * 8 + (sc2 >> 4)) * 64) + (tr & 31) + 32 * ((sc2 >> 3) & 1)) * 8 + (sc2 & 7)) = pk2(w0, w1); } const float rs = wave_sum(w0 + w1); if (lane == 0) smallf[SM_RSW + r] = rs; }
        for (int i = bx * NTHR + tid; i < 2048; i += G * NTHR) { const int jj = i >> 10, r = i & 1023; float v = 0.f;
            if (jj == 1) { const float l0 = a.lb_logits[r], l1 = a.lb_logits[1024 + r]; const float mxx = fmaxf(l0, l1), e0 = expf(l0 - mxx), e1 = expf(l1 - mxx); const float p0 = e0 / (e0 + e1), p1 = e1 / (e0 + e1); v = fmaxf((p0 + p1) - p0, 0.f); }
            smallf[SM_LB + i] = v; }
        static_assert(M % (4 * NGW) == 0, "x conversion: 4 rows per wave per step");
        for (int m0 = gw; m0 < M; m0 += 4 * NGW) { f32x4 v[4][4];
#pragma unroll
            for (int q = 0; q < 4; ++q) { const int m = m0 + q * NGW; const float* xr = m < MP ? a.x_prompt + (size_t)m * D : a.x_sample + (size_t)(m - MP) * D; const GAS f32x4* xp = (const GAS f32x4*)xr + lane;
#pragma unroll
                for (int jq = 0; jq < 4; ++jq) v[q][jq] = xp[64 * jq]; }
#pragma unroll
            for (int q = 0; q < 4; ++q) { GAS v2u* o8 = (GAS v2u*)(XB + (size_t)(m0 + q * NGW) * D) + lane;
#pragma unroll
                for (int jq = 0; jq < 4; ++jq) { v2u w; w.x = pk2h(v[q][jq].x, v[q][jq].y); w.y = pk2h(v[q][jq].z, v[q][jq].w); o8[64 * jq] = w; } } }
    }
    GRID_BAR();
    {
        PH_ARGS(); PH_TID(); const float* PF = (const float*)(ws + WS_PF);
        for (int i = bx * NTHR + tid; i < FOLD_N; i += G * NTHR) { float acc = 0.f;
#pragma unroll
            for (int kb = 0; kb < 16; ++kb) acc += PF[(size_t)kb * FOLD_N + i];
            smallf[SM_GW_AB1 + i] = acc; }
    }

    for (int L = 0; L < 4; ++L) {
        const int j = L >> 1;
        if ((L & 1) == 0) {
            { PH_ARGS(); pg8::Gemm g{XB, Wb + W_INAB + (size_t)j * NZ * D, M, NZ, D}; pg8::StaticOrder S; S.init(M, NZ, G, bx);
              pg8::EpiZ E{Zb, NZ, L == 0 ? nullptr : stat_ffn, smallf + SM_GW_AB1, smallf + SM_BW_AB1};
              for (int rep = 0; rep < REP_G; ++rep) pg8::gemm_phase<pg8::EpiZ, pg8::StaticOrder, true, true, true>(lds, g, S, E, wave_s); }
            GRID_BAR();
            { PH_ARGS();
#if NAIVE_HGRN
              for (int u = bx; u < 66; u += G) naive_hgrn_unit(a, u, j, lds, wave_s);
#else
#ifndef SKIP_HA
              for (int rep = 0; rep < REP_HA; ++rep) for (int u = bx; u < 512; u += G) hgrn_a_unit2(a, u, j, lds, wave_s);
#endif
#endif
#if NAIVE_ATTN
              for (int u = bx; u < M / 64; u += G) naive_attn_unit(a, u, j, wave_s);
#else
              for (int rep = 0; rep < REP_ATT; ++rep) for (int u = bx; u < (M / 128) * 2; u += G) attn_unit(a, u, j, lds, wave_s);
#endif
            }
            GRID_BAR();
            { PH_ARGS();
#if NAIVE_HGRN
              naive_hgrn_finish(a, j, vcu, NGW, wave_s);
#else
#ifndef SKIP_HB
              for (int rep = 0; rep < REP_HBC; ++rep) for (int it = bx; it < 256; it += G) hgrn_b_item(a, it, wave_s);
#endif
#endif
            }
            GRID_BAR();
#if !NAIVE_HGRN
            { PH_ARGS();
#ifndef SKIP_HC
              for (int rep = 0; rep < REP_HBC; ++rep) for (int i = 0; i < 5; ++i) hgrn_c_wave4(a, i < 4 ? (bx * 4 + i) * 8 + wave_s : 8192 + bx * 8 + wave_s, j, lds, wave_s);
#endif
            }
            GRID_BAR();
#endif
            { PH_ARGS(); pg8::Gemm g{OB, Wb + W_OUTAB + (size_t)j * D * D, M, D, D}; pg8::StaticOrder S; S.init(M, D, G, bx);
              if (L == 0) { pg8::EpiResid<true> E{nullptr, nullptr, nullptr, XB, stat_mix, nullptr, nullptr, nullptr, ALPHA};
                  pg8::gemm_phase<pg8::EpiResid<true>, pg8::StaticOrder, true, true>(lds, g, S, E, wave_s); }
              else { pg8::EpiResid<false> E{nullptr, nullptr, nullptr, XB, stat_mix, stat_ffn, a.ln_ffn_g + (L - 1) * D, a.ln_ffn_b + (L - 1) * D, ALPHA};
                  pg8::gemm_phase<pg8::EpiResid<false>, pg8::StaticOrder, true, true>(lds, g, S, E, wave_s); } }
            GRID_BAR();
        } else {
            { PH_ARGS(); pg8::Gemm g{XB, Wb + W_INC + (size_t)j * 4096 * D, M, 4096, D}; pg8::StaticOrder S; S.init(M, 4096, G, bx);
              pg8::EpiGeluUV E{Zb, (bf16*)(ws + WS_R1), vstat, stat_ffn, smallf + SM_GW_C + j * 4096, smallf + SM_BW_C + j * 4096};
              for (int rep = 0; rep < REP_G; ++rep) pg8::gemm_phase<pg8::EpiGeluUV, pg8::StaticOrder, true, true, true>(lds, g, S, E, wave_s); }
            GRID_BAR();
            { PH_ARGS();
#if NAIVE_SGU
              for (int u = bx; u < (M / 128) * 8; u += G) naive_sgu_unit(a, u, j, lds, wave_s);
#else
              for (int i5 = 0; i5 < 5; ++i5) {
                  const int pmi = 40 * ((bx >> 2) & 7) + 8 * (4 - i5) + (bx >> 5); sgu_unit4(a, (2 * pmi + ((bx >> 1) & 1)) * 2 + (bx & 1), j, lds, wave_s); }
#endif
            }
            GRID_BAR();
            { PH_ARGS(); pg8::Gemm g{Zb, Wb + W_OUTC + (size_t)j * D * CW, M, D, CW}; pg8::StaticOrder S; S.init(M, D, G, bx);
              pg8::EpiResid<false> E{nullptr, nullptr, nullptr, XB, stat_mix, stat_ffn, a.ln_ffn_g + (L - 1) * D, a.ln_ffn_b + (L - 1) * D, ALPHA};
              pg8::gemm_phase<pg8::EpiResid<false>, pg8::StaticOrder, true, true>(lds, g, S, E, wave_s); }
            GRID_BAR();
        }
        { PH_ARGS(); pg8::Gemm g{XB, Wb + W_GU + (size_t)L * 2 * FF * D, M, 2 * FF, D}; pg8::StaticOrder S; S.init(M, 2 * FF, G, bx);
          pg8::EpiSwiglu E{Zb, stat_mix, smallf + SM_GW_GU + L * 5632, smallf + SM_BW_GU + L * 5632};
          for (int rep = 0; rep < REP_G; ++rep) pg8::gemm_phase<pg8::EpiSwiglu, pg8::StaticOrder, true, true, true>(lds, g, S, E, wave_s); }
        GRID_BAR();
        { PH_ARGS(); pg8::Gemm g{Zb, Wb + W_DN + (size_t)L * D * FF, M, D, FF}; pg8::StaticOrder S; S.init(M, D, G, bx, true);
          pg8::EpiResid<false> E{nullptr, nullptr, nullptr, XB, stat_ffn, stat_mix, a.ln_mix_g + L * D, a.ln_mix_b + L * D, ALPHA};
          pg8::gemm_phase<pg8::EpiResid<false>, pg8::StaticOrder, true, true>(lds, g, S, E, wave_s); }
        GRID_BAR();
    }
    { PH_ARGS(); PH_TID();
      f32x4 gq[4], bq[4];
#pragma unroll
      for (int jq = 0; jq < 4; ++jq) { gq[jq] = *((const f32x4*)(a.ln_ffn_g + 3 * D) + lane + 64 * jq); bq[jq] = *((const f32x4*)(a.ln_ffn_b + 3 * D) + lane + 64 * jq); }
      static_assert(M % (2 * NGW) == 0, "final LayerNorm: two rows per wave per step");
      for (int m0 = gw; m0 < M; m0 += 2 * NGW) {
          v2u xw[2][4]; f32x4 sv[2][8];
#pragma unroll
          for (int rr = 0; rr < 2; ++rr) { const int m = m0 + rr * NGW; const GAS v2u* xq = (const GAS v2u*)(XB + (size_t)m * D) + lane; const f32x4* sp = (const f32x4*)(stat_ffn + (size_t)m * 32);
#pragma unroll
              for (int jq = 0; jq < 4; ++jq) xw[rr][jq] = xq[64 * jq];
#pragma unroll
              for (int i8 = 0; i8 < 8; ++i8) sv[rr][i8] = sp[i8]; }
          __builtin_amdgcn_sched_barrier(0);
#pragma unroll
          for (int rr = 0; rr < 2; ++rr) { const int m = m0 + rr * NGW; float ms = 0.f;
#pragma unroll
              for (int i8 = 0; i8 < 8; ++i8) ms += sv[rr][i8][0] + sv[rr][i8][2];
              const float mu = ms * (1.0f / 16.0f); float q = 0.f;
#pragma unroll
              for (int i8 = 0; i8 < 8; ++i8) { const float d0 = sv[rr][i8][0] - mu, d1 = sv[rr][i8][2] - mu; q += (sv[rr][i8][1] + sv[rr][i8][3]) + 64.0f * (d0 * d0 + d1 * d1); }
              const float rstd = __builtin_amdgcn_rsqf(q * (1.0f / 1024.0f) + pg8::LN_EPS);
              GAS f32x4* op = (GAS f32x4*)(a.out + (size_t)m * D) + lane;
#pragma unroll
              for (int jq = 0; jq < 4; ++jq) { pg8::u32x2 w2; w2.x = xw[rr][jq].x; w2.y = xw[rr][jq].y; const f32x4 v = pg8::f16x4_to_f32(w2); op[64 * jq] = (v - mu) * rstd * gq[jq] + bq[jq]; } } } }
}

extern "C" void kernel_launch(void* const* d_in, const int* in_sizes, int n_in, void* d_out, int out_size, void* d_ws, size_t ws_size, hipStream_t stream) {
    static int grid = 0;
    if (grid == 0) {
        if (n_in != 20 || out_size != M * D || ws_size < WS_END) { fprintf(stderr, "kernel_launch: unexpected shapes (n_in %d out %d ws %zu)\n", n_in, out_size, ws_size); grid = -1; return; }
        int dev = 0, cus = 0, per_cu = 0;
        if (hipGetDevice(&dev) != hipSuccess || hipDeviceGetAttribute(&cus, hipDeviceAttributeMultiprocessorCount, dev) != hipSuccess) { grid = -1; return; }
        if (hipFuncSetAttribute((const void*)fwd_kernel, hipFuncAttributeMaxDynamicSharedMemorySize, LDS_BYTES) != hipSuccess) { fprintf(stderr, "kernel_launch: hipFuncSetAttribute failed\n"); grid = -1; return; }
        if (hipOccupancyMaxActiveBlocksPerMultiprocessor(&per_cu, (const void*)fwd_kernel, NTHR, LDS_BYTES) != hipSuccess || per_cu < 1) fprintf(stderr, "kernel_launch: occupancy query says %d\n", per_cu);
        (void)hipGetLastError();
        if (cus < 256) { fprintf(stderr, "kernel_launch: needs 256 CUs, device has %d\n", cus); grid = -1; return; }
        grid = 256;
    }
    if (grid < 0) return;
    (void)hipMemsetAsync((char*)d_ws + WS_CTL, 0, CTL_ZERO_BYTES, stream);
    Args a{};
    a.x_prompt = (const float*)d_in[0]; a.x_sample = (const float*)d_in[1]; a.w_in_ab = (const float*)d_in[2]; a.lb_logits = (const float*)d_in[3]; a.hgrn_norm_g = (const float*)d_in[4];
    a.attn_sink = (const float*)d_in[5]; a.w_out_ab = (const float*)d_in[6]; a.w_in_c = (const float*)d_in[7]; a.c_ln_g = (const float*)d_in[8]; a.c_ln_b = (const float*)d_in[9];
    a.c_ws = (const float*)d_in[10]; a.c_bs = (const float*)d_in[11]; a.w_out_c = (const float*)d_in[12]; a.w_gate = (const float*)d_in[13]; a.w_up = (const float*)d_in[14];
    a.w_down = (const float*)d_in[15]; a.ln_mix_g = (const float*)d_in[16]; a.ln_mix_b = (const float*)d_in[17]; a.ln_ffn_g = (const float*)d_in[18]; a.ln_ffn_b = (const float*)d_in[19];
    a.out = (float*)d_out; a.ws = (unsigned char*)d_ws;
    hipLaunchKernelGGL(fwd_kernel, dim3(grid), dim3(NTHR), LDS_BYTES, stream, a);
}
```

```cpp
#include <hip/hip_runtime.h>
#include <cstdio>
#include <cstdint>

#ifndef NAIVE_HGRN
#define NAIVE_HGRN 0
#endif
#ifndef NAIVE_ATTN
#define NAIVE_ATTN 0
#endif
#ifndef REP_G
#define REP_G 1
#endif
#ifndef REP_HA
#define REP_HA 1
#endif
#ifndef REP_ATT
#define REP_ATT 1
#endif
#ifndef REP_HBC
#define REP_HBC 1
#endif
#ifndef NAIVE_SGU
#define NAIVE_SGU 0
#endif

__device__ __forceinline__ int tid_from_wave(int wave_s) { return wave_s * 64 + (int)__builtin_amdgcn_mbcnt_hi(~0u, __builtin_amdgcn_mbcnt_lo(~0u, 0u)); }
namespace pg8 {
#define PG8_LAS __attribute__((address_space(3)))
typedef unsigned short bf16_t;
typedef short bf16x8 __attribute__((ext_vector_type(8)));
typedef _Float16 f16x8 __attribute__((ext_vector_type(8)));
typedef _Float16 f16x2 __attribute__((ext_vector_type(2)));
typedef float f32x4 __attribute__((ext_vector_type(4)));
typedef float f32x2 __attribute__((ext_vector_type(2)));
typedef unsigned u32x4 __attribute__((ext_vector_type(4)));
typedef unsigned u32x2 __attribute__((ext_vector_type(2)));
constexpr int BM = 256, BK = 64, HALF = 128, HTB = HALF * BK * 2, STAGE_BYTES = 8 * HTB, NXCD = 8, WGM = 8;

__host__ __device__ __forceinline__ int lds_byte(int r, int c) { const int st = (r >> 4) * 2 + (c >> 5), rr = r & 15, cc = c & 31, ob = rr * 64 + cc * 2; return st * 1024 + (ob ^ (((ob >> 9) & 1) << 5)); }
__host__ __device__ __forceinline__ void stage_rc(int b, int& R, int& C) { const int st = b / 1024, sb = b % 1024, swz = sb ^ (((sb >> 9) & 1) << 5); R = (st >> 1) * 16 + swz / 64; C = (st & 1) * 32 + (swz % 64) / 2; }
__host__ __device__ __forceinline__ int perm32(int rho) { const int n = rho >> 4, i = rho & 15; return 8 * (i >> 2) + 4 * n + (i & 3); }

struct Unit { int pm, pn; };
struct Gemm { const bf16_t* A; const bf16_t* Bt; int M, N, K; };

struct StaticOrder {
    int nM, nN, nwg, G, c; bool rev;
    __host__ __device__ void init(int M, int N, int G_, int c_, bool rev_ = false) { nM = M / BM; nN = N / BM; nwg = nM * nN; G = G_; c = c_; rev = rev_; }
    __host__ __device__ bool next(int i, Unit& u) const {
        const long L = (long)i * G + c; if (L >= nwg) return false;
        int wgid = (int)L; { const int q = nwg / NXCD, r = nwg % NXCD, xcd = wgid % NXCD, off = wgid / NXCD, cnt = xcd < r ? q + 1 : q; wgid = (xcd < r ? xcd * (q + 1) : r * (q + 1) + (xcd - r) * q) + (rev ? cnt - 1 - off : off); }
        const int nig = WGM * nN, gid = wgid / nig, fm = gid * WGM, gsz = (nM - fm) < WGM ? (nM - fm) : WGM;
        u.pm = fm + ((wgid % nig) % gsz); u.pn = (wgid % nig) / gsz; return true;
    }
    __device__ __forceinline__ void a_ready(const Unit&) const {}
    __device__ __forceinline__ void done(const Unit&) const {}
};

typedef __bf16 bf16x2_t __attribute__((ext_vector_type(2)));
__device__ __forceinline__ unsigned cvt_pk_bf16(float lo, float hi) { bf16x2_t v = {(__bf16)lo, (__bf16)hi}; return __builtin_bit_cast(unsigned, v); }
__device__ __forceinline__ f32x2 gelu_pk(f32x2 v) {
    const f32x2 av = __builtin_elementwise_abs(v), d = av * 0.2316418882f + 1.0f;
    f32x2 t; t.x = __builtin_amdgcn_rcpf(d.x); t.y = __builtin_amdgcn_rcpf(d.y);
    f32x2 q = t * 0.5307027145f + (-0.7265760135f); q = q * t + 0.7107068705f; q = q * t + (-0.142248368f); q = q * t + 0.127414796f; q = q * t;
    const f32x2 s = (v * v) * (-0.72134752044f);
    f32x2 e; e.x = __builtin_amdgcn_exp2f(s.x); e.y = __builtin_amdgcn_exp2f(s.y);
    const f32x2 m = v * (q * e), r = v - m;
    f32x2 o; o.x = v.x < 0.f ? m.x : r.x; o.y = v.y < 0.f ? m.y : r.y; return o;
}

constexpr float LN_EPS = 1e-5f;
__device__ __forceinline__ void row_mu_rstd(const float* stat, int row, float& mu, float& rstd) {
    const f32x4* p = (const f32x4*)(stat + (size_t)row * 32);
    f32x4 v[8]; float ms = 0.f;
#pragma unroll
    for (int i = 0; i < 8; ++i) { v[i] = p[i]; ms += v[i][0] + v[i][2]; }
    const float mean = ms * (1.0f / 16.0f); float q = 0.f;
#pragma unroll
    for (int i = 0; i < 8; ++i) { const float d0 = v[i][0] - mean, d1 = v[i][2] - mean; q += (v[i][1] + v[i][3]) + 64.0f * (d0 * d0 + d1 * d1); }
    mu = mean; rstd = __builtin_amdgcn_rsqf(q * (1.0f / 1024.0f) + LN_EPS);
}

constexpr int STAT_TAB_OFF = STAGE_BYTES;
__device__ __forceinline__ float lane_xor1(float x) { return __builtin_bit_cast(float, __builtin_amdgcn_update_dpp(0, __builtin_bit_cast(int, x), 0xB1, 0xF, 0xF, false)); }
__device__ __forceinline__ void stat_tab_build(PG8_LAS unsigned char* lds, const float* stat, int pm, int wr, int wc, int lane) {
    const int lrow = (wc >> 1) * HALF + wr * 64 + (wc & 1) * 32 + (lane >> 1);
    const f32x4* p = (const f32x4*)(stat + (size_t)(pm * BM + lrow) * 32 + (lane & 1) * 16);
    const f32x4 v0 = p[0], v1 = p[1], v2 = p[2], v3 = p[3];
    float ms = ((v0[0] + v0[2]) + (v1[0] + v1[2])) + ((v2[0] + v2[2]) + (v3[0] + v3[2])); ms += lane_xor1(ms);
    const float mean = ms * (1.0f / 16.0f);
    const float d0 = v0[0] - mean, d1 = v0[2] - mean, d2 = v1[0] - mean, d3 = v1[2] - mean, d4 = v2[0] - mean, d5 = v2[2] - mean, d6 = v3[0] - mean, d7 = v3[2] - mean;
    float q = (((v0[1] + v0[3]) + (v1[1] + v1[3])) + ((v2[1] + v2[3]) + (v3[1] + v3[3]))) + 64.0f * (((d0 * d0 + d1 * d1) + (d2 * d2 + d3 * d3)) + ((d4 * d4 + d5 * d5) + (d6 * d6 + d7 * d7)));
    q += lane_xor1(q);
    const float rstd = __builtin_amdgcn_rsqf(q * (1.0f / 1024.0f) + LN_EPS);
    if ((lane & 1) == 0) *(PG8_LAS f32x2*)(lds + STAT_TAB_OFF + lrow * 8) = (f32x2){mean, rstd};
    asm volatile("s_waitcnt lgkmcnt(0)" ::: "memory");
    __builtin_amdgcn_s_barrier();
}
__device__ __forceinline__ void stat_tab_get(PG8_LAS unsigned char* lds, int lrow, float& mu, float& rstd) { const f32x2 t = *(const PG8_LAS f32x2*)(lds + STAT_TAB_OFF + lrow * 8); mu = t.x; rstd = t.y; }
#define RG_ROW(rg) (row0 + ((rg) >> 2) * HALF + ((rg) & 3) * 16)

struct EpiZ {
    static constexpr bool PERM = true, AFTER_DRAIN = false;
    bf16_t* O; int ldc; const float* stat; const float* gW; const float* bW;
    __device__ __forceinline__ void operator()(const f32x4 (&acc)[2][2][4][2], const Unit& u, int wr, int wc, int fr, int fq, PG8_LAS unsigned char* lds, bool tab_valid) const {
        const int row0 = u.pm * BM + wr * 64 + fr, col0 = u.pn * BM + wc * 32 + 8 * fq;
        f32x4 gv[2][2], bv[2][2];
#pragma unroll
        for (int bj = 0; bj < 2; ++bj)
#pragma unroll
            for (int n = 0; n < 2; ++n) { gv[bj][n] = stat ? *(const f32x4*)(gW + col0 + bj * HALF + 4 * n) : (f32x4){0.f, 0.f, 0.f, 0.f}; bv[bj][n] = stat ? *(const f32x4*)(bW + col0 + bj * HALF + 4 * n) : (f32x4){0.f, 0.f, 0.f, 0.f}; }
        if (stat && !tab_valid) stat_tab_build(lds, stat, u.pm, wr, wc, fr + 16 * fq);
#pragma unroll
        for (int rg = 0; rg < 8; ++rg) { const int ai = rg >> 2, m = rg & 3; const int row = RG_ROW(rg); bf16_t* rowp = O + (size_t)row * ldc + col0;
                float mu = 0.f, rstd = 1.f; if (stat) stat_tab_get(lds, row - u.pm * BM, mu, rstd);
#pragma unroll
                for (int bj = 0; bj < 2; ++bj) { const f32x4 v0 = (acc[ai][bj][m][0] - mu * gv[bj][0]) * rstd + bv[bj][0], v1 = (acc[ai][bj][m][1] - mu * gv[bj][1]) * rstd + bv[bj][1];
                    u32x4 w; w.x = cvt_pk_bf16(v0[0], v0[1]); w.y = cvt_pk_bf16(v0[2], v0[3]); w.z = cvt_pk_bf16(v1[0], v1[1]); w.w = cvt_pk_bf16(v1[2], v1[3]);
                    *(u32x4*)(rowp + bj * HALF) = w; }
                asm volatile("" ::: "memory"); }
    }
};
struct EpiGeluUV {
    static constexpr bool PERM = true, AFTER_DRAIN = false;
    bf16_t* U; bf16_t* V; float* vstat; const float* stat; const float* gW; const float* bW;
    __device__ __forceinline__ void operator()(const f32x4 (&acc)[2][2][4][2], const Unit& u, int wr, int wc, int fr, int fq, PG8_LAS unsigned char* lds, bool tab_valid) const {
        const int row0 = u.pm * BM + wr * 64 + fr, col0 = u.pn * BM + wc * 32 + 8 * fq;
        const bool isv = u.pn >= 8; bf16_t* base = isv ? V : U; const int ocol0 = col0 - (isv ? 2048 : 0);
        f32x4 gv[2][2], bv[2][2];
#pragma unroll
        for (int bj = 0; bj < 2; ++bj)
#pragma unroll
            for (int n = 0; n < 2; ++n) { gv[bj][n] = *(const f32x4*)(gW + col0 + bj * HALF + 4 * n); bv[bj][n] = *(const f32x4*)(bW + col0 + bj * HALF + 4 * n); }
        if (!tab_valid) stat_tab_build(lds, stat, u.pm, wr, wc, fr + 16 * fq);
#pragma unroll
        for (int rg = 0; rg < 8; ++rg) { const int ai = rg >> 2, m = rg & 3; const int row = RG_ROW(rg); bf16_t* rowp = base + (size_t)row * 2048 + ocol0;
                float mu, rstd; stat_tab_get(lds, row - u.pm * BM, mu, rstd);
                f32x4 y[2][2];
#pragma unroll
                for (int bj = 0; bj < 2; ++bj) {
#pragma unroll
                    for (int n = 0; n < 2; ++n) { const f32x4 z = (acc[ai][bj][m][n] - mu * gv[bj][n]) * rstd + bv[bj][n];
                        const f32x2 a = gelu_pk((f32x2){z[0], z[1]}), b = gelu_pk((f32x2){z[2], z[3]}); y[bj][n] = (f32x4){a.x, a.y, b.x, b.y}; }
                    u32x4 w; w.x = cvt_pk_bf16(y[bj][0][0], y[bj][0][1]); w.y = cvt_pk_bf16(y[bj][0][2], y[bj][0][3]); w.z = cvt_pk_bf16(y[bj][1][0], y[bj][1][1]); w.w = cvt_pk_bf16(y[bj][1][2], y[bj][1][3]);
                    *(u32x4*)(rowp + bj * HALF) = w; }
                if (isv) {
                    float s = 0.f;
#pragma unroll
                    for (int bj = 0; bj < 2; ++bj)
#pragma unroll
                        for (int n = 0; n < 2; ++n) s += (y[bj][n][0] + y[bj][n][1]) + (y[bj][n][2] + y[bj][n][3]);
                    s += __shfl_xor(s, 16); s += __shfl_xor(s, 32);
                    const float mw = s * (1.0f / 64.0f); float q = 0.f;
#pragma unroll
                    for (int bj = 0; bj < 2; ++bj)
#pragma unroll
                        for (int n = 0; n < 2; ++n) { const f32x4 d = y[bj][n] - mw; q += (d[0] * d[0] + d[1] * d[1]) + (d[2] * d[2] + d[3] * d[3]); }
                    q += __shfl_xor(q, 16); q += __shfl_xor(q, 32);
                    if (fq == 0) *(f32x2*)(vstat + ((size_t)row * 32 + (u.pn - 8) * 4 + wc) * 2) = (f32x2){mw, q};
                }
                asm volatile("" ::: "memory"); }
    }
};
__device__ __forceinline__ float silu_e(float x) { return x * __builtin_amdgcn_rcpf(1.0f + __expf(-x)); }
struct EpiSwiglu {
    static constexpr bool PERM = true, AFTER_DRAIN = false;
    bf16_t* H; const float* stat; const float* gW; const float* bW;
    __device__ __forceinline__ void operator()(const f32x4 (&acc)[2][2][4][2], const Unit& u, int wr, int wc, int fr, int fq, PG8_LAS unsigned char* lds, bool tab_valid) const {
        const int row0 = u.pm * BM + wr * 64 + fr, col0 = u.pn * BM + wc * 32 + 8 * fq, hcol0 = u.pn * HALF + wc * 32 + 8 * fq;
        f32x4 gv[2][2], bv[2][2];
#pragma unroll
        for (int bj = 0; bj < 2; ++bj)
#pragma unroll
            for (int n = 0; n < 2; ++n) { gv[bj][n] = *(const f32x4*)(gW + col0 + bj * HALF + 4 * n); bv[bj][n] = *(const f32x4*)(bW + col0 + bj * HALF + 4 * n); }
        if (!tab_valid) stat_tab_build(lds, stat, u.pm, wr, wc, fr + 16 * fq);
#pragma unroll
        for (int rg = 0; rg < 8; ++rg) { const int ai = rg >> 2, m = rg & 3; const int row = RG_ROW(rg);
                float mu, rstd; stat_tab_get(lds, row - u.pm * BM, mu, rstd);
                f32x4 h[2];
#pragma unroll
                for (int n = 0; n < 2; ++n) { const f32x4 g = (acc[ai][0][m][n] - mu * gv[0][n]) * rstd + bv[0][n], up = (acc[ai][1][m][n] - mu * gv[1][n]) * rstd + bv[1][n];
#pragma unroll
                    for (int j = 0; j < 4; ++j) h[n][j] = silu_e(g[j]) * up[j]; }
                u32x4 w; w.x = cvt_pk_bf16(h[0][0], h[0][1]); w.y = cvt_pk_bf16(h[0][2], h[0][3]); w.z = cvt_pk_bf16(h[1][0], h[1][1]); w.w = cvt_pk_bf16(h[1][2], h[1][3]);
                *(u32x4*)(H + (size_t)row * 2816 + hcol0) = w;
                asm volatile("" ::: "memory"); }
    }
};
__device__ __forceinline__ f32x4 f16x4_to_f32(const u32x2 w) { const unsigned wx = w.x, wy = w.y;
    const f16x2 a = __builtin_bit_cast(f16x2, wx), b = __builtin_bit_cast(f16x2, wy); return (f32x4){(float)a.x, (float)a.y, (float)b.x, (float)b.y}; }
__device__ __forceinline__ unsigned cvt_pk_f16(float lo, float hi) { f16x2 t; t.x = (_Float16)lo; t.y = (_Float16)hi; return __builtin_bit_cast(unsigned, t); }
template <bool F32IN>
struct EpiResid {
    static constexpr bool PERM = true, AFTER_DRAIN = false;
    const float* Xa; const float* Xb; float* out; bf16_t* xb; float* statOut; const float* stat; const float* lg; const float* lb; float alpha;
    __device__ __forceinline__ void operator()(const f32x4 (&acc)[2][2][4][2], const Unit& u, int wr, int wc, int fr, int fq, PG8_LAS unsigned char* lds, bool tab_valid) const {
        const int row0 = u.pm * BM + wr * 64 + fr, col0 = u.pn * BM + wc * 32 + 8 * fq;
        f32x4 gv[2][2], bv[2][2];
        if constexpr (!F32IN) {
#pragma unroll
            for (int bj = 0; bj < 2; ++bj)
#pragma unroll
                for (int n = 0; n < 2; ++n) { gv[bj][n] = *(const f32x4*)(lg + col0 + bj * HALF + 4 * n); bv[bj][n] = *(const f32x4*)(lb + col0 + bj * HALF + 4 * n); }
        }
        const bf16_t* qbase = xb + (size_t)row0 * 1024 + col0;
        u32x4 xq[2][2];
#pragma unroll
        for (int bj = 0; bj < 2; ++bj) xq[0][bj] = *(const u32x4*)(qbase + bj * HALF);
        if constexpr (!F32IN) { if (!tab_valid) stat_tab_build(lds, stat, u.pm, wr, wc, fr + 16 * fq); }
#pragma unroll
        for (int rg = 0; rg < 8; ++rg) { const int ai = rg >> 2, m = rg & 3; const int row = RG_ROW(rg);
                if (rg < 7) { const size_t ro = (size_t)((((rg + 1) >> 2) * HALF + ((rg + 1) & 3) * 16)) * 1024;
#pragma unroll
                    for (int bj = 0; bj < 2; ++bj) xq[(rg + 1) & 1][bj] = *(const u32x4*)(qbase + ro + bj * HALF); }
                float mu = 0.f, rstd = 1.f; if constexpr (!F32IN) stat_tab_get(lds, row - u.pm * BM, mu, rstd);
                f32x4 y[2][2]; float s = 0.f;
#pragma unroll
                for (int bj = 0; bj < 2; ++bj)
#pragma unroll
                    for (int n = 0; n < 2; ++n) { f32x4 xin;
                        { const u32x4 w4 = xq[rg & 1][bj]; u32x2 w2; w2.x = n ? w4.z : w4.x; w2.y = n ? w4.w : w4.y; xin = f16x4_to_f32(w2); if constexpr (!F32IN) xin = (xin - mu) * rstd * gv[bj][n] + bv[bj][n]; }
                        y[bj][n] = alpha * xin + acc[ai][bj][m][n]; s += (y[bj][n][0] + y[bj][n][1]) + (y[bj][n][2] + y[bj][n][3]); }
                s += __shfl_xor(s, 16); s += __shfl_xor(s, 32);
                const float mw = s * (1.0f / 64.0f); float q = 0.f;
#pragma unroll
                for (int bj = 0; bj < 2; ++bj) {
#pragma unroll
                    for (int n = 0; n < 2; ++n) { const f32x4 d = y[bj][n] - mw; q += (d[0] * d[0] + d[1] * d[1]) + (d[2] * d[2] + d[3] * d[3]);
                        if (out) *(f32x4*)(out + (size_t)row * 1024 + col0 + bj * HALF + 4 * n) = y[bj][n]; }
                    u32x4 w; w.x = cvt_pk_f16(y[bj][0][0], y[bj][0][1]); w.y = cvt_pk_f16(y[bj][0][2], y[bj][0][3]); w.z = cvt_pk_f16(y[bj][1][0], y[bj][1][1]); w.w = cvt_pk_f16(y[bj][1][2], y[bj][1][3]);
                    *(u32x4*)(xb + (size_t)row * 1024 + col0 + bj * HALF) = w; }
                q += __shfl_xor(q, 16); q += __shfl_xor(q, 32);
                if (fq == 0) *(f32x2*)(statOut + ((size_t)row * 16 + u.pn * 4 + wc) * 2) = (f32x2){mw, q};
                asm volatile("" ::: "memory"); }
    }
};

template <class Epi, class Sched, bool ALIGN_EPI = false, bool SP2 = false, bool F16 = false>
__device__ __forceinline__ void gemm_phase(PG8_LAS unsigned char* lds, const Gemm g, const Sched& S, const Epi& E, int wave_s) {
    int tid_ = tid_from_wave(wave_s); asm volatile("" : "+v"(tid_));
    const int tid = tid_, wid = __builtin_amdgcn_readfirstlane(tid >> 6), lane = tid & 63, wr = wid >> 2, wc = wid & 3, fr = lane & 15, fq = lane >> 4;
    const int K = g.K, nt = K / BK;
    unsigned voffA[2], voffB[2];
#pragma unroll
    for (int i = 0; i < 2; ++i) { int R, C; stage_rc(tid * 16 + i * 8192, R, C); const int Rb = Epi::PERM ? ((R & ~31) + perm32(R & 31)) : R;
        voffA[i] = (unsigned)(R * K + C) * 2u; voffB[i] = (unsigned)(Rb * K + C) * 2u; }
    const size_t kstep = (size_t)(BK * 2);
    const size_t hstep = (size_t)HALF * K * 2;
    const size_t tstep = 2 * hstep;
    const unsigned ldsw = (unsigned)wid * 1024u;
    const int aoff = lds_byte(wr * 64 + fr, fq * 8), boff = lds_byte(wc * 32 + fr, fq * 8);
#define PG8_SA(b, h) (((b) * 2 + (h)) * HTB)
#define PG8_SB(b, h) ((4 + (b) * 2 + (h)) * HTB)
#define PG8_STAGE(bufoff, gbase, voff) do { _Pragma("unroll") for (int _i = 0; _i < 2; ++_i) \
        __builtin_amdgcn_global_load_lds((const unsigned*)((const char*)(gbase) + (voff)[_i]), (PG8_LAS unsigned*)(lds + (bufoff) + ldsw + _i * 8192), 16, 0, 0); } while (0)
#define PG8_LDA(dst, b, h) do { _Pragma("unroll") for (int m = 0; m < 4; ++m) _Pragma("unroll") for (int k = 0; k < 2; ++k) dst[m][k] = *(const PG8_LAS bf16x8*)(lds + PG8_SA(b, h) + aoff + m * 2048 + k * 1024); } while (0)
#define PG8_LDB(dst, b, h) do { _Pragma("unroll") for (int n = 0; n < 2; ++n) _Pragma("unroll") for (int k = 0; k < 2; ++k) dst[n][k] = *(const PG8_LAS bf16x8*)(lds + PG8_SB(b, h) + boff + n * 2048 + k * 1024); } while (0)
#define PG8_MMA(ai, bj, At, Bt) do { __builtin_amdgcn_s_setprio(1); _Pragma("unroll") for (int m = 0; m < 4; ++m) _Pragma("unroll") for (int n = 0; n < 2; ++n) _Pragma("unroll") for (int k = 0; k < 2; ++k) \
        { if constexpr (F16) acc[ai][bj][m][n] = __builtin_amdgcn_mfma_f32_16x16x32_f16(__builtin_bit_cast(f16x8, Bt[n][k]), __builtin_bit_cast(f16x8, At[m][k]), acc[ai][bj][m][n], 0, 0, 0); \
          else acc[ai][bj][m][n] = __builtin_amdgcn_mfma_f32_16x16x32_bf16(Bt[n][k], At[m][k], acc[ai][bj][m][n], 0, 0, 0); } __builtin_amdgcn_s_setprio(0); } while (0)
#define PG8_WAIT_V(n) asm volatile("s_waitcnt vmcnt(" #n ")" ::: "memory")
#define PG8_WAIT_L(n) asm volatile("s_waitcnt lgkmcnt(" #n ")" ::: "memory")
#define PG8_BAR __builtin_amdgcn_s_barrier()
#define PG8_SCHED __builtin_amdgcn_sched_barrier(0)
    Unit cur, nxt; int ui = 0, tab_pm = -1;
    if (!S.next(0, cur)) return;
    f32x4 acc[2][2][4][2];
#pragma unroll
    for (int a = 0; a < 2; ++a)
#pragma unroll
        for (int b = 0; b < 2; ++b)
#pragma unroll
            for (int m = 0; m < 4; ++m)
#pragma unroll
                for (int n = 0; n < 2; ++n) acc[a][b][m][n] = (f32x4){0.f, 0.f, 0.f, 0.f};
    bf16x8 At[4][2], B0[2][2], B1[2][2];
    const char* cA = (const char*)g.A + (size_t)cur.pm * tstep; const char* cB = (const char*)g.Bt + (size_t)cur.pn * tstep;
    S.a_ready(cur);
    if constexpr (SP2) {
        PG8_STAGE(PG8_SB(0, 0), cB, voffB); PG8_STAGE(PG8_SB(0, 1), cB + hstep, voffB); PG8_STAGE(PG8_SA(0, 0), cA, voffA); PG8_STAGE(PG8_SA(0, 1), cA + hstep, voffA);
        if (wr == 1) PG8_BAR;
        PG8_WAIT_V(2); PG8_BAR;
        PG8_STAGE(PG8_SB(1, 0), cB + kstep, voffB); PG8_STAGE(PG8_SA(1, 0), cA + kstep, voffA); PG8_STAGE(PG8_SB(1, 1), cB + hstep + kstep, voffB);
        PG8_WAIT_V(6); PG8_BAR;
    } else {
        PG8_STAGE(PG8_SB(0, 0), cB, voffB); PG8_STAGE(PG8_SA(0, 0), cA, voffA); PG8_STAGE(PG8_SB(0, 1), cB + hstep, voffB); PG8_STAGE(PG8_SA(0, 1), cA + hstep, voffA);
        if (wr == 1) PG8_BAR;
        PG8_WAIT_V(4); PG8_BAR;
        PG8_STAGE(PG8_SB(1, 0), cB + kstep, voffB); PG8_STAGE(PG8_SA(1, 0), cA + kstep, voffA); PG8_STAGE(PG8_SB(1, 1), cB + hstep + kstep, voffB);
        PG8_WAIT_V(6); PG8_BAR;
    }
    for (;;) {
        const bool has_next = S.next(ui + 1, nxt);
        const char* nA = has_next ? (const char*)g.A + (size_t)nxt.pm * tstep : cA; const char* nB = has_next ? (const char*)g.Bt + (size_t)nxt.pn * tstep : cB;
        for (int t = 0; t < nt; t += 2) {
            const bool last = (t == nt - 2);
            const char* a1 = cA + (size_t)(t + 1) * kstep;
            const char* a2 = last ? nA : cA + (size_t)(t + 2) * kstep; const char* b2 = last ? nB : cB + (size_t)(t + 2) * kstep;
            const char* a3 = a2 + kstep; const char* b3 = b2 + kstep;
            if (last && has_next) S.a_ready(nxt);
            if constexpr (SP2) {
            PG8_LDB(B0, 0, 0); PG8_LDB(B1, 0, 1); PG8_SCHED; PG8_LDA(At, 0, 0); PG8_STAGE(PG8_SA(1, 1), a1 + hstep, voffA);
            PG8_WAIT_V(8); PG8_WAIT_L(0); PG8_BAR; PG8_MMA(0, 0, At, B0); PG8_MMA(0, 1, At, B1); PG8_BAR; PG8_SCHED;
            PG8_LDA(At, 0, 1); PG8_STAGE(PG8_SB(0, 0), b2, voffB); PG8_STAGE(PG8_SB(0, 1), b2 + hstep, voffB); PG8_STAGE(PG8_SA(0, 0), a2, voffA);
            PG8_WAIT_V(8); PG8_WAIT_L(0); PG8_BAR; PG8_MMA(1, 0, At, B0); PG8_MMA(1, 1, At, B1); PG8_BAR; PG8_SCHED;
            PG8_LDB(B0, 1, 0); PG8_LDB(B1, 1, 1); PG8_SCHED; PG8_LDA(At, 1, 0); PG8_STAGE(PG8_SA(0, 1), a2 + hstep, voffA);
            PG8_WAIT_V(8); PG8_WAIT_L(0); PG8_BAR; PG8_MMA(0, 0, At, B0); PG8_MMA(0, 1, At, B1); PG8_BAR; PG8_SCHED;
            PG8_LDA(At, 1, 1); PG8_STAGE(PG8_SB(1, 0), b3, voffB); PG8_STAGE(PG8_SB(1, 1), b3 + hstep, voffB); PG8_STAGE(PG8_SA(1, 0), a3, voffA);
            PG8_WAIT_V(8); PG8_WAIT_L(0); PG8_BAR; PG8_MMA(1, 0, At, B0); PG8_MMA(1, 1, At, B1); PG8_BAR; PG8_SCHED;
            } else {
            PG8_LDB(B0, 0, 0); PG8_SCHED; PG8_LDA(At, 0, 0); PG8_STAGE(PG8_SA(1, 1), a1 + hstep, voffA);
            PG8_WAIT_L(8); PG8_BAR; PG8_WAIT_L(0); PG8_MMA(0, 0, At, B0); PG8_BAR; PG8_SCHED;
            PG8_LDB(B1, 0, 1); PG8_STAGE(PG8_SB(0, 0), b2, voffB);
            PG8_BAR; PG8_WAIT_L(0); PG8_MMA(0, 1, At, B1); PG8_BAR;
            PG8_LDA(At, 0, 1); PG8_STAGE(PG8_SA(0, 0), a2, voffA);
            PG8_BAR; PG8_WAIT_L(0); PG8_MMA(1, 0, At, B0); PG8_BAR; PG8_SCHED;
            PG8_STAGE(PG8_SB(0, 1), b2 + hstep, voffB);
            PG8_WAIT_V(6); PG8_BAR; PG8_MMA(1, 1, At, B1); PG8_BAR;
            PG8_LDB(B0, 1, 0); PG8_SCHED; PG8_LDA(At, 1, 0); PG8_STAGE(PG8_SA(0, 1), a2 + hstep, voffA);
            PG8_WAIT_L(8); PG8_BAR; PG8_WAIT_L(0); PG8_MMA(0, 0, At, B0); PG8_BAR; PG8_SCHED;
            PG8_LDB(B1, 1, 1); PG8_STAGE(PG8_SB(1, 0), b3, voffB);
            PG8_BAR; PG8_WAIT_L(0); PG8_MMA(0, 1, At, B1); PG8_BAR;
            PG8_LDA(At, 1, 1); PG8_STAGE(PG8_SA(1, 0), a3, voffA);
            PG8_BAR; PG8_WAIT_L(0); PG8_MMA(1, 0, At, B0); PG8_BAR; PG8_SCHED;
            PG8_STAGE(PG8_SB(1, 1), b3 + hstep, voffB);
            PG8_WAIT_V(6); PG8_BAR; PG8_MMA(1, 1, At, B1); PG8_BAR;
            }
        }
        if constexpr (ALIGN_EPI) { if (wr == 0) PG8_BAR; }
        if constexpr (!Epi::AFTER_DRAIN) { E(acc, cur, wr, wc, fr, fq, lds, cur.pm == tab_pm); tab_pm = cur.pm; S.done(cur); }
        if (!has_next) break;
#pragma unroll
        for (int a = 0; a < 2; ++a)
#pragma unroll
            for (int b = 0; b < 2; ++b)
#pragma unroll
                for (int m = 0; m < 4; ++m)
#pragma unroll
                    for (int n = 0; n < 2; ++n) acc[a][b][m][n] = (f32x4){0.f, 0.f, 0.f, 0.f};
        cur = nxt; cA = nA; cB = nB; ++ui;
        if constexpr (ALIGN_EPI) { if (wr == 1) PG8_BAR; }
    }
    PG8_WAIT_V(0);
    if constexpr (!ALIGN_EPI) { if (wr == 0) PG8_BAR; }
    PG8_BAR;
#undef PG8_SA
#undef PG8_SB
#undef PG8_STAGE
#undef PG8_LDA
#undef PG8_LDB
#undef PG8_MMA
#undef PG8_WAIT_V
#undef PG8_WAIT_L
#undef PG8_BAR
#undef PG8_SCHED
}
}

__device__ __forceinline__ float silu_f(float x) { return x * __builtin_amdgcn_rcpf(1.0f + __expf(-x)); }
constexpr int NWAVES = 8, NTHR = 512;
constexpr int D = 1024, MP = 65536, MS = 16384, M = MP + MS;
constexpr int AW = 512, NZ = 3328, FF = 2816, CW = 2048;
constexpr int ZQ = 0, ZFF = 512, ZFB = 1024, ZI = 1536, ZG = 2048, ZQB = 2560, ZKB = 3072, ZVB = 3200;
constexpr float ALPHA = 1.681792830507429f, RMS_EPS = 1e-6f;
__device__ __forceinline__ int seq_start(int t) { return t < MP ? (t & ~2047) : MP; }
__device__ __forceinline__ int seq_end(int t) { return t < MP ? (t & ~2047) + 2048 : M; }

constexpr size_t MiB = 1u << 20;
constexpr size_t WS_CTL = 0, CTL_ZERO_BYTES = 64 * 1024;
constexpr size_t WS_SMALL = 1 * MiB;
constexpr size_t SM_LB = 0;
constexpr size_t SM_GW_AB1 = 4096, SM_BW_AB1 = SM_GW_AB1 + 3328;
constexpr size_t SM_GW_C = SM_BW_AB1 + 3328;
constexpr size_t SM_BW_C = SM_GW_C + 2 * 4096;
constexpr size_t SM_GW_GU = SM_BW_C + 2 * 4096;
constexpr size_t SM_BW_GU = SM_GW_GU + 4 * 5632;
constexpr size_t SM_RSW = SM_BW_GU + 4 * 5632;
constexpr size_t SM_TDEC = SM_RSW + 2048;
constexpr size_t SM_END = SM_TDEC + 1280 * 128;
constexpr int FOLD_N = (int)(SM_RSW - SM_GW_AB1);
constexpr size_t WS_PF = 3 * MiB + 512 * 1024;
static_assert(WS_PF + 16ull * FOLD_N * 4 <= 8 * MiB, "fold partials");
static_assert(SM_END * 4 <= 2 * MiB, "small region");
constexpr size_t WS_WSB = 3 * MiB;
constexpr size_t WS_STATMIX = 8 * MiB, WS_STATFFN = 18 * MiB, WS_VSTAT = 28 * MiB;
constexpr size_t WS_W = 48 * MiB;
constexpr size_t W_INAB = 0, W_OUTAB = W_INAB + 2ull * NZ * D, W_INC = W_OUTAB + 2ull * D * D, W_OUTC = W_INC + 2ull * 4096 * D, W_GU = W_OUTC + 2ull * D * CW, W_DN = W_GU + 4ull * 2 * FF * D, W_END = W_DN + 4ull * D * FF;
static_assert(W_END * 2 <= 108 * MiB, "weights");
constexpr size_t WS_XB = 156 * MiB;
constexpr size_t WS_Z = 316 * MiB;
constexpr size_t WS_R1 = 836 * MiB;
constexpr size_t WS_OB = WS_R1, WS_QT = WS_R1 + 160 * MiB;
constexpr size_t WS_F = 1156 * MiB, WS_SIN = 1236 * MiB, WS_END = 1276 * MiB;

constexpr int LDS_BYTES = 163840;
constexpr int MISC_OFF = 163840 - 256;

#define GAS __attribute__((address_space(1)))
#define LAS __attribute__((address_space(3)))
typedef unsigned short bf16;
typedef unsigned v4u __attribute__((ext_vector_type(4)));
typedef unsigned v2u __attribute__((ext_vector_type(2)));
typedef float f32x4 __attribute__((ext_vector_type(4)));
typedef short bf16x8 __attribute__((ext_vector_type(8)));
typedef GAS unsigned gu32;
#define RLX_AGENT __ATOMIC_RELAXED, __HIP_MEMORY_SCOPE_AGENT
#define LDS_WAIT() asm volatile("s_waitcnt lgkmcnt(0)" ::: "memory")
#define LDS_SYNC() do { asm volatile("s_waitcnt lgkmcnt(0)" ::: "memory"); __builtin_amdgcn_s_barrier(); asm volatile("" ::: "memory"); } while (0)
#define VM_WAIT() asm volatile("s_waitcnt vmcnt(0)" ::: "memory")
__device__ __forceinline__ unsigned f2bf(float f) { unsigned u = __builtin_bit_cast(unsigned, f); return (u + 0x7fffu + ((u >> 16) & 1u)) >> 16; }
__device__ __forceinline__ unsigned pk2(float lo, float hi) { return f2bf(lo) | (f2bf(hi) << 16); }
__device__ __forceinline__ unsigned pk2h(float lo, float hi) { pg8::f16x2 t; t.x = (_Float16)lo; t.y = (_Float16)hi; return __builtin_bit_cast(unsigned, t); }
__device__ __forceinline__ float bf2f(unsigned short b) { return __builtin_bit_cast(float, (unsigned)b << 16); }
__device__ __forceinline__ float bflo(unsigned w) { return __builtin_bit_cast(float, w << 16); }
__device__ __forceinline__ float bfhi(unsigned w) { return __builtin_bit_cast(float, w & 0xffff0000u); }

#define XB_TMO      128
#define XB_XCNT(j)  (256  + 64 * (j))
#define XB_XSUB(j)  (1280 + 64 * (j))
#define XB_XGEN(j)  (2304 + 64 * (j))
#define XB_TOP      3328
#define XB_TOPGEN   3392
#define XCD_BAR_WORDS 3456
#define XB_SPIN_CAP (1u << 22)
__device__ __forceinline__ unsigned xb_ld(unsigned* p)              { return __hip_atomic_load(p, __ATOMIC_RELAXED, __HIP_MEMORY_SCOPE_AGENT); }
__device__ __forceinline__ unsigned xb_add(unsigned* p, unsigned v) { return __hip_atomic_fetch_add(p, v, __ATOMIC_RELAXED, __HIP_MEMORY_SCOPE_AGENT); }
__device__ __forceinline__ unsigned xb_xcc_id() { return (unsigned)__builtin_amdgcn_s_getreg((3 << 11) | 20) & 0xFu; }
#define XB_SPIN(cond, bar) do { unsigned _sp = 0; while (cond) { __builtin_amdgcn_s_sleep(1); \
    if ((++_sp & 255u) == 0u) { if (xb_ld(&(bar)[XB_TMO])) break; if (_sp > XB_SPIN_CAP) { atomicAdd(&(bar)[XB_TMO], 1u); break; } } } } while (0)
struct XcdBarrier { unsigned* bar; unsigned x; volatile LAS unsigned* st; };
__device__ __forceinline__ XcdBarrier xcd_barrier_post(unsigned* bar, volatile LAS unsigned* st, bool is_t0) {
    XcdBarrier b; b.bar = bar; b.x = xb_xcc_id(); b.st = st;
    if (is_t0) (void)xb_add(&bar[XB_XCNT(b.x)], 1u);
    return b;
}
__device__ __forceinline__ void xcd_barrier_complete(unsigned* bar, unsigned x, unsigned& nloc, unsigned& nx) {
    const unsigned G = gridDim.x * gridDim.y * gridDim.z;
    unsigned sum, cnt, mine, sp = 0u;
    for (;;) {
        sum = 0u; cnt = 0u; mine = 0u;
#pragma unroll
        for (unsigned j = 0; j < 16; ++j) { const unsigned c = xb_ld(&bar[XB_XCNT(j)]); sum += c; cnt += (c > 0u) ? 1u : 0u; mine = (j == x) ? c : mine; }
        if (sum == G) break;
        __builtin_amdgcn_s_sleep(1);
        if ((++sp & 255u) == 0u) { if (xb_ld(&bar[XB_TMO])) break; if (sp > XB_SPIN_CAP) { atomicAdd(&bar[XB_TMO], 1u); break; } }
    }
    nloc = mine > 0u ? mine : 1u; nx = cnt > 0u ? cnt : 1u;
}
__device__ __forceinline__ void xcd_barrier(const XcdBarrier& b, bool is_t0) {
    asm volatile("s_waitcnt vmcnt(0)" ::: "memory");
    __syncthreads();
    if (is_t0) {
        unsigned* bar = b.bar;
        __builtin_amdgcn_s_waitcnt(0);
        unsigned nloc = b.st[0], nx = b.st[1];
        if (nloc == 0u) { xcd_barrier_complete(bar, b.x, nloc, nx); b.st[0] = nloc; b.st[1] = nx; }
        const unsigned old = xb_add(&bar[XB_XSUB(b.x)], 1u);
        const unsigned gen = old / nloc;
        if (old + 1u == (gen + 1u) * nloc) {
            __builtin_amdgcn_fence(__ATOMIC_RELEASE, "agent");
            asm volatile("s_waitcnt vmcnt(0)" ::: "memory");
            const unsigned og = xb_add(&bar[XB_TOP], 1u);
            const unsigned tg = og / nx;
            if (og + 1u == (tg + 1u) * nx) xb_add(&bar[XB_TOPGEN], 1u);
            else XB_SPIN(xb_ld(&bar[XB_TOPGEN]) == tg, bar);
            __builtin_amdgcn_fence(__ATOMIC_ACQUIRE, "agent");
            xb_add(&bar[XB_XGEN(b.x)], 1u);
            asm volatile("s_waitcnt vmcnt(0)" ::: "memory");
        } else {
            XB_SPIN(xb_ld(&bar[XB_XGEN(b.x)]) == gen, bar);
            __builtin_amdgcn_fence(__ATOMIC_ACQUIRE, "agent");
            asm volatile("s_waitcnt vmcnt(0)" ::: "memory");
        }
    }
    __syncthreads();
}

struct Args {
    const float* x_prompt; const float* x_sample; const float* w_in_ab; const float* lb_logits; const float* hgrn_norm_g; const float* attn_sink; const float* w_out_ab;
    const float* w_in_c; const float* c_ln_g; const float* c_ln_b; const float* c_ws; const float* c_bs; const float* w_out_c;
    const float* w_gate; const float* w_up; const float* w_down; const float* ln_mix_g; const float* ln_mix_b; const float* ln_ffn_g; const float* ln_ffn_b;
    float* out; unsigned char* ws;
};

__device__ __forceinline__ float wave_sum(float v) {
#pragma unroll
    for (int o = 1; o < 64; o <<= 1) v += __shfl_xor(v, o);
    return v;
}

__device__ __forceinline__ int rowmap(int n, int mode) { return mode == 0 ? n : (256 * (n >> 7) + (n & 127) + (mode == 2 ? 128 : 0)); }
__device__ __forceinline__ void p0_transpose_item(const float* W, int K, int N, bf16* WT, int mode, const float* scale, LAS float* scr, int item, int lane, bool f16 = false, const float* bvec = nullptr, float* pg = nullptr, float* pb = nullptr) {
    const int nblk = N / 64, kb = item / nblk, nb = item % nblk, k0 = 64 * kb, n0 = 64 * nb;
    float sg = 0.f, sb = 0.f;
    const float scv = scale ? scale[k0 + lane] : 1.0f, bvv = bvec ? bvec[k0 + lane] : 0.0f;
    float wv[64];
#pragma unroll
    for (int kk = 0; kk < 64; ++kk) wv[kk] = W[(size_t)(k0 + kk) * N + n0 + lane];
    __builtin_amdgcn_sched_barrier(0);
#pragma unroll
    for (int kk = 0; kk < 64; ++kk) { const float sc = __builtin_bit_cast(float, __builtin_amdgcn_readlane(__builtin_bit_cast(int, scv), kk)); const float w = wv[kk]; scr[kk * 65 + lane] = w * sc;
        if (pg) { sg += w * sc; sb += w * __builtin_bit_cast(float, __builtin_amdgcn_readlane(__builtin_bit_cast(int, bvv), kk)); } }
    if (pg) { const size_t o = (size_t)kb * FOLD_N + rowmap(n0 + lane, mode); pg[o] = sg; pb[o] = sb; }
    LDS_WAIT(); asm volatile("" ::: "memory");
    const int c = lane & 7;
#pragma unroll
    for (int j = 0; j < 8; ++j) { const int n = (lane >> 3) + 8 * j; const LAS float* s = scr + (8 * c) * 65 + n;
        v4u o; if (f16) { o.x = pk2h(s[0 * 65], s[1 * 65]); o.y = pk2h(s[2 * 65], s[3 * 65]); o.z = pk2h(s[4 * 65], s[5 * 65]); o.w = pk2h(s[6 * 65], s[7 * 65]); }
        else { o.x = pk2(s[0 * 65], s[1 * 65]); o.y = pk2(s[2 * 65], s[3 * 65]); o.z = pk2(s[4 * 65], s[5 * 65]); o.w = pk2(s[6 * 65], s[7 * 65]); }
        *(GAS v4u*)(WT + (size_t)rowmap(n0 + n, mode) * K + k0 + 8 * c) = o; }
    LDS_WAIT(); asm volatile("" ::: "memory");
}
__device__ __forceinline__ void p0_fold_item(const float* W, int N, const float* g, const float* b, float* gW, float* bW, int mode, int item, int lane) {
    const int n = item * 64 + lane; float sg = 0.f, sb = 0.f;
#pragma unroll 32
    for (int k = 0; k < 1024; ++k) { const float w = W[(size_t)k * N + n]; sg += g[k] * w; sb += b[k] * w; }
    gW[rowmap(n, mode)] = sg; bW[rowmap(n, mode)] = sb;
}

__device__ __forceinline__ void naive_hgrn_unit(const Args& a, int unit, int j, LAS unsigned char* lds, int wave_s) {
    const bf16* Z = (const bf16*)(a.ws + WS_Z); bf16* OP = (bf16*)a.out; const float* lbv = (const float*)(a.ws + WS_SMALL) + SM_LB + (size_t)j * 1024;
    int tid_ = tid_from_wave(wave_s); asm volatile("" : "+v"(tid_)); const int tid = tid_, grp = tid >> 7, e = tid & 127;
    int seq, h, dir;
    if (unit < 64) { const int ch = unit * 4 + grp; seq = ch >> 3; h = (ch >> 1) & 3; dir = ch & 1; } else { const int ch = (unit - 64) * 4 + grp; seq = 32; h = ch >> 1; dir = ch & 1; }
    const int t0 = seq < 32 ? seq * 2048 : MP, len = seq < 32 ? 2048 : MS;
    const float lb = lbv[dir * 512 + h * 128 + e], oml = 1.0f - lb;
    LAS float* sq = (LAS float*)lds + grp * (3 * 16 * 128); LAS float* sf = sq + 16 * 128; LAS float* sk = sf + 16 * 128;
    float S[128];
#pragma unroll
    for (int i = 0; i < 128; ++i) S[i] = 0.f;
    for (int tb = 0; tb < len; tb += 16) {
        float v[16];
#pragma unroll
        for (int i = 0; i < 16; ++i) { const int tok = dir == 0 ? t0 + tb + i : t0 + len - 1 - tb - i; const bf16* zr = Z + (size_t)tok * NZ + h * 128 + e;
            const float qr = bf2f(zr[ZQ]), fr = bf2f(zr[dir == 0 ? ZFF : ZFB]); v[i] = bf2f(zr[ZI]);
            const float sg = 1.0f / (1.0f + expf(-fr));
            sq[i * 128 + e] = qr / (1.0f + expf(-qr)); sf[i * 128 + e] = lb + oml * sg; sk[i * 128 + e] = oml * (1.0f - sg); }
        __syncthreads();
        for (int i = 0; i < 16; ++i) { const int tok = dir == 0 ? t0 + tb + i : t0 + len - 1 - tb - i; float o = 0.f; const float vi = v[0];
#pragma unroll
            for (int d4 = 0; d4 < 32; ++d4) { const f32x4 q4 = *(const LAS f32x4*)(sq + i * 128 + d4 * 4), f4 = *(const LAS f32x4*)(sf + i * 128 + d4 * 4), k4 = *(const LAS f32x4*)(sk + i * 128 + d4 * 4);
#pragma unroll
                for (int jj = 0; jj < 4; ++jj) { S[d4 * 4 + jj] = f4[jj] * S[d4 * 4 + jj] + k4[jj] * vi; o += q4[jj] * S[d4 * 4 + jj]; } }
            OP[((size_t)dir * M + tok) * 512 + h * 128 + e] = (bf16)f2bf(o);
#pragma unroll
            for (int s = 0; s < 15; ++s) v[s] = v[s + 1]; }
        __syncthreads();
    }
}
__device__ __forceinline__ void naive_hgrn_finish(const Args& a, int j, int vcu, int ngw, int wave_s) {
    int tid_ = tid_from_wave(wave_s); asm volatile("" : "+v"(tid_)); const int lane = tid_ & 63, gw = vcu * NWAVES + __builtin_amdgcn_readfirstlane(tid_ >> 6);
    const bf16* Z = (const bf16*)(a.ws + WS_Z); const bf16* OP = (const bf16*)a.out; bf16* OB = (bf16*)(a.ws + WS_OB); const float* ng = a.hgrn_norm_g + j * 128;
    for (int it = gw; it < M * 4; it += ngw) { const int tok = it >> 2, h = it & 3; const size_t o0 = (size_t)tok * 512 + h * 128 + 2 * lane;
        const unsigned w0 = *(const unsigned*)(OP + o0), w1 = *(const unsigned*)(OP + (size_t)M * 512 + o0);
        const float x0 = bflo(w0) + bflo(w1), x1 = bfhi(w0) + bfhi(w1);
        const float ss = wave_sum(x0 * x0 + x1 * x1); const float r = 1.0f / sqrtf(ss * (1.0f / 128.0f) + RMS_EPS);
        const unsigned gw2 = *(const unsigned*)(Z + (size_t)tok * NZ + ZG + h * 128 + 2 * lane); const float g0 = bflo(gw2), g1 = bfhi(gw2);
        const float y0 = x0 * r * ng[2 * lane] * (g0 / (1.0f + expf(-g0))), y1 = x1 * r * ng[2 * lane + 1] * (g1 / (1.0f + expf(-g1)));
        *(unsigned*)(OB + (size_t)tok * 1024 + h * 128 + 2 * lane) = pk2(y0, y1); }
}
__device__ __forceinline__ void naive_attn_unit(const Args& a, int unit, int j, int wave_s) {
    const bf16* Z = (const bf16*)(a.ws + WS_Z); bf16* OB = (bf16*)(a.ws + WS_OB);
    int tid_ = tid_from_wave(wave_s); asm volatile("" : "+v"(tid_)); const int tid = tid_, hq = tid & 7, t = unit * 64 + (tid >> 3), kvh = hq >> 2;
    const float slope = exp2f(-(float)(hq + 1)), sink = a.attn_sink[j * 8 + hq];
    float q[64], o[64];
    { const v4u* qp = (const v4u*)(Z + (size_t)t * NZ + ZQB + hq * 64);
#pragma unroll
      for (int i = 0; i < 8; ++i) { const v4u w = qp[i]; q[8 * i] = bflo(w.x); q[8 * i + 1] = bfhi(w.x); q[8 * i + 2] = bflo(w.y); q[8 * i + 3] = bfhi(w.y); q[8 * i + 4] = bflo(w.z); q[8 * i + 5] = bfhi(w.z); q[8 * i + 6] = bflo(w.w); q[8 * i + 7] = bfhi(w.w); } }
#pragma unroll
    for (int i = 0; i < 64; ++i) o[i] = 0.f;
    float mx = sink, l = 1.0f;
    const int s0 = seq_start(t), s1 = seq_end(t);
    for (int dlt = -128; dlt <= 128; ++dlt) { const int s = t + dlt; if (s < s0 || s >= s1) continue;
        const v4u* kp = (const v4u*)(Z + (size_t)s * NZ + ZKB + kvh * 64); float sc = 0.f;
#pragma unroll
        for (int i = 0; i < 8; ++i) { const v4u w = kp[i]; sc += q[8 * i] * bflo(w.x) + q[8 * i + 1] * bfhi(w.x) + q[8 * i + 2] * bflo(w.y) + q[8 * i + 3] * bfhi(w.y) + q[8 * i + 4] * bflo(w.z) + q[8 * i + 5] * bfhi(w.z) + q[8 * i + 6] * bflo(w.w) + q[8 * i + 7] * bfhi(w.w); }
        sc = sc * 0.125f - slope * fabsf((float)dlt);
        const float mn = fmaxf(mx, sc), cf = expf(mx - mn), p = expf(sc - mn); l = l * cf + p; mx = mn;
        const v4u* vp = (const v4u*)(Z + (size_t)s * NZ + ZVB + kvh * 64);
#pragma unroll
        for (int i = 0; i < 8; ++i) { const v4u w = vp[i]; o[8 * i] = o[8 * i] * cf + p * bflo(w.x); o[8 * i + 1] = o[8 * i + 1] * cf + p * bfhi(w.x); o[8 * i + 2] = o[8 * i + 2] * cf + p * bflo(w.y); o[8 * i + 3] = o[8 * i + 3] * cf + p * bfhi(w.y);
            o[8 * i + 4] = o[8 * i + 4] * cf + p * bflo(w.z); o[8 * i + 5] = o[8 * i + 5] * cf + p * bfhi(w.z); o[8 * i + 6] = o[8 * i + 6] * cf + p * bflo(w.w); o[8 * i + 7] = o[8 * i + 7] * cf + p * bfhi(w.w); } }
    const float inv = 1.0f / l; v4u* op = (v4u*)(OB + (size_t)t * 1024 + 512 + hq * 64);
#pragma unroll
    for (int i = 0; i < 8; ++i) { v4u w; w.x = pk2(o[8 * i] * inv, o[8 * i + 1] * inv); w.y = pk2(o[8 * i + 2] * inv, o[8 * i + 3] * inv); w.z = pk2(o[8 * i + 4] * inv, o[8 * i + 5] * inv); w.w = pk2(o[8 * i + 6] * inv, o[8 * i + 7] * inv); op[i] = w; }
}
__device__ __forceinline__ void vrow_mu_rstd(const float* vstat, int row, float& mu, float& rstd) {
    const f32x4* p = (const f32x4*)(vstat + (size_t)row * 64); float ms = 0.f; f32x4 v[16];
#pragma unroll
    for (int i = 0; i < 16; ++i) v[i] = p[i];
    __builtin_amdgcn_sched_barrier(0);
#pragma unroll
    for (int i = 0; i < 16; ++i) ms += v[i][0] + v[i][2];
    const float mean = ms * (1.0f / 32.0f); float q = 0.f;
#pragma unroll
    for (int i = 0; i < 16; ++i) { const float d0 = v[i][0] - mean, d1 = v[i][2] - mean; q += (v[i][1] + v[i][3]) + 64.0f * (d0 * d0 + d1 * d1); }
    mu = mean; rstd = 1.0f / sqrtf(q * (1.0f / 2048.0f) + pg8::LN_EPS);
}
__device__ __forceinline__ void naive_sgu_unit(const Args& a, int unit, int j, LAS unsigned char* lds, int wave_s) {
    int tid_ = tid_from_wave(wave_s); asm volatile("" : "+v"(tid_)); const int chunk = unit >> 3, g = unit & 7, tid = tid_, ch = tid & 255, half = tid >> 8;
    bf16* U = (bf16*)(a.ws + WS_Z); const bf16* V = (const bf16*)(a.ws + WS_R1); const float* vstat = (const float*)(a.ws + WS_VSTAT);
    LAS float* vn = (LAS float*)lds; LAS float* st = vn + 128 * 256;
    const int tok0 = chunk * 128;
    __syncthreads();
    if (tid < 128) { float mu, rstd; vrow_mu_rstd(vstat, tok0 + tid, mu, rstd); st[2 * tid] = mu; st[2 * tid + 1] = rstd; }
    __syncthreads();
    const float cg = a.c_ln_g[j * 2048 + g * 256 + ch], cb = a.c_ln_b[j * 2048 + g * 256 + ch];
    for (int s = half; s < 128; s += 2) vn[s * 256 + ch] = (bf2f(V[(size_t)(tok0 + s) * 2048 + g * 256 + ch]) - st[2 * s]) * st[2 * s + 1] * cg + cb;
    __syncthreads();
    const float* Wg = a.c_ws + ((size_t)(j * 8 + g) * 128) * 128;
    for (int t = half * 64; t < half * 64 + 64; ++t) { float acc = 0.f; const float* wr = Wg + (size_t)t * 128;
#pragma unroll 8
        for (int s = 0; s < 128; ++s) acc += wr[s] * vn[s * 256 + ch];
        acc += a.c_bs[(j * 8 + g) * 128 + t];
        bf16* up = U + (size_t)(tok0 + t) * 2048 + g * 256 + ch; *up = (bf16)f2bf(bf2f(*up) * acc); }
}


typedef float f32x16 __attribute__((ext_vector_type(16)));
__device__ __forceinline__ unsigned cvtpk(float lo, float hi) { return pg8::cvt_pk_bf16(lo, hi); }
__device__ __forceinline__ float max_xor32(float x) { const unsigned xi = __builtin_bit_cast(unsigned, x); const auto r = __builtin_amdgcn_permlane32_swap(xi, xi, false, false); const unsigned a = r[0], b = r[1]; return fmaxf(__builtin_bit_cast(float, a), __builtin_bit_cast(float, b)); }
__device__ __forceinline__ float sum_xor32(float x) { const unsigned xi = __builtin_bit_cast(unsigned, x); const auto r = __builtin_amdgcn_permlane32_swap(xi, xi, false, false); const unsigned a = r[0], b = r[1]; return __builtin_bit_cast(float, a) + __builtin_bit_cast(float, b); }
__device__ __forceinline__ v4u widen_pair(v2u a, v2u b) {
    const auto r0 = __builtin_amdgcn_permlane32_swap(a.x, b.x, false, false); const auto r1 = __builtin_amdgcn_permlane32_swap(a.y, b.y, false, false);
    const unsigned ax = r0[0], bx = r0[1], ay = r1[0], by = r1[1];
    return (v4u){ax, ay, bx, by};
}

__device__ __forceinline__ void sgu_unit(const Args& a, int unit, int j, LAS unsigned char* lds, int wave_s) {
    int tid_ = tid_from_wave(wave_s); asm volatile("" : "+v"(tid_)); const int tid = tid_, lane = tid & 63, wave = __builtin_amdgcn_readfirstlane(tid >> 6), l31 = lane & 31, h = lane >> 5;
    const int chunk = unit >> 3, g = unit & 7, tok0 = chunk * 128;
    bf16* U = (bf16*)(a.ws + WS_Z); const bf16* V = (const bf16*)(a.ws + WS_R1); const float* vstat = (const float*)(a.ws + WS_VSTAT);
    const bf16* Wsb = (const bf16*)(a.ws + WS_WSB) + (size_t)(j * 8 + g) * 128 * 128;
    const float* rsw = (const float*)(a.ws + WS_SMALL) + SM_RSW + (j * 8 + g) * 128; const float* bs = a.c_bs + (j * 8 + g) * 128;
    LAS float* st = (LAS float*)(lds + 65536);
    __syncthreads();
    if (tid < 128) { float mu, rstd; vrow_mu_rstd(vstat, tok0 + tid, mu, rstd); st[2 * tid] = mu; st[2 * tid + 1] = rstd; }
    __syncthreads();
#pragma unroll
    for (int it = 0; it < 8; ++it) { const int p = tid & 7, sl = (it >> 2) * 64 + (tid >> 3), c0 = (it & 3) * 64 + 8 * p;
        const v4u w = *(const v4u*)(V + (size_t)(tok0 + sl) * 2048 + g * 256 + c0); const float mu = st[2 * sl], rstd = st[2 * sl + 1];
        const unsigned ww[4] = {w.x, w.y, w.z, w.w};
#pragma unroll
        for (int i = 0; i < 8; ++i) { const int c = c0 + i; const float x = (i & 1) ? bfhi(ww[i >> 1]) : bflo(ww[i >> 1]);
            const unsigned short ob = (unsigned short)f2bf((x - mu) * rstd);
            *(LAS unsigned short*)(lds + c * 256 + ((((sl >> 3) ^ ((c ^ (c >> 3)) & 15))) << 4) + (sl & 7) * 2) = ob; } }
    __syncthreads();
    const int tt = wave & 3, cq = wave >> 2, t = 32 * tt + l31;
    bf16x8 bw[8];
#pragma unroll
    for (int kk = 0; kk < 8; ++kk) bw[kk] = *(const bf16x8*)(Wsb + (size_t)t * 128 + 16 * kk + 8 * h);
    f32x16 acc[4];
#pragma unroll
    for (int i = 0; i < 4; ++i) { acc[i] = (f32x16){0.f, 0.f, 0.f, 0.f, 0.f, 0.f, 0.f, 0.f, 0.f, 0.f, 0.f, 0.f, 0.f, 0.f, 0.f, 0.f};
        const int c = 32 * (4 * cq + i) + l31, sw = (c ^ (c >> 3)) & 15;
#pragma unroll
        for (int kk = 0; kk < 8; ++kk) { const bf16x8 af = *(const LAS bf16x8*)(lds + c * 256 + (((2 * kk + h) ^ sw) << 4));
            acc[i] = __builtin_amdgcn_mfma_f32_32x32x16_bf16(af, bw[kk], acc[i], 0, 0, 0); } }
    const float rswt = rsw[t], bst = bs[t];
    bf16* urow = U + (size_t)(tok0 + t) * 2048 + g * 256; const float* cgp = a.c_ln_g + j * 2048 + g * 256; const float* cbp = a.c_ln_b + j * 2048 + g * 256;
#pragma unroll
    for (int i = 0; i < 4; ++i)
#pragma unroll
        for (int qd = 0; qd < 4; ++qd) { const int c = 32 * (4 * cq + i) + 8 * qd + 4 * h;
            const v2u uw = *(const v2u*)(urow + c); const f32x4 cg4 = *(const f32x4*)(cgp + c), cb4 = *(const f32x4*)(cbp + c);
            const float o0 = bflo(uw.x) * (cg4[0] * acc[i][4 * qd + 0] + cb4[0] * rswt + bst), o1 = bfhi(uw.x) * (cg4[1] * acc[i][4 * qd + 1] + cb4[1] * rswt + bst);
            const float o2 = bflo(uw.y) * (cg4[2] * acc[i][4 * qd + 2] + cb4[2] * rswt + bst), o3 = bfhi(uw.y) * (cg4[3] * acc[i][4 * qd + 3] + cb4[3] * rswt + bst);
            v2u ow; ow.x = cvtpk(o0, o1); ow.y = cvtpk(o2, o3); *(v2u*)(urow + c) = ow; }
}

__device__ __forceinline__ void sgu_unit2(const Args& a, int unit, int j, LAS unsigned char* lds, int wave_s) {
    int tid_ = tid_from_wave(wave_s); asm volatile("" : "+v"(tid_)); const int tid = tid_, lane = tid & 63, wave = __builtin_amdgcn_readfirstlane(tid >> 6), l31 = lane & 31, h = lane >> 5;
    const int chunk = unit >> 1, g0 = (unit & 1) * 4, tok0 = chunk * 128;
    bf16* U = (bf16*)(a.ws + WS_Z); const bf16* V = (const bf16*)(a.ws + WS_R1); const float* vstat = (const float*)(a.ws + WS_VSTAT);
    LAS float* st = (LAS float*)(lds + 131072);
    __syncthreads();
    if (tid < 128) { float mu, rstd; vrow_mu_rstd(vstat, tok0 + tid, mu, rstd); st[2 * tid] = mu; st[2 * tid + 1] = rstd; }
    const int tt = wave & 3, cq = wave >> 2, t = 32 * tt + l31;
    v4u vreg[8];
#pragma unroll
    for (int it = 0; it < 8; ++it) { const int sl = (it >> 2) * 64 + (tid >> 3), c0 = (it & 3) * 64 + 8 * (tid & 7); vreg[it] = *(const v4u*)(V + (size_t)(tok0 + sl) * 2048 + g0 * 256 + c0); }
    __syncthreads();
    for (int k = 0; k < 4; ++k) {
        const int g = g0 + k; LAS unsigned char* buf = lds + (k & 1) * 65536;
        const float* cgp = a.c_ln_g + j * 2048 + g * 256; const float* cbp = a.c_ln_b + j * 2048 + g * 256;
        int tk = tid; asm volatile("" : "+v"(tk)); const int p = tk & 7;
#pragma unroll
        for (int it = 0; it < 8; ++it) { const int sl = (it >> 2) * 64 + (tk >> 3), c0 = (it & 3) * 64 + 8 * p; const float mu = st[2 * sl], rstd = st[2 * sl + 1];
            const f32x4 ga = *(const f32x4*)(cgp + c0), gb = *(const f32x4*)(cgp + c0 + 4); const float gg[8] = {ga[0], ga[1], ga[2], ga[3], gb[0], gb[1], gb[2], gb[3]};
            const unsigned ww[4] = {vreg[it].x, vreg[it].y, vreg[it].z, vreg[it].w};
#pragma unroll
            for (int i = 0; i < 8; ++i) { const int c = c0 + i; const float x = (i & 1) ? bfhi(ww[i >> 1]) : bflo(ww[i >> 1]);
                *(LAS unsigned short*)(buf + c * 256 + ((((sl >> 3) ^ ((c ^ (c >> 3)) & 15))) << 4) + (sl & 7) * 2) = (unsigned short)f2bf((x - mu) * rstd * gg[i]); } }
        __syncthreads();
        const bf16* Wsb = (const bf16*)(a.ws + WS_WSB) + (size_t)(j * 8 + g) * 128 * 128;
        bf16x8 bw[8];
#pragma unroll
        for (int kk = 0; kk < 8; ++kk) bw[kk] = *(const bf16x8*)(Wsb + (size_t)t * 128 + 16 * kk + 8 * h);
        f32x16 acc[4];
#pragma unroll
        for (int i = 0; i < 4; ++i) { acc[i] = (f32x16){0.f, 0.f, 0.f, 0.f, 0.f, 0.f, 0.f, 0.f, 0.f, 0.f, 0.f, 0.f, 0.f, 0.f, 0.f, 0.f};
            const int c = 32 * (4 * cq + i) + l31, sw = (c ^ (c >> 3)) & 15;
#pragma unroll
            for (int kk = 0; kk < 8; ++kk) { const bf16x8 af = *(const LAS bf16x8*)(buf + c * 256 + (((2 * kk + h) ^ sw) << 4));
                acc[i] = __builtin_amdgcn_mfma_f32_32x32x16_bf16(af, bw[kk], acc[i], 0, 0, 0); } }
        if (k < 3) {
#pragma unroll
            for (int it = 0; it < 8; ++it) { const int sl = (it >> 2) * 64 + (tk >> 3), c0 = (it & 3) * 64 + 8 * p; vreg[it] = *(const v4u*)(V + (size_t)(tok0 + sl) * 2048 + (g + 1) * 256 + c0); } }
        const float rswt = ((const float*)(a.ws + WS_SMALL))[SM_RSW + (j * 8 + g) * 128 + t], bst = a.c_bs[(j * 8 + g) * 128 + t];
        bf16* urow = U + (size_t)(tok0 + t) * 2048 + g * 256;
#pragma unroll
        for (int i = 0; i < 4; ++i)
#pragma unroll
            for (int qd = 0; qd < 4; ++qd) { const int c = 32 * (4 * cq + i) + 8 * qd + 4 * h;
                const v2u uw = *(const v2u*)(urow + c); const f32x4 cb4 = *(const f32x4*)(cbp + c);
                const float o0 = bflo(uw.x) * (acc[i][4 * qd + 0] + cb4[0] * rswt + bst), o1 = bfhi(uw.x) * (acc[i][4 * qd + 1] + cb4[1] * rswt + bst);
                const float o2 = bflo(uw.y) * (acc[i][4 * qd + 2] + cb4[2] * rswt + bst), o3 = bfhi(uw.y) * (acc[i][4 * qd + 3] + cb4[3] * rswt + bst);
                v2u ow; ow.x = cvtpk(o0, o1); ow.y = cvtpk(o2, o3); *(v2u*)(urow + c) = ow; }
    }
}

typedef short s16x4 __attribute__((ext_vector_type(4)));
__device__ __forceinline__ unsigned sgu_off_b(unsigned row, unsigned ch) { return 256u * row + 16u * (ch ^ (((row & 3) << 2) | ((row >> 2) & 3))); }
__device__ __forceinline__ s16x4 sgu_tr(const LAS unsigned char* p) { return __builtin_amdgcn_ds_read_tr16_b64_v4i16((LAS s16x4*)p); }
__device__ __forceinline__ void sgu_unit3(const Args& a, int unit, int j, LAS unsigned char* lds, int wave_s) {
    int tid_ = tid_from_wave(wave_s); asm volatile("" : "+v"(tid_)); const int tid = tid_, lane = tid & 63, wave = __builtin_amdgcn_readfirstlane(tid >> 6), l31 = lane & 31, h = lane >> 5;
    const int chunk = unit >> 1, g0 = (unit & 1) * 4, tok0 = chunk * 128;
    bf16* U = (bf16*)(a.ws + WS_Z); const bf16* V = (const bf16*)(a.ws + WS_R1); const float* vstat = (const float*)(a.ws + WS_VSTAT);
    LAS float* st = (LAS float*)(lds + 131072);
    __syncthreads();
    if (tid < 128) { float mu, rstd; vrow_mu_rstd(vstat, tok0 + tid, mu, rstd); st[2 * tid] = mu; st[2 * tid + 1] = rstd; }
    const int tt = wave & 3, cq = wave >> 2, t = 32 * tt + l31;
    v4u vreg[8];
#pragma unroll
    for (int it = 0; it < 8; ++it) { const int sl = (it >> 2) * 64 + (tid >> 3), c0 = (it & 3) * 64 + 8 * (tid & 7); vreg[it] = *(const v4u*)(V + (size_t)(tok0 + sl) * 2048 + g0 * 256 + c0); }
    __syncthreads();
    for (int k = 0; k < 4; ++k) {
        const int g = g0 + k; LAS unsigned char* buf = lds + (k & 1) * 65536;
        const float* cgp = a.c_ln_g + j * 2048 + g * 256; const float* cbp = a.c_ln_b + j * 2048 + g * 256;
        int tk = tid; asm volatile("" : "+v"(tk)); const int p = tk & 7;
#pragma unroll
        for (int it = 0; it < 8; ++it) { const int sl = (it >> 2) * 64 + (tk >> 3), c0 = (it & 3) * 64 + 8 * p; const float mu = st[2 * sl], rstd = st[2 * sl + 1];
            const f32x4 ga = *(const f32x4*)(cgp + c0), gb = *(const f32x4*)(cgp + c0 + 4);
            const unsigned w0 = vreg[it].x, w1 = vreg[it].y, w2 = vreg[it].z, w3 = vreg[it].w;
            v4u o; o.x = cvtpk((bflo(w0) - mu) * rstd * ga[0], (bfhi(w0) - mu) * rstd * ga[1]); o.y = cvtpk((bflo(w1) - mu) * rstd * ga[2], (bfhi(w1) - mu) * rstd * ga[3]);
            o.z = cvtpk((bflo(w2) - mu) * rstd * gb[0], (bfhi(w2) - mu) * rstd * gb[1]); o.w = cvtpk((bflo(w3) - mu) * rstd * gb[2], (bfhi(w3) - mu) * rstd * gb[3]);
            *(LAS v4u*)(buf + ((it & 3) >> 1) * 32768 + sgu_off_b((unsigned)sl, (unsigned)((it & 1) * 8 + p))) = o; }
        __syncthreads();
        const bf16* Wsb = (const bf16*)(a.ws + WS_WSB) + (size_t)(j * 8 + g) * 128 * 128;
        bf16x8 bw[8];
#pragma unroll
        for (int kk = 0; kk < 8; ++kk) bw[kk] = *(const bf16x8*)(Wsb + (size_t)t * 128 + 16 * kk + 8 * h);
        f32x16 acc[4];
#pragma unroll
        for (int i = 0; i < 4; ++i) { acc[i] = (f32x16){0.f, 0.f, 0.f, 0.f, 0.f, 0.f, 0.f, 0.f, 0.f, 0.f, 0.f, 0.f, 0.f, 0.f, 0.f, 0.f};
            const int ct = 4 * cq + i; const unsigned lq = (unsigned)(lane & 15) >> 2, lp = (unsigned)lane & 3, lblk = ((unsigned)lane >> 4) & 1;
            const LAS unsigned char* ib = buf + (ct >> 2) * 32768;
            const unsigned a0 = sgu_off_b(8u * h + lq, 4u * (ct & 3) + 2u * lblk + (lp >> 1)) + 8u * (lp & 1), a1 = sgu_off_b(8u * h + 4u + lq, 4u * (ct & 3) + 2u * lblk + (lp >> 1)) + 8u * (lp & 1);
#pragma unroll
            for (int kk = 0; kk < 8; ++kk) { const s16x4 lo = sgu_tr(ib + a0 + kk * 4096), hi = sgu_tr(ib + a1 + kk * 4096);
                const bf16x8 af = __builtin_shufflevector(lo, hi, 0, 1, 2, 3, 4, 5, 6, 7);
                acc[i] = __builtin_amdgcn_mfma_f32_32x32x16_bf16(af, bw[kk], acc[i], 0, 0, 0); } }
        if (k < 3) {
#pragma unroll
            for (int it = 0; it < 8; ++it) { const int sl = (it >> 2) * 64 + (tk >> 3), c0 = (it & 3) * 64 + 8 * p; vreg[it] = *(const v4u*)(V + (size_t)(tok0 + sl) * 2048 + (g + 1) * 256 + c0); } }
        const float rswt = ((const float*)(a.ws + WS_SMALL))[SM_RSW + (j * 8 + g) * 128 + t], bst = a.c_bs[(j * 8 + g) * 128 + t];
        bf16* urow = U + (size_t)(tok0 + t) * 2048 + g * 256;
#pragma unroll
        for (int i = 0; i < 4; ++i)
#pragma unroll
            for (int qd = 0; qd < 4; ++qd) { const int c = 32 * (4 * cq + i) + 8 * qd + 4 * h;
                const v2u uw = *(const v2u*)(urow + c); const f32x4 cb4 = *(const f32x4*)(cbp + c);
                const float o0 = bflo(uw.x) * (acc[i][4 * qd + 0] + cb4[0] * rswt + bst), o1 = bfhi(uw.x) * (acc[i][4 * qd + 1] + cb4[1] * rswt + bst);
                const float o2 = bflo(uw.y) * (acc[i][4 * qd + 2] + cb4[2] * rswt + bst), o3 = bfhi(uw.y) * (acc[i][4 * qd + 3] + cb4[3] * rswt + bst);
                v2u ow; ow.x = cvtpk(o0, o1); ow.y = cvtpk(o2, o3); *(v2u*)(urow + c) = ow; }
    }
}

__device__ __forceinline__ void sgu_unit4(const Args& a, int unit, int j, LAS unsigned char* lds, int wave_s) {
    int tid_ = tid_from_wave(wave_s); asm volatile("" : "+v"(tid_)); const int tid = tid_, lane = tid & 63, wave = __builtin_amdgcn_readfirstlane(tid >> 6), l31 = lane & 31, h = lane >> 5;
    const int chunk = unit >> 1, g0 = (unit & 1) * 4, tok0 = chunk * 128;
    bf16* U = (bf16*)(a.ws + WS_Z); const bf16* V = (const bf16*)(a.ws + WS_R1); const float* vstat = (const float*)(a.ws + WS_VSTAT);
    LAS float* st = (LAS float*)(lds + 131072);
    __syncthreads();
    const int tt = wave & 3, cq = wave >> 2, t = 32 * tt + l31;
    v4u vreg[8];
#pragma unroll
    for (int it = 0; it < 8; ++it) { const int sl = (it >> 2) * 64 + (tid >> 3), c0 = (it & 3) * 64 + 8 * (tid & 7); vreg[it] = *(const v4u*)(V + (size_t)(tok0 + sl) * 2048 + g0 * 256 + c0); }
#define cgL ((LAS float*)(lds + 132096))
#define cbL ((LAS float*)(lds + 136192))
#define rsL ((LAS float*)(lds + 140288))
#define bsL ((LAS float*)(lds + 142336))
    if (tid < 128) { float mu, rstd; vrow_mu_rstd(vstat, tok0 + tid, mu, rstd); st[2 * tid] = mu; st[2 * tid + 1] = rstd; }
    { const float c0v = a.c_ln_g[j * 2048 + g0 * 256 + tid], c1v = a.c_ln_g[j * 2048 + g0 * 256 + 512 + tid], b0v = a.c_ln_b[j * 2048 + g0 * 256 + tid], b1v = a.c_ln_b[j * 2048 + g0 * 256 + 512 + tid];
      const float rv = ((const float*)(a.ws + WS_SMALL))[SM_RSW + (j * 8 + g0) * 128 + tid], sv = a.c_bs[(j * 8 + g0) * 128 + tid];
      cgL[tid] = c0v; cgL[512 + tid] = c1v; cbL[tid] = b0v; cbL[512 + tid] = b1v; rsL[tid] = rv; bsL[tid] = sv; }
    __syncthreads();
    for (int k = 0; k < 4; ++k) {
        const int g = g0 + k; LAS unsigned char* buf = lds + (k & 1) * 65536;
        bf16* ubase = U + (size_t)(tok0 + 32 * tt + 4 * h) * 2048 + g * 256 + 128 * cq + 2 * l31;
        unsigned uwv[16][2];
#pragma unroll
        for (int r = 0; r < 16; ++r)
#pragma unroll
            for (int u = 0; u < 2; ++u) uwv[r][u] = *(const unsigned*)(ubase + (size_t)(8 * (r >> 2) + (r & 3)) * 2048 + 64 * u);
        int tk = tid; asm volatile("" : "+v"(tk)); const int p = tk & 7;
#pragma unroll
        for (int it = 0; it < 8; ++it) { const int sl = (it >> 2) * 64 + (tk >> 3), c0 = (it & 3) * 64 + 8 * p; const float mu = st[2 * sl], rstd = st[2 * sl + 1];
            const f32x4 ga = *(const LAS f32x4*)(cgL + k * 256 + c0), gb = *(const LAS f32x4*)(cgL + k * 256 + c0 + 4);
            const unsigned w0 = vreg[it].x, w1 = vreg[it].y, w2 = vreg[it].z, w3 = vreg[it].w;
            const float e0 = (bflo(w0) - mu) * rstd * ga[0], e1 = (bfhi(w0) - mu) * rstd * ga[1], e2 = (bflo(w1) - mu) * rstd * ga[2], e3 = (bfhi(w1) - mu) * rstd * ga[3];
            const float e4 = (bflo(w2) - mu) * rstd * gb[0], e5 = (bfhi(w2) - mu) * rstd * gb[1], e6 = (bflo(w3) - mu) * rstd * gb[2], e7 = (bfhi(w3) - mu) * rstd * gb[3];
            v2u ev, od; ev.x = cvtpk(e0, e2); ev.y = cvtpk(e4, e6); od.x = cvtpk(e1, e3); od.y = cvtpk(e5, e7);
            LAS unsigned char* ib = buf + ((it & 3) >> 1) * 32768 + 8 * (p & 1);
            *(LAS v2u*)(ib + sgu_off_b((unsigned)sl, (unsigned)((it & 1) * 8 + (p >> 1)))) = ev; *(LAS v2u*)(ib + sgu_off_b((unsigned)sl, (unsigned)((it & 1) * 8 + 4 + (p >> 1)))) = od; }
        const bf16* Wsb = (const bf16*)(a.ws + WS_WSB) + (size_t)(j * 8 + g) * 128 * 128;
        bf16x8 bw[8];
#pragma unroll
        for (int kk = 0; kk < 8; ++kk) bw[kk] = *(const bf16x8*)(Wsb + (size_t)((tt * 8 + kk) * 64 + lane) * 8);
        if (k < 3) {
#pragma unroll
            for (int it = 0; it < 8; ++it) { const int sl = (it >> 2) * 64 + (tk >> 3), c0 = (it & 3) * 64 + 8 * p; vreg[it] = *(const v4u*)(V + (size_t)(tok0 + sl) * 2048 + (g + 1) * 256 + c0); } }
        LDS_SYNC();
        f32x16 acc[4];
#pragma unroll
        for (int i = 0; i < 4; ++i) { acc[i] = (f32x16){0.f, 0.f, 0.f, 0.f, 0.f, 0.f, 0.f, 0.f, 0.f, 0.f, 0.f, 0.f, 0.f, 0.f, 0.f, 0.f};
            const int ct = 4 * cq + i; const unsigned lq = (unsigned)(lane & 15) >> 2, lp = (unsigned)lane & 3, lblk = ((unsigned)lane >> 4) & 1;
            const LAS unsigned char* ib = buf + (ct >> 2) * 32768;
            const unsigned a0 = sgu_off_b(8u * h + lq, 4u * (ct & 3) + 2u * lblk + (lp >> 1)) + 8u * (lp & 1), a1 = sgu_off_b(8u * h + 4u + lq, 4u * (ct & 3) + 2u * lblk + (lp >> 1)) + 8u * (lp & 1);
#pragma unroll
            for (int kk = 0; kk < 8; ++kk) { const s16x4 lo = sgu_tr(ib + a0 + kk * 4096), hi = sgu_tr(ib + a1 + kk * 4096);
                const bf16x8 af = __builtin_shufflevector(lo, hi, 0, 1, 2, 3, 4, 5, 6, 7);
                acc[i] = __builtin_amdgcn_mfma_f32_32x32x16_bf16(bw[kk], af, acc[i], 0, 0, 0); } }
        const LAS float* rswp = rsL + k * 128 + 32 * tt + 4 * h; const LAS float* bsp = bsL + k * 128 + 32 * tt + 4 * h;
        pg8::f32x2 cb2[2];
#pragma unroll
        for (int u = 0; u < 2; ++u) cb2[u] = *(const LAS pg8::f32x2*)(cbL + k * 256 + 64 * (2 * cq + u) + 2 * l31);
#pragma unroll
        for (int rq = 0; rq < 4; ++rq) { const f32x4 rs4 = *(const LAS f32x4*)(rswp + 8 * rq), bs4 = *(const LAS f32x4*)(bsp + 8 * rq);
#pragma unroll
            for (int rr = 0; rr < 4; ++rr)
#pragma unroll
                for (int u = 0; u < 2; ++u) { unsigned* up = (unsigned*)(ubase + (size_t)(8 * rq + rr) * 2048 + 64 * u); const unsigned uw = uwv[4 * rq + rr][u];
                    const float o0 = bflo(uw) * (acc[2 * u][4 * rq + rr] + cb2[u].x * rs4[rr] + bs4[rr]), o1 = bfhi(uw) * (acc[2 * u + 1][4 * rq + rr] + cb2[u].y * rs4[rr] + bs4[rr]);
                    *up = cvtpk(o0, o1); } }
    }
}
#undef cgL
#undef cbL
#undef rsL
#undef bsL

constexpr int ATT_VT_OFF = 49152, ATT_VT_PITCH = 776;
__device__ __forceinline__ void attn_unit(const Args& a, int unit, int j, LAS unsigned char* lds, int wave_s) {
    int tid_ = tid_from_wave(wave_s); asm volatile("" : "+v"(tid_)); const int tid = tid_, lane = tid & 63, wave = __builtin_amdgcn_readfirstlane(tid >> 6), l31 = lane & 31, h = lane >> 5;
    const bf16* Z = (const bf16*)(a.ws + WS_Z); bf16* OB = (bf16*)(a.ws + WS_OB);
    const int blk = unit >> 1, kvh = unit & 1, t0 = blk * 128, ss = seq_start(t0), se = seq_end(t0), kbase = t0 - 128;
    __syncthreads();
    v4u kwv[6], vwv[6];
#pragma unroll
    for (int it = 0; it < 6; ++it) { const int idx = it * 512 + tid, row = idx >> 3, q = idx & 7; int sr = kbase + row; sr = sr < ss ? ss : sr; sr = sr > se - 1 ? se - 1 : sr;
        kwv[it] = *(const v4u*)(Z + (size_t)sr * NZ + ZKB + kvh * 64 + 8 * q); vwv[it] = *(const v4u*)(Z + (size_t)sr * NZ + ZVB + kvh * 64 + 8 * q); }
    bf16x8 qfa[2][4];
#pragma unroll
    for (int qi = 0; qi < 2; ++qi) { const int qt = wave * 2 + qi, hq = kvh * 4 + (qt >> 2), tq = t0 + 32 * (qt & 3) + l31;
#pragma unroll
        for (int kk = 0; kk < 4; ++kk) qfa[qi][kk] = *(const bf16x8*)(Z + (size_t)tq * NZ + ZQB + hq * 64 + 16 * kk + 8 * h); }
    __builtin_amdgcn_sched_barrier(0);
#pragma unroll
    for (int it = 0; it < 6; ++it) { const int idx = it * 512 + tid, row = idx >> 3, q = idx & 7, sx = kbase + row; const bool ok = sx >= ss && sx < se;
        const v4u zero4 = (v4u){0u, 0u, 0u, 0u}; const v4u kw = ok ? kwv[it] : zero4, vw = ok ? vwv[it] : zero4;
        *(LAS v4u*)(lds + row * 128 + ((q ^ ((row >> 1) & 7)) << 4)) = kw;
        const unsigned ww[4] = {vw.x, vw.y, vw.z, vw.w};
#pragma unroll
        for (int i = 0; i < 8; ++i) *(LAS unsigned short*)(lds + ATT_VT_OFF + (8 * q + i) * ATT_VT_PITCH + row * 2) = (unsigned short)((i & 1) ? (ww[i >> 1] >> 16) : (ww[i >> 1] & 0xffffu)); }
    __syncthreads();
    const float ninf = -__builtin_inff(); const bool edge = !(kbase >= ss && kbase + 384 <= se);
    for (int qi = 0; qi < 2; ++qi) {
        const int qt = wave * 2 + qi, g = qt >> 2, sb = qt & 3, hq = kvh * 4 + g, tq = t0 + 32 * sb + l31;
        const float slope = exp2f(-(float)(hq + 1)), sink = a.attn_sink[j * 8 + hq];
        bf16x8 qf[4];
#pragma unroll
        for (int kk = 0; kk < 4; ++kk) qf[kk] = qi ? qfa[1][kk] : qfa[0][kk];
        float m = sink, lsum = h == 0 ? 1.0f : 0.0f;
        f32x16 o0 = (f32x16){0.f, 0.f, 0.f, 0.f, 0.f, 0.f, 0.f, 0.f, 0.f, 0.f, 0.f, 0.f, 0.f, 0.f, 0.f, 0.f}, o1 = o0;
        for (int kt = sb; kt < sb + 9; ++kt) {
            f32x16 sc = (f32x16){0.f, 0.f, 0.f, 0.f, 0.f, 0.f, 0.f, 0.f, 0.f, 0.f, 0.f, 0.f, 0.f, 0.f, 0.f, 0.f};
            const int row = 32 * kt + l31, rsw = (row >> 1) & 7;
#pragma unroll
            for (int kk = 0; kk < 4; ++kk) { const bf16x8 kf = *(const LAS bf16x8*)(lds + row * 128 + (((2 * kk + h) ^ rsw) << 4)); sc = __builtin_amdgcn_mfma_f32_32x32x16_bf16(kf, qf[kk], sc, 0, 0, 0); }
            float mx = m;
            if (edge || kt == sb || kt == sb + 8) {
#pragma unroll
                for (int r = 0; r < 16; ++r) { const int s = kbase + 32 * kt + (r & 3) + 8 * (r >> 2) + 4 * h; const int dd = tq - s, dist = dd < 0 ? -dd : dd;
                    const bool ok = dist <= 128 && s >= ss && s < se; const float v = ok ? sc[r] * 0.125f - slope * (float)dist : ninf; sc[r] = v; mx = fmaxf(mx, v); }
            } else {
                const float fd = (float)(tq - (kbase + 32 * kt) - 4 * h);
#pragma unroll
                for (int r = 0; r < 16; ++r) { const float v = sc[r] * 0.125f - slope * fabsf(fd - (float)((r & 3) + 8 * (r >> 2))); sc[r] = v; mx = fmaxf(mx, v); }
            }
            mx = max_xor32(mx);
            const float cf = __expf(m - mx); m = mx; lsum *= cf; o0 = o0 * cf; o1 = o1 * cf;
#pragma unroll
            for (int r = 0; r < 16; ++r) { sc[r] = __expf(sc[r] - m); lsum += sc[r]; }
            bf16x8 pf[2];
#pragma unroll
            for (int sp = 0; sp < 2; ++sp) { v4u w; w.x = cvtpk(sc[8 * sp + 0], sc[8 * sp + 1]); w.y = cvtpk(sc[8 * sp + 2], sc[8 * sp + 3]); w.z = cvtpk(sc[8 * sp + 4], sc[8 * sp + 5]); w.w = cvtpk(sc[8 * sp + 6], sc[8 * sp + 7]); pf[sp] = __builtin_bit_cast(bf16x8, w); }
#pragma unroll
            for (int sp = 0; sp < 2; ++sp) {
                const int ko = (32 * kt + 16 * sp + 4 * h) * 2;
                { const LAS unsigned char* vp = lds + ATT_VT_OFF + l31 * ATT_VT_PITCH + ko; const v2u lo = *(const LAS v2u*)vp, hi = *(const LAS v2u*)(vp + 16); const v4u w = (v4u){lo.x, lo.y, hi.x, hi.y};
                  o0 = __builtin_amdgcn_mfma_f32_32x32x16_bf16(__builtin_bit_cast(bf16x8, w), pf[sp], o0, 0, 0, 0); }
                { const LAS unsigned char* vp = lds + ATT_VT_OFF + (32 + l31) * ATT_VT_PITCH + ko; const v2u lo = *(const LAS v2u*)vp, hi = *(const LAS v2u*)(vp + 16); const v4u w = (v4u){lo.x, lo.y, hi.x, hi.y};
                  o1 = __builtin_amdgcn_mfma_f32_32x32x16_bf16(__builtin_bit_cast(bf16x8, w), pf[sp], o1, 0, 0, 0); } }
        }
        lsum = sum_xor32(lsum); const float inv = 1.0f / lsum;
        bf16* orow = OB + (size_t)tq * 1024 + 512 + hq * 64;
#pragma unroll
        for (int qp = 0; qp < 2; ++qp) { v2u a0, a1, b0, b1;
            a0.x = cvtpk(o0[8 * qp] * inv, o0[8 * qp + 1] * inv); a0.y = cvtpk(o0[8 * qp + 2] * inv, o0[8 * qp + 3] * inv); a1.x = cvtpk(o0[8 * qp + 4] * inv, o0[8 * qp + 5] * inv); a1.y = cvtpk(o0[8 * qp + 6] * inv, o0[8 * qp + 7] * inv);
            b0.x = cvtpk(o1[8 * qp] * inv, o1[8 * qp + 1] * inv); b0.y = cvtpk(o1[8 * qp + 2] * inv, o1[8 * qp + 3] * inv); b1.x = cvtpk(o1[8 * qp + 4] * inv, o1[8 * qp + 5] * inv); b1.y = cvtpk(o1[8 * qp + 6] * inv, o1[8 * qp + 7] * inv);
            *(v4u*)(orow + 16 * qp + 8 * h) = widen_pair(a0, a1); *(v4u*)(orow + 32 + 16 * qp + 8 * h) = widen_pair(b0, b1); }
    }
}


constexpr int HA_G = 0, HA_T = 32768, HA_QT = 34816, HA_KT = HA_QT + 17408, HA_QF = HA_KT + 17408, HA_KE = HA_QF + 17408, HA_VT = HA_KE + 17408, HA_ST = HA_VT + 17408, HA_END = HA_ST + 34816;
static_assert(HA_END <= MISC_OFF, "HGRN level A LDS map");
__device__ __forceinline__ void hgrn_a_unit(const Args& a, int unit, int j, LAS unsigned char* lds, int wave_s) {
    int tid_ = tid_from_wave(wave_s); asm volatile("" : "+v"(tid_)); const int tid = tid_, lane = tid & 63, wave = __builtin_amdgcn_readfirstlane(tid >> 6), l31 = lane & 31, h = lane >> 5;
    const int sc = unit >> 3, hh = (unit >> 1) & 3, dir = unit & 1, scbase = sc * 512;
    const bf16* Z = (const bf16*)(a.ws + WS_Z); bf16* OP = (bf16*)a.out + (size_t)dir * M * 512; bf16* QTg = (bf16*)(a.ws + WS_QT) + (size_t)dir * M * 512;
    float* Fo = (float*)(a.ws + WS_F) + (size_t)unit * 16384; float* Td = (float*)(a.ws + WS_SMALL) + SM_TDEC + (size_t)unit * 128;
    const float* lbv = (const float*)(a.ws + WS_SMALL) + SM_LB + (size_t)j * 1024 + dir * 512 + hh * 128;
    const int ri = tid >> 3, d0 = (tid & 7) * 16, cd = tid & 127, rg = tid >> 7, ti = wave >> 2, ej = wave & 3;
    LAS float* Gm = (LAS float*)(lds + HA_G); LAS float* Tm = (LAS float*)(lds + HA_T);
    float lb16[16], Bc[16];
#pragma unroll
    for (int e = 0; e < 16; ++e) { lb16[e] = lbv[d0 + e]; Bc[e] = 0.f; }
    const f32x16 zero16 = (f32x16){0.f, 0.f, 0.f, 0.f, 0.f, 0.f, 0.f, 0.f, 0.f, 0.f, 0.f, 0.f, 0.f, 0.f, 0.f, 0.f};
    f32x16 sacc0 = zero16, sacc1 = zero16;
    __syncthreads();
    for (int i = tid; i < 34816 / 16; i += NTHR) *(LAS v4u*)(lds + HA_ST + 16 * i) = (v4u){0u, 0u, 0u, 0u};
    __syncthreads();
    for (int cc = 0; cc < 8; ++cc) {
        const int tok = dir == 0 ? scbase + 64 * cc + ri : scbase + 511 - 64 * cc - ri;
        float q[16], kk[16]; unsigned vraw[8];
        {
            const bf16* zr = Z + (size_t)tok * NZ + hh * 128 + d0;
            const v4u qa = *(const v4u*)(zr + ZQ), qb = *(const v4u*)(zr + ZQ + 8), fa = *(const v4u*)(zr + (dir == 0 ? ZFF : ZFB)), fb = *(const v4u*)(zr + (dir == 0 ? ZFF : ZFB) + 8), va = *(const v4u*)(zr + ZI), vb = *(const v4u*)(zr + ZI + 8);
            const unsigned qw[8] = {qa.x, qa.y, qa.z, qa.w, qb.x, qb.y, qb.z, qb.w}, fw[8] = {fa.x, fa.y, fa.z, fa.w, fb.x, fb.y, fb.z, fb.w};
            vraw[0] = va.x; vraw[1] = va.y; vraw[2] = va.z; vraw[3] = va.w; vraw[4] = vb.x; vraw[5] = vb.y; vraw[6] = vb.z; vraw[7] = vb.w;
            float lf[16];
#pragma unroll
            for (int e = 0; e < 16; ++e) { const float qr = (e & 1) ? bfhi(qw[e >> 1]) : bflo(qw[e >> 1]), fr = (e & 1) ? bfhi(fw[e >> 1]) : bflo(fw[e >> 1]);
                q[e] = qr * __builtin_amdgcn_rcpf(1.0f + __expf(-qr));
                const float ea = __expf(-fabsf(fr)), rc = __builtin_amdgcn_rcpf(1.0f + ea), sg = fr >= 0.f ? rc : ea * rc;
                const float lb = lb16[e], oml = 1.0f - lb;
                kk[e] = oml * (1.0f - sg);
                lf[e] = lb == 0.f ? (fminf(fr, 0.f) - __logf(1.0f + ea)) : __logf(lb + oml * sg); }
#pragma unroll
            for (int c4 = 0; c4 < 4; ++c4) *(LAS f32x4*)(Gm + ri * 128 + d0 + 4 * c4) = (f32x4){lf[4 * c4], lf[4 * c4 + 1], lf[4 * c4 + 2], lf[4 * c4 + 3]};
        }
        __syncthreads();
        {
            float pre[16]; float run = 0.f;
#pragma unroll
            for (int k = 0; k < 16; ++k) { run += Gm[(16 * rg + k) * 128 + cd]; pre[k] = run; }
            Tm[rg * 128 + cd] = run;
            __syncthreads();
            float off = 0.f;
#pragma unroll
            for (int r2 = 0; r2 < 3; ++r2) off += (r2 < rg) ? Tm[r2 * 128 + cd] : 0.f;
#pragma unroll
            for (int k = 0; k < 16; ++k) Gm[(16 * rg + k) * 128 + cd] = pre[k] + off;
        }
        __syncthreads();
        {
            float b[16], rr[16], bl[16];
#pragma unroll
            for (int c4 = 0; c4 < 4; ++c4) { const f32x4 x = *(const LAS f32x4*)(Gm + ri * 128 + d0 + 4 * c4), y = *(const LAS f32x4*)(Gm + 31 * 128 + d0 + 4 * c4), z = *(const LAS f32x4*)(Gm + 63 * 128 + d0 + 4 * c4);
#pragma unroll
                for (int i = 0; i < 4; ++i) { b[4 * c4 + i] = x[i]; rr[4 * c4 + i] = y[i]; bl[4 * c4 + i] = z[i]; } }
            unsigned wqt[8], wkt[8], wqf[8], wqg[8]; unsigned short ke[16];
#pragma unroll
            for (int e2 = 0; e2 < 8; ++e2) { float qt2[2], kt2[2], qf2[2], qg2[2];
#pragma unroll
                for (int x = 0; x < 2; ++x) { const int e = 2 * e2 + x; const float ex = __expf(b[e] - rr[e]), er = __expf(rr[e]), elr = __expf(bl[e] - rr[e]), ebc = __expf(Bc[e]);
                    qt2[x] = q[e] * ex; kt2[x] = kk[e] * __builtin_amdgcn_rcpf(ex); qf2[x] = qt2[x] * er; qg2[x] = qf2[x] * ebc; ke[e] = (unsigned short)f2bf(kt2[x] * elr); }
                wqt[e2] = cvtpk(qt2[0], qt2[1]); wkt[e2] = cvtpk(kt2[0], kt2[1]); wqf[e2] = cvtpk(qf2[0], qf2[1]); wqg[e2] = cvtpk(qg2[0], qg2[1]); }
            *(LAS v4u*)(lds + HA_QT + ri * 272 + d0 * 2) = (v4u){wqt[0], wqt[1], wqt[2], wqt[3]}; *(LAS v4u*)(lds + HA_QT + ri * 272 + d0 * 2 + 16) = (v4u){wqt[4], wqt[5], wqt[6], wqt[7]};
            *(LAS v4u*)(lds + HA_KT + ri * 272 + d0 * 2) = (v4u){wkt[0], wkt[1], wkt[2], wkt[3]}; *(LAS v4u*)(lds + HA_KT + ri * 272 + d0 * 2 + 16) = (v4u){wkt[4], wkt[5], wkt[6], wkt[7]};
            *(LAS v4u*)(lds + HA_QF + ri * 272 + d0 * 2) = (v4u){wqf[0], wqf[1], wqf[2], wqf[3]}; *(LAS v4u*)(lds + HA_QF + ri * 272 + d0 * 2 + 16) = (v4u){wqf[4], wqf[5], wqf[6], wqf[7]};
            *(v4u*)(QTg + (size_t)tok * 512 + hh * 128 + d0) = (v4u){wqg[0], wqg[1], wqg[2], wqg[3]}; *(v4u*)(QTg + (size_t)tok * 512 + hh * 128 + d0 + 8) = (v4u){wqg[4], wqg[5], wqg[6], wqg[7]};
#pragma unroll
            for (int e = 0; e < 16; ++e) { *(LAS unsigned short*)(lds + HA_KE + (d0 + e) * 136 + ri * 2) = ke[e];
                *(LAS unsigned short*)(lds + HA_VT + (d0 + e) * 136 + ri * 2) = (unsigned short)((e & 1) ? (vraw[e >> 1] >> 16) : (vraw[e >> 1] & 0xffffu)); Bc[e] += bl[e]; }
        }
        __syncthreads();
        bf16x8 vf[2][2]; float dec0, dec1;
        {
            bf16x8 pf[2][2];
#pragma unroll
            for (int sj = 0; sj < 2; ++sj) {
                if (sj <= ti) {
                    f32x16 pt = zero16;
#pragma unroll
                    for (int k8 = 0; k8 < 8; ++k8) { const bf16x8 af = *(const LAS bf16x8*)(lds + HA_KT + (32 * sj + l31) * 272 + (16 * k8 + 8 * h) * 2), bq = *(const LAS bf16x8*)(lds + HA_QT + (32 * ti + l31) * 272 + (16 * k8 + 8 * h) * 2);
                        pt = __builtin_amdgcn_mfma_f32_32x32x16_bf16(af, bq, pt, 0, 0, 0); }
#pragma unroll
                    for (int r = 0; r < 16; ++r) { const int sl = 32 * sj + (r & 3) + 8 * (r >> 2) + 4 * h, tl = 32 * ti + l31; pt[r] = sl <= tl ? pt[r] : 0.f; }
#pragma unroll
                    for (int sp = 0; sp < 2; ++sp) { v4u w; w.x = cvtpk(pt[8 * sp + 0], pt[8 * sp + 1]); w.y = cvtpk(pt[8 * sp + 2], pt[8 * sp + 3]); w.z = cvtpk(pt[8 * sp + 4], pt[8 * sp + 5]); w.w = cvtpk(pt[8 * sp + 6], pt[8 * sp + 7]); pf[sj][sp] = __builtin_bit_cast(bf16x8, w); }
                } else { pf[sj][0] = (bf16x8){0, 0, 0, 0, 0, 0, 0, 0}; pf[sj][1] = pf[sj][0]; }
            }
            f32x16 ot = zero16;
#pragma unroll
            for (int k8 = 0; k8 < 8; ++k8) { const bf16x8 af = *(const LAS bf16x8*)(lds + HA_ST + (32 * ej + l31) * 272 + (16 * k8 + 8 * h) * 2), bq = *(const LAS bf16x8*)(lds + HA_QF + (32 * ti + l31) * 272 + (16 * k8 + 8 * h) * 2);
                ot = __builtin_amdgcn_mfma_f32_32x32x16_bf16(af, bq, ot, 0, 0, 0); }
#pragma unroll
            for (int sj = 0; sj < 2; ++sj)
#pragma unroll
                for (int sp = 0; sp < 2; ++sp) { const LAS unsigned char* vp = lds + HA_VT + (32 * ej + l31) * 136 + (32 * sj + 16 * sp + 4 * h) * 2; const v2u lo = *(const LAS v2u*)vp, hi = *(const LAS v2u*)(vp + 16);
                    vf[sj][sp] = __builtin_bit_cast(bf16x8, ((v4u){lo.x, lo.y, hi.x, hi.y})); }
#pragma unroll
            for (int sj = 0; sj < 2; ++sj)
#pragma unroll
                for (int sp = 0; sp < 2; ++sp) ot = __builtin_amdgcn_mfma_f32_32x32x16_bf16(vf[sj][sp], pf[sj][sp], ot, 0, 0, 0);
            dec0 = __expf(Gm[63 * 128 + 32 * (2 * ti) + l31]); dec1 = __expf(Gm[63 * 128 + 32 * (2 * ti + 1) + l31]);
            const int tl = 32 * ti + l31, tokc = dir == 0 ? scbase + 64 * cc + tl : scbase + 511 - 64 * cc - tl;
            bf16* orow = OP + (size_t)tokc * 512 + hh * 128 + 32 * ej + 4 * h;
#pragma unroll
            for (int qd = 0; qd < 4; ++qd) { v2u w; w.x = cvtpk(ot[4 * qd], ot[4 * qd + 1]); w.y = cvtpk(ot[4 * qd + 2], ot[4 * qd + 3]); *(v2u*)(orow + 8 * qd) = w; }
        }
        __syncthreads();
        {
            sacc0 = sacc0 * dec0; sacc1 = sacc1 * dec1;
#pragma unroll
            for (int sj = 0; sj < 2; ++sj)
#pragma unroll
                for (int sp = 0; sp < 2; ++sp) {
                    { const LAS unsigned char* kp = lds + HA_KE + (32 * (2 * ti) + l31) * 136 + (32 * sj + 16 * sp + 4 * h) * 2; const v2u lo = *(const LAS v2u*)kp, hi = *(const LAS v2u*)(kp + 16);
                      sacc0 = __builtin_amdgcn_mfma_f32_32x32x16_bf16(vf[sj][sp], __builtin_bit_cast(bf16x8, ((v4u){lo.x, lo.y, hi.x, hi.y})), sacc0, 0, 0, 0); }
                    { const LAS unsigned char* kp = lds + HA_KE + (32 * (2 * ti + 1) + l31) * 136 + (32 * sj + 16 * sp + 4 * h) * 2; const v2u lo = *(const LAS v2u*)kp, hi = *(const LAS v2u*)(kp + 16);
                      sacc1 = __builtin_amdgcn_mfma_f32_32x32x16_bf16(vf[sj][sp], __builtin_bit_cast(bf16x8, ((v4u){lo.x, lo.y, hi.x, hi.y})), sacc1, 0, 0, 0); } }
#pragma unroll
            for (int r = 0; r < 16; ++r) { const int e = 32 * ej + (r & 3) + 8 * (r >> 2) + 4 * h;
                *(LAS unsigned short*)(lds + HA_ST + e * 272 + (32 * (2 * ti) + l31) * 2) = (unsigned short)f2bf(sacc0[r]);
                *(LAS unsigned short*)(lds + HA_ST + e * 272 + (32 * (2 * ti + 1) + l31) * 2) = (unsigned short)f2bf(sacc1[r]); }
        }
    }
#pragma unroll
    for (int r = 0; r < 16; ++r) { const int e = 32 * ej + (r & 3) + 8 * (r >> 2) + 4 * h; Fo[(size_t)e * 128 + 32 * (2 * ti) + l31] = sacc0[r]; Fo[(size_t)e * 128 + 32 * (2 * ti + 1) + l31] = sacc1[r]; }
    if (ri == 0) {
#pragma unroll
        for (int e = 0; e < 16; ++e) Td[d0 + e] = __expf(Bc[e]); }
}
constexpr int HB_T = 0, HB_BL = 4096, HB_QT = 8192, HB_KT = HB_QT + 17408, HB_QF = HB_KT + 17408, HB_KE = HB_QF + 17408, HB_VT = HB_KE + 17408, HB_ST = HB_VT + 17408, HB_END = HB_ST + 34816;
static_assert(HB_END <= MISC_OFF, "HGRN level A v2 LDS map");
__device__ __forceinline__ void hgrn_a_unit2(const Args& a, int unit, int j, LAS unsigned char* lds, int wave_s) {
    int tid_ = tid_from_wave(wave_s); asm volatile("" : "+v"(tid_)); const int tid = tid_, lane = tid & 63, wave = __builtin_amdgcn_readfirstlane(tid >> 6), l31 = lane & 31, h = lane >> 5;
    const bool smp = unit >= 256; const int uv = smp ? unit - 256 : unit, hh = (uv >> 1) & 3, dir = uv & 1;
    const int scbase = smp ? MP + (uv >> 3) * 512 : (uv >> 3) * 2048, nch = smp ? 8 : 32, lastt = 64 * nch - 1;
    const int funit = smp ? (MP / 512 + (uv >> 3)) * 8 + hh * 2 + dir : 0;
    const bf16* Z = (const bf16*)(a.ws + WS_Z); bf16* OP = (bf16*)a.out + (size_t)dir * M * 512; bf16* QTg = (bf16*)(a.ws + WS_QT) + (size_t)dir * M * 512;
    float* Fo = (float*)(a.ws + WS_F) + (size_t)funit * 16384; float* Td = (float*)(a.ws + WS_SMALL) + SM_TDEC + (size_t)funit * 128;
    const float* lbv = (const float*)(a.ws + WS_SMALL) + SM_LB + (size_t)j * 1024 + dir * 512 + hh * 128;
    const int c0 = 2 * lane, rg = wave, ti = wave >> 2, ej = wave & 3, zf = dir == 0 ? ZFF : ZFB;
    LAS float* Tm = (LAS float*)(lds + HB_T); LAS float* BLm = (LAS float*)(lds + HB_BL);
    const float lb0 = lbv[c0], lb1 = lbv[c0 + 1];
    float Bc0 = 0.f, Bc1 = 0.f;
    const f32x16 zero16 = (f32x16){0.f, 0.f, 0.f, 0.f, 0.f, 0.f, 0.f, 0.f, 0.f, 0.f, 0.f, 0.f, 0.f, 0.f, 0.f, 0.f};
    f32x16 sacc0 = zero16, sacc1 = zero16;
    unsigned rq[8], rf[8], rv[8];
#pragma unroll
    for (int r = 0; r < 8; ++r) { const int tok = dir == 0 ? scbase + 8 * rg + r : scbase + lastt - 8 * rg - r; const bf16* zr = Z + (size_t)tok * NZ + hh * 128 + c0;
        rq[r] = *(const unsigned*)(zr + ZQ); rf[r] = *(const unsigned*)(zr + zf); rv[r] = *(const unsigned*)(zr + ZI); }
    __syncthreads();
    { unsigned z0 = 0u; asm volatile("" : "+v"(z0));
      for (int i = tid; i < 34816 / 16; i += NTHR) *(LAS v4u*)(lds + HB_ST + 16 * i) = (v4u){z0, z0, z0, z0}; }
    for (int cc = 0; cc < nch; ++cc) {
        float q[8][2], kk[8][2], pre[8][2]; unsigned vw[8];
        {
            float run0 = 0.f, run1 = 0.f;
#pragma unroll
            for (int r = 0; r < 8; ++r) { vw[r] = rv[r];
#pragma unroll
                for (int x = 0; x < 2; ++x) { const float qr = x ? bfhi(rq[r]) : bflo(rq[r]), fr = x ? bfhi(rf[r]) : bflo(rf[r]), lb = x ? lb1 : lb0, oml = 1.0f - lb;
                    q[r][x] = qr * __builtin_amdgcn_rcpf(1.0f + __expf(-qr));
                    const float ea = __expf(-fabsf(fr)), rc = __builtin_amdgcn_rcpf(1.0f + ea), sg = fr >= 0.f ? rc : ea * rc;
                    kk[r][x] = oml * (1.0f - sg);
                    const float lf = lb == 0.f ? (fminf(fr, 0.f) - __logf(1.0f + ea)) : __logf(lb + oml * sg);
                    if (x) { run1 += lf; pre[r][1] = run1; } else { run0 += lf; pre[r][0] = run0; } } }
            *(LAS pg8::f32x2*)(Tm + rg * 128 + c0) = (pg8::f32x2){run0, run1};
        }
        __syncthreads();
        {
            float off0 = 0.f, off1 = 0.f, r310 = 0.f, r311 = 0.f, bl0 = 0.f, bl1 = 0.f;
#pragma unroll
            for (int r2 = 0; r2 < 8; ++r2) { const pg8::f32x2 tv = *(const LAS pg8::f32x2*)(Tm + r2 * 128 + c0); if (r2 < rg) { off0 += tv[0]; off1 += tv[1]; } if (r2 < 4) { r310 += tv[0]; r311 += tv[1]; } bl0 += tv[0]; bl1 += tv[1]; }
            const float er0 = __expf(r310), er1 = __expf(r311), elr0 = __expf(bl0 - r310), elr1 = __expf(bl1 - r311), ebc0 = __expf(Bc0), ebc1 = __expf(Bc1);
            float ke[8][2];
#pragma unroll
            for (int r = 0; r < 8; ++r) { const int row = 8 * rg + r, tok = dir == 0 ? scbase + 64 * cc + row : scbase + lastt - 64 * cc - row;
                const float ex0 = __expf(pre[r][0] + off0 - r310), ex1 = __expf(pre[r][1] + off1 - r311);
                const float qt0 = q[r][0] * ex0, qt1 = q[r][1] * ex1, kt0 = kk[r][0] * __builtin_amdgcn_rcpf(ex0), kt1 = kk[r][1] * __builtin_amdgcn_rcpf(ex1);
                const float qf0 = qt0 * er0, qf1 = qt1 * er1; ke[r][0] = kt0 * elr0; ke[r][1] = kt1 * elr1;
                *(LAS unsigned*)(lds + HB_QT + row * 272 + c0 * 2) = cvtpk(qt0, qt1);
                *(LAS unsigned*)(lds + HB_KT + row * 272 + c0 * 2) = cvtpk(kt0, kt1);
                *(LAS unsigned*)(lds + HB_QF + row * 272 + c0 * 2) = cvtpk(qf0, qf1);
                if (smp) *(unsigned*)(QTg + (size_t)tok * 512 + hh * 128 + c0) = cvtpk(qf0 * ebc0, qf1 * ebc1); }
#pragma unroll
            for (int x = 0; x < 2; ++x) { LAS unsigned char* kp = lds + HB_KE + (c0 + x) * 136 + 16 * rg; LAS unsigned char* vp = lds + HB_VT + (c0 + x) * 136 + 16 * rg;
                *(LAS v2u*)kp = (v2u){cvtpk(ke[0][x], ke[1][x]), cvtpk(ke[2][x], ke[3][x])}; *(LAS v2u*)(kp + 8) = (v2u){cvtpk(ke[4][x], ke[5][x]), cvtpk(ke[6][x], ke[7][x])};
                unsigned vv[4];
#pragma unroll
                for (int r2 = 0; r2 < 4; ++r2) vv[r2] = x ? ((vw[2 * r2] >> 16) | (vw[2 * r2 + 1] & 0xffff0000u)) : ((vw[2 * r2] & 0xffffu) | (vw[2 * r2 + 1] << 16));
                *(LAS v2u*)vp = (v2u){vv[0], vv[1]}; *(LAS v2u*)(vp + 8) = (v2u){vv[2], vv[3]}; }
            if (rg == 0) *(LAS pg8::f32x2*)(BLm + c0) = (pg8::f32x2){bl0, bl1};
            Bc0 += bl0; Bc1 += bl1;
            if (cc < nch - 1) {
#pragma unroll
                for (int r = 0; r < 8; ++r) { const int row = 8 * rg + r, tok = dir == 0 ? scbase + 64 * (cc + 1) + row : scbase + lastt - 64 * (cc + 1) - row; const bf16* zr = Z + (size_t)tok * NZ + hh * 128 + c0;
                    rq[r] = *(const unsigned*)(zr + ZQ); rf[r] = *(const unsigned*)(zr + zf); rv[r] = *(const unsigned*)(zr + ZI); } }
        }
        __syncthreads();
        bf16x8 vf[2][2]; float dec0, dec1;
        {
            bf16x8 pf[2][2];
#pragma unroll
            for (int sj = 0; sj < 2; ++sj) {
                if (sj <= ti) {
                    f32x16 pt = zero16;
#pragma unroll
                    for (int k8 = 0; k8 < 8; ++k8) { const bf16x8 af = *(const LAS bf16x8*)(lds + HB_KT + (32 * sj + l31) * 272 + (16 * k8 + 8 * h) * 2), bq = *(const LAS bf16x8*)(lds + HB_QT + (32 * ti + l31) * 272 + (16 * k8 + 8 * h) * 2);
                        pt = __builtin_amdgcn_mfma_f32_32x32x16_bf16(af, bq, pt, 0, 0, 0); }
#pragma unroll
                    for (int r = 0; r < 16; ++r) { const int sl = 32 * sj + (r & 3) + 8 * (r >> 2) + 4 * h, tl = 32 * ti + l31; pt[r] = sl <= tl ? pt[r] : 0.f; }
#pragma unroll
                    for (int sp = 0; sp < 2; ++sp) { v4u w; w.x = cvtpk(pt[8 * sp + 0], pt[8 * sp + 1]); w.y = cvtpk(pt[8 * sp + 2], pt[8 * sp + 3]); w.z = cvtpk(pt[8 * sp + 4], pt[8 * sp + 5]); w.w = cvtpk(pt[8 * sp + 6], pt[8 * sp + 7]); pf[sj][sp] = __builtin_bit_cast(bf16x8, w); }
                } else { pf[sj][0] = (bf16x8){0, 0, 0, 0, 0, 0, 0, 0}; pf[sj][1] = pf[sj][0]; }
            }
            f32x16 ot = zero16;
#pragma unroll
            for (int k8 = 0; k8 < 8; ++k8) { const bf16x8 af = *(const LAS bf16x8*)(lds + HB_ST + (32 * ej + l31) * 272 + (16 * k8 + 8 * h) * 2), bq = *(const LAS bf16x8*)(lds + HB_QF + (32 * ti + l31) * 272 + (16 * k8 + 8 * h) * 2);
                ot = __builtin_amdgcn_mfma_f32_32x32x16_bf16(af, bq, ot, 0, 0, 0); }
#pragma unroll
            for (int sj = 0; sj < 2; ++sj)
#pragma unroll
                for (int sp = 0; sp < 2; ++sp) { const LAS unsigned char* vp = lds + HB_VT + (32 * ej + l31) * 136 + (32 * sj + 16 * sp + 4 * h) * 2; const v2u lo = *(const LAS v2u*)vp, hi = *(const LAS v2u*)(vp + 16);
                    vf[sj][sp] = __builtin_bit_cast(bf16x8, ((v4u){lo.x, lo.y, hi.x, hi.y})); }
#pragma unroll
            for (int sj = 0; sj < 2; ++sj)
#pragma unroll
                for (int sp = 0; sp < 2; ++sp) ot = __builtin_amdgcn_mfma_f32_32x32x16_bf16(vf[sj][sp], pf[sj][sp], ot, 0, 0, 0);
            dec0 = __expf(BLm[32 * (2 * ti) + l31]); dec1 = __expf(BLm[32 * (2 * ti + 1) + l31]);
            const int tl = 32 * ti + l31, tokc = dir == 0 ? scbase + 64 * cc + tl : scbase + lastt - 64 * cc - tl;
            bf16* orow = OP + (size_t)tokc * 512 + hh * 128 + 32 * ej + 8 * h;
#pragma unroll
            for (int qp = 0; qp < 2; ++qp) { v2u w0, w1; w0.x = cvtpk(ot[8 * qp], ot[8 * qp + 1]); w0.y = cvtpk(ot[8 * qp + 2], ot[8 * qp + 3]); w1.x = cvtpk(ot[8 * qp + 4], ot[8 * qp + 5]); w1.y = cvtpk(ot[8 * qp + 6], ot[8 * qp + 7]);
                *(v4u*)(orow + 16 * qp) = widen_pair(w0, w1); }
        }
        __syncthreads();
        {
            sacc0 = sacc0 * dec0; sacc1 = sacc1 * dec1;
#pragma unroll
            for (int sj = 0; sj < 2; ++sj)
#pragma unroll
                for (int sp = 0; sp < 2; ++sp) {
                    { const LAS unsigned char* kp = lds + HB_KE + (32 * (2 * ti) + l31) * 136 + (32 * sj + 16 * sp + 4 * h) * 2; const v2u lo = *(const LAS v2u*)kp, hi = *(const LAS v2u*)(kp + 16);
                      sacc0 = __builtin_amdgcn_mfma_f32_32x32x16_bf16(vf[sj][sp], __builtin_bit_cast(bf16x8, ((v4u){lo.x, lo.y, hi.x, hi.y})), sacc0, 0, 0, 0); }
                    { const LAS unsigned char* kp = lds + HB_KE + (32 * (2 * ti + 1) + l31) * 136 + (32 * sj + 16 * sp + 4 * h) * 2; const v2u lo = *(const LAS v2u*)kp, hi = *(const LAS v2u*)(kp + 16);
                      sacc1 = __builtin_amdgcn_mfma_f32_32x32x16_bf16(vf[sj][sp], __builtin_bit_cast(bf16x8, ((v4u){lo.x, lo.y, hi.x, hi.y})), sacc1, 0, 0, 0); } }
#pragma unroll
            for (int r = 0; r < 16; ++r) { const int e = 32 * ej + (r & 3) + 8 * (r >> 2) + 4 * h;
                *(LAS unsigned short*)(lds + HB_ST + e * 272 + (32 * (2 * ti) + l31) * 2) = (unsigned short)f2bf(sacc0[r]);
                *(LAS unsigned short*)(lds + HB_ST + e * 272 + (32 * (2 * ti + 1) + l31) * 2) = (unsigned short)f2bf(sacc1[r]); }
        }
    }
    if (smp) {
#pragma unroll
    for (int r = 0; r < 16; ++r) { const int e = 32 * ej + (r & 3) + 8 * (r >> 2) + 4 * h; Fo[(size_t)e * 128 + 32 * (2 * ti) + l31] = sacc0[r]; Fo[(size_t)e * 128 + 32 * (2 * ti + 1) + l31] = sacc1[r]; }
    if (rg == 0) *(pg8::f32x2*)(Td + c0) = (pg8::f32x2){__expf(Bc0), __expf(Bc1)}; }
}
__device__ __forceinline__ int sin_frag_off(int e4) { const int e = e4 >> 7, dk = e4 & 127; return ((((e >> 5) * 8 + (dk >> 4)) * 64) + (e & 31) + 32 * ((dk >> 3) & 1)) * 8 + (dk & 7); }
template <int NB>
__device__ __forceinline__ void hgrn_b_chain(const float* Fo, const float* Td, bf16* SIN, int sc0, int nsc, int hh, int dir, int e4, f32x4& carry) {
    const int dk = e4 & 127;
    for (int k0 = 0; k0 < nsc; k0 += NB) {
        f32x4 f[NB], t[NB];
#pragma unroll
        for (int i = 0; i < NB; ++i) { const int sc = dir == 0 ? sc0 + k0 + i : sc0 + nsc - 1 - (k0 + i); const size_t unit = (size_t)sc * 8 + hh * 2 + dir;
            f[i] = *(const f32x4*)(Fo + unit * 16384 + e4); t[i] = *(const f32x4*)(Td + unit * 128 + dk); }
#pragma unroll
        for (int i = 0; i < NB; ++i) { const int sc = dir == 0 ? sc0 + k0 + i : sc0 + nsc - 1 - (k0 + i); const size_t unit = (size_t)sc * 8 + hh * 2 + dir;
            v2u w; w.x = cvtpk(carry[0], carry[1]); w.y = cvtpk(carry[2], carry[3]); *(v2u*)(SIN + unit * 16384 + sin_frag_off(e4)) = w; carry = t[i] * carry + f[i]; }
    }
}
__device__ __forceinline__ void hgrn_b_item(const Args& a, int it, int wave_s) {
    int tid_ = tid_from_wave(wave_s); asm volatile("" : "+v"(tid_)); const int tid = tid_;
    const float* Fo = (const float*)(a.ws + WS_F); const float* Td = (const float*)(a.ws + WS_SMALL) + SM_TDEC; bf16* SIN = (bf16*)(a.ws + WS_SIN);
    f32x4 carry = (f32x4){0.f, 0.f, 0.f, 0.f};
    if (it < 256) { if (tid < 128) { const int ch = it >> 5; hgrn_b_chain<8>(Fo, Td, SIN, MP / 512, MS / 512, ch >> 1, ch & 1, (it & 31) * 512 + tid * 4, carry); } }
    else { const int r = it - 256, pc = r >> 3; hgrn_b_chain<4>(Fo, Td, SIN, (pc >> 3) * 4, 4, (pc >> 1) & 3, pc & 1, (r & 7) * 2048 + tid * 4, carry); }
}
__device__ __forceinline__ void hgrn_c_unit(const Args& a, int unit, int j, LAS unsigned char* lds, int wave_s) {
    int tid_ = tid_from_wave(wave_s); asm volatile("" : "+v"(tid_)); const int tid = tid_, lane = tid & 63, wave = __builtin_amdgcn_readfirstlane(tid >> 6), l31 = lane & 31, h = lane >> 5;
    const int tt = unit >> 2, hh = unit & 3, ti = wave >> 2, ej = wave & 3, tok = tt * 64 + 32 * ti + l31, sc = (tt * 64) >> 9;
    const bf16* Z = (const bf16*)(a.ws + WS_Z); const bf16* OP = (const bf16*)a.out; const bf16* QTg = (const bf16*)(a.ws + WS_QT); const bf16* SIN = (const bf16*)(a.ws + WS_SIN); bf16* OB = (bf16*)(a.ws + WS_OB);
    f32x16 acc = (f32x16){0.f, 0.f, 0.f, 0.f, 0.f, 0.f, 0.f, 0.f, 0.f, 0.f, 0.f, 0.f, 0.f, 0.f, 0.f, 0.f};
#pragma unroll
    for (int dir = 0; dir < 2; ++dir) { const bf16* sin = SIN + ((size_t)sc * 8 + hh * 2 + dir) * 16384 + (size_t)(32 * ej + l31) * 128 + 8 * h; const bf16* qt = QTg + ((size_t)dir * M + tok) * 512 + hh * 128 + 8 * h;
        bf16x8 af[8], bq[8];
#pragma unroll
        for (int k8 = 0; k8 < 8; ++k8) { af[k8] = *(const bf16x8*)(sin + 16 * k8); bq[k8] = *(const bf16x8*)(qt + 16 * k8); }
#pragma unroll
        for (int k8 = 0; k8 < 8; ++k8) acc = __builtin_amdgcn_mfma_f32_32x32x16_bf16(af[k8], bq[k8], acc, 0, 0, 0); }
    float ss = 0.f;
#pragma unroll
    for (int qd = 0; qd < 4; ++qd) { const int e0 = 32 * ej + 8 * qd + 4 * h; const v2u p0 = *(const v2u*)(OP + (size_t)tok * 512 + hh * 128 + e0), p1 = *(const v2u*)(OP + ((size_t)M + tok) * 512 + hh * 128 + e0);
        acc[4 * qd] += bflo(p0.x) + bflo(p1.x); acc[4 * qd + 1] += bfhi(p0.x) + bfhi(p1.x); acc[4 * qd + 2] += bflo(p0.y) + bflo(p1.y); acc[4 * qd + 3] += bfhi(p0.y) + bfhi(p1.y);
        ss += (acc[4 * qd] * acc[4 * qd] + acc[4 * qd + 1] * acc[4 * qd + 1]) + (acc[4 * qd + 2] * acc[4 * qd + 2] + acc[4 * qd + 3] * acc[4 * qd + 3]); }
    ss += __shfl_xor(ss, 32);
    LAS float* sq = (LAS float*)lds;
    __syncthreads();
    if (h == 0) sq[(ti * 4 + ej) * 32 + l31] = ss;
    __syncthreads();
    const float tot = (sq[(ti * 4 + 0) * 32 + l31] + sq[(ti * 4 + 1) * 32 + l31]) + (sq[(ti * 4 + 2) * 32 + l31] + sq[(ti * 4 + 3) * 32 + l31]);
    const float rstd = 1.0f / sqrtf(tot * (1.0f / 128.0f) + RMS_EPS);
    const float* ng = a.hgrn_norm_g + j * 128;
#pragma unroll
    for (int qd = 0; qd < 4; ++qd) { const int e0 = 32 * ej + 8 * qd + 4 * h; const v2u gw2 = *(const v2u*)(Z + (size_t)tok * NZ + ZG + hh * 128 + e0); const f32x4 n4 = *(const f32x4*)(ng + e0);
        const float g0 = bflo(gw2.x), g1 = bfhi(gw2.x), g2 = bflo(gw2.y), g3 = bfhi(gw2.y);
        const float y0 = acc[4 * qd] * rstd * n4[0] * silu_f(g0), y1 = acc[4 * qd + 1] * rstd * n4[1] * silu_f(g1), y2 = acc[4 * qd + 2] * rstd * n4[2] * silu_f(g2), y3 = acc[4 * qd + 3] * rstd * n4[3] * silu_f(g3);
        v2u w; w.x = cvtpk(y0, y1); w.y = cvtpk(y2, y3); *(v2u*)(OB + (size_t)tok * 1024 + hh * 128 + e0) = w; }
}

__device__ __forceinline__ void hgrn_c_wave(const Args& a, int wu, int j, int wave_s) {
    int tid_ = tid_from_wave(wave_s); asm volatile("" : "+v"(tid_)); const int lane = tid_ & 63, l31 = lane & 31, h = lane >> 5;
    const int tile = wu >> 2, hh = wu & 3, tok = tile * 32 + l31, sc = (tile * 32) >> 9;
    const bf16* Z = (const bf16*)(a.ws + WS_Z); const bf16* OP = (const bf16*)a.out; const bf16* QTg = (const bf16*)(a.ws + WS_QT); const bf16* SIN = (const bf16*)(a.ws + WS_SIN); bf16* OB = (bf16*)(a.ws + WS_OB);
    const f32x16 zero16 = (f32x16){0.f, 0.f, 0.f, 0.f, 0.f, 0.f, 0.f, 0.f, 0.f, 0.f, 0.f, 0.f, 0.f, 0.f, 0.f, 0.f};
    f32x16 acc[4] = {zero16, zero16, zero16, zero16};
#pragma unroll
    for (int dir = 0; dir < 2; ++dir) {
        const bf16* sin = SIN + ((size_t)sc * 8 + hh * 2 + dir) * 16384 + (size_t)l31 * 128 + 8 * h; const bf16* qt = QTg + ((size_t)dir * M + tok) * 512 + hh * 128 + 8 * h;
#pragma unroll
        for (int kh = 0; kh < 2; ++kh) {
            bf16x8 af[4][4], bq[4];
#pragma unroll
            for (int k4 = 0; k4 < 4; ++k4) { bq[k4] = *(const bf16x8*)(qt + 16 * (4 * kh + k4));
#pragma unroll
                for (int et = 0; et < 4; ++et) af[k4][et] = *(const bf16x8*)(sin + (size_t)et * 32 * 128 + 16 * (4 * kh + k4)); }
#pragma unroll
            for (int k4 = 0; k4 < 4; ++k4)
#pragma unroll
                for (int et = 0; et < 4; ++et) acc[et] = __builtin_amdgcn_mfma_f32_32x32x16_bf16(af[k4][et], bq[k4], acc[et], 0, 0, 0);
        }
    }
    float ss = 0.f;
#pragma unroll
    for (int et = 0; et < 4; ++et)
#pragma unroll
        for (int qd = 0; qd < 4; ++qd) { const int e0 = 32 * et + 8 * qd + 4 * h; const v2u p0 = *(const v2u*)(OP + (size_t)tok * 512 + hh * 128 + e0), p1 = *(const v2u*)(OP + ((size_t)M + tok) * 512 + hh * 128 + e0);
            acc[et][4 * qd] += bflo(p0.x) + bflo(p1.x); acc[et][4 * qd + 1] += bfhi(p0.x) + bfhi(p1.x); acc[et][4 * qd + 2] += bflo(p0.y) + bflo(p1.y); acc[et][4 * qd + 3] += bfhi(p0.y) + bfhi(p1.y);
            ss += (acc[et][4 * qd] * acc[et][4 * qd] + acc[et][4 * qd + 1] * acc[et][4 * qd + 1]) + (acc[et][4 * qd + 2] * acc[et][4 * qd + 2] + acc[et][4 * qd + 3] * acc[et][4 * qd + 3]); }
    ss += __shfl_xor(ss, 32);
    const float rstd = 1.0f / sqrtf(ss * (1.0f / 128.0f) + RMS_EPS);
    const float* ng = a.hgrn_norm_g + j * 128;
#pragma unroll
    for (int et = 0; et < 4; ++et)
#pragma unroll
        for (int qd = 0; qd < 4; ++qd) { const int e0 = 32 * et + 8 * qd + 4 * h; const v2u gw2 = *(const v2u*)(Z + (size_t)tok * NZ + ZG + hh * 128 + e0); const f32x4 n4 = *(const f32x4*)(ng + e0);
            const float g0 = bflo(gw2.x), g1 = bfhi(gw2.x), g2 = bflo(gw2.y), g3 = bfhi(gw2.y);
            const float y0 = acc[et][4 * qd] * rstd * n4[0] * silu_f(g0), y1 = acc[et][4 * qd + 1] * rstd * n4[1] * silu_f(g1), y2 = acc[et][4 * qd + 2] * rstd * n4[2] * silu_f(g2), y3 = acc[et][4 * qd + 3] * rstd * n4[3] * silu_f(g3);
            v2u w; w.x = cvtpk(y0, y1); w.y = cvtpk(y2, y3); *(v2u*)(OB + (size_t)tok * 1024 + hh * 128 + e0) = w; }
}

constexpr int HC_PITCH = 272, HC_BUF = 32 * HC_PITCH, HC_WAVE = 2 * HC_BUF;
static_assert(8 * HC_WAVE <= MISC_OFF, "HGRN level C v4 LDS map");
__device__ __forceinline__ void hgrn_c_wave4(const Args& a, int wu, int j, LAS unsigned char* lds, int wave_s) {
    int tid_ = tid_from_wave(wave_s); asm volatile("" : "+v"(tid_)); const int lane = tid_ & 63, l31 = lane & 31, h = lane >> 5;
    const int tile = wu >> 2, hh = wu & 3, tok = tile * 32 + l31, sc = (tile * 32) >> 9;
    const bf16* Z = (const bf16*)(a.ws + WS_Z); const bf16* OP = (const bf16*)a.out; const bf16* QTg = (const bf16*)(a.ws + WS_QT); const bf16* SIN = (const bf16*)(a.ws + WS_SIN); bf16* OB = (bf16*)(a.ws + WS_OB);
    LAS unsigned char* b0 = lds + wave_s * HC_WAVE; LAS unsigned char* b1 = b0 + HC_BUF;
    const int cch = lane & 15, rsub = lane >> 4;
    const int lco = rsub * HC_PITCH + cch * 16, lmf = l31 * HC_PITCH + 8 * h;
    const f32x16 zero16 = (f32x16){0.f, 0.f, 0.f, 0.f, 0.f, 0.f, 0.f, 0.f, 0.f, 0.f, 0.f, 0.f, 0.f, 0.f, 0.f, 0.f};
    f32x16 acc[4] = {zero16, zero16, zero16, zero16};
    v4u pa[8], pb[8];
    { const bf16* o0 = OP + ((size_t)tile * 32 + rsub) * 512 + hh * 128 + 8 * cch; const bf16* o1 = o0 + (size_t)M * 512;
#pragma unroll
      for (int it = 0; it < 8; ++it) { pa[it] = *(const v4u*)(o0 + (size_t)(4 * it) * 512); pb[it] = *(const v4u*)(o1 + (size_t)(4 * it) * 512); } }
    __builtin_amdgcn_sched_barrier(0);
    if (tile * 32 >= MP) {
#pragma unroll
    for (int dir = 0; dir < 2; ++dir) {
        const bf16* sin = SIN + ((size_t)sc * 8 + hh * 2 + dir) * 16384 + (size_t)lane * 8; const bf16* qt = QTg + ((size_t)dir * M + tok) * 512 + hh * 128 + 8 * h;
#pragma unroll
        for (int kh = 0; kh < 4; ++kh) {
            bf16x8 af[2][4], bq[2];
#pragma unroll
            for (int k2 = 0; k2 < 2; ++k2) { bq[k2] = *(const bf16x8*)(qt + 16 * (2 * kh + k2));
#pragma unroll
                for (int et = 0; et < 4; ++et) af[k2][et] = *(const bf16x8*)(sin + (size_t)((et * 8 + 2 * kh + k2) * 64) * 8); }
#pragma unroll
            for (int k2 = 0; k2 < 2; ++k2)
#pragma unroll
                for (int et = 0; et < 4; ++et) acc[et] = __builtin_amdgcn_mfma_f32_32x32x16_bf16(af[k2][et], bq[k2], acc[et], 0, 0, 0);
        }
    }
    }
    __builtin_amdgcn_sched_barrier(0);
#pragma unroll
    for (int it = 0; it < 8; ++it) { *(LAS v4u*)(b0 + lco + it * 4 * HC_PITCH) = pa[it]; *(LAS v4u*)(b1 + lco + it * 4 * HC_PITCH) = pb[it]; }
    { const bf16* g0p = Z + ((size_t)tile * 32 + rsub) * NZ + ZG + hh * 128 + 8 * cch;
#pragma unroll
      for (int it = 0; it < 8; ++it) pa[it] = *(const v4u*)(g0p + (size_t)(4 * it) * NZ); }
    LDS_WAIT();
    float ss = 0.f;
#pragma unroll
    for (int et = 0; et < 4; ++et)
#pragma unroll
        for (int qd = 0; qd < 4; ++qd) { const v2u p0 = *(const LAS v2u*)(b0 + lmf + (32 * et + 8 * qd) * 2), p1 = *(const LAS v2u*)(b1 + lmf + (32 * et + 8 * qd) * 2);
            acc[et][4 * qd] += bflo(p0.x) + bflo(p1.x); acc[et][4 * qd + 1] += bfhi(p0.x) + bfhi(p1.x); acc[et][4 * qd + 2] += bflo(p0.y) + bflo(p1.y); acc[et][4 * qd + 3] += bfhi(p0.y) + bfhi(p1.y);
            ss += (acc[et][4 * qd] * acc[et][4 * qd] + acc[et][4 * qd + 1] * acc[et][4 * qd + 1]) + (acc[et][4 * qd + 2] * acc[et][4 * qd + 2] + acc[et][4 * qd + 3] * acc[et][4 * qd + 3]); }
    ss = sum_xor32(ss);
    const float rstd = 1.0f / sqrtf(ss * (1.0f / 128.0f) + RMS_EPS);
    LDS_WAIT();
#pragma unroll
    for (int it = 0; it < 8; ++it) *(LAS v4u*)(b0 + lco + it * 4 * HC_PITCH) = pa[it];
    LDS_WAIT();
    const float* ng = a.hgrn_norm_g + j * 128;
#pragma unroll
    for (int et = 0; et < 4; ++et)
#pragma unroll
        for (int qd = 0; qd < 4; ++qd) { const int e0 = 32 * et + 8 * qd + 4 * h; const v2u gw2 = *(const LAS v2u*)(b0 + lmf + (32 * et + 8 * qd) * 2); const f32x4 n4 = *(const f32x4*)(ng + e0);
            const float g0 = bflo(gw2.x), g1 = bfhi(gw2.x), g2 = bflo(gw2.y), g3 = bfhi(gw2.y);
            const float y0 = acc[et][4 * qd] * rstd * n4[0] * silu_f(g0), y1 = acc[et][4 * qd + 1] * rstd * n4[1] * silu_f(g1), y2 = acc[et][4 * qd + 2] * rstd * n4[2] * silu_f(g2), y3 = acc[et][4 * qd + 3] * rstd * n4[3] * silu_f(g3);
            v2u w; w.x = cvtpk(y0, y1); w.y = cvtpk(y2, y3); *(LAS v2u*)(b1 + lmf + (32 * et + 8 * qd) * 2) = w; }
    LDS_WAIT();
    { bf16* ob = OB + ((size_t)tile * 32 + rsub) * 1024 + hh * 128 + 8 * cch;
#pragma unroll
      for (int it = 0; it < 8; ++it) *(v4u*)(ob + (size_t)(4 * it) * 1024) = *(const LAS v4u*)(b1 + lco + it * 4 * HC_PITCH); }
    LDS_WAIT();
}

__device__ __forceinline__ Args load_args() {
#if defined(__HIP_DEVICE_COMPILE__)
    unsigned long long p = (unsigned long long)__builtin_amdgcn_kernarg_segment_ptr(); asm volatile("" : "+s"(p)); return *(const __attribute__((address_space(4))) Args*)p;
#else
    return Args{};
#endif
}
#define PH_ARGS() const Args a = load_args(); unsigned char* const ws = a.ws; float* const smallf = (float*)(ws + WS_SMALL); bf16* const Wb = (bf16*)(ws + WS_W); bf16* const XB = (bf16*)(ws + WS_XB); bf16* const Zb = (bf16*)(ws + WS_Z); \
    bf16* const OB = (bf16*)(ws + WS_OB); float* const stat_mix = (float*)(ws + WS_STATMIX); float* const stat_ffn = (float*)(ws + WS_STATFFN); float* const vstat = (float*)(ws + WS_VSTAT); \
    (void)smallf; (void)Wb; (void)XB; (void)Zb; (void)OB; (void)stat_mix; (void)stat_ffn; (void)vstat
#define PH_TID() int tid_ = tid_from_wave(wave_s); asm volatile("" : "+v"(tid_)); const int tid = tid_, lane = tid & 63, wave = __builtin_amdgcn_readfirstlane(tid >> 6), gw = vcu * NWAVES + wave; (void)lane; (void)gw

__global__ void __launch_bounds__(NTHR, 2) fwd_kernel(Args a_unused) {
    extern __shared__ __attribute__((aligned(16))) unsigned char lds_raw[];
    LAS unsigned char* lds = (LAS unsigned char*)lds_raw;
    volatile LAS unsigned* MISC = (volatile LAS unsigned*)(lds + MISC_OFF);
    constexpr int G = 256, NGW = G * NWAVES;
    const int bx = blockIdx.x; __builtin_assume(bx >= 0 && bx < 256);
    const int vcu = (bx & 7) * (G / 8) + (bx >> 3);
    const int wave_s = __builtin_amdgcn_readfirstlane((int)threadIdx.x >> 6);
    if (threadIdx.x < 64) MISC[threadIdx.x] = 0u;
    __syncthreads();
    { const Args a = load_args(); (void)xcd_barrier_post((unsigned*)(a.ws + WS_CTL), MISC + 8, tid_from_wave(wave_s) == 0); }
#define GRID_BAR() do { const Args a_ = load_args(); XcdBarrier b_; b_.bar = (unsigned*)(a_.ws + WS_CTL); b_.x = xb_xcc_id(); b_.st = MISC + 8; int t_ = tid_from_wave(wave_s); asm volatile("" : "+v"(t_)); xcd_barrier(b_, t_ == 0); } while (0)

    {
        PH_ARGS(); PH_TID();
        LAS float* scr = (LAS float*)(lds + wave * 16640);
        constexpr int I_INAB = (D / 64) * (NZ / 64), I_OUTAB = (D / 64) * (D / 64), I_INC = (D / 64) * (4096 / 64), I_OUTC = (CW / 64) * (D / 64), I_GU = (D / 64) * (FF / 64), I_DN = (FF / 64) * (D / 64);
        float* const PF = (float*)(ws + WS_PF);
        constexpr int NITEMS = 2 * I_INAB + 2 * I_OUTAB + 2 * I_INC + 2 * I_OUTC + 8 * I_GU + 4 * I_DN;
        for (int it = gw; it < NITEMS; it += NGW) {
            int r = it;
            if (r < 2 * I_INAB) { const int jj = r / I_INAB; p0_transpose_item(a.w_in_ab + (size_t)jj * D * NZ, D, NZ, Wb + W_INAB + (size_t)jj * NZ * D, 0, jj ? a.ln_ffn_g + 1 * D : nullptr, scr, r % I_INAB, lane, true, jj ? a.ln_ffn_b + 1 * D : nullptr, jj ? PF : nullptr, jj ? PF + (SM_BW_AB1 - SM_GW_AB1) : nullptr); continue; } r -= 2 * I_INAB;
            if (r < 2 * I_OUTAB) { const int jj = r / I_OUTAB; p0_transpose_item(a.w_out_ab + (size_t)jj * D * D, D, D, Wb + W_OUTAB + (size_t)jj * D * D, 0, nullptr, scr, r % I_OUTAB, lane); continue; } r -= 2 * I_OUTAB;
            if (r < 2 * I_INC) { const int jj = r / I_INC; p0_transpose_item(a.w_in_c + (size_t)jj * D * 4096, D, 4096, Wb + W_INC + (size_t)jj * 4096 * D, 0, a.ln_ffn_g + (2 * jj) * D, scr, r % I_INC, lane, true, a.ln_ffn_b + (2 * jj) * D, PF + (SM_GW_C - SM_GW_AB1) + jj * 4096, PF + (SM_BW_C - SM_GW_AB1) + jj * 4096); continue; } r -= 2 * I_INC;
            if (r < 2 * I_OUTC) { const int jj = r / I_OUTC; p0_transpose_item(a.w_out_c + (size_t)jj * CW * D, CW, D, Wb + W_OUTC + (size_t)jj * D * CW, 0, nullptr, scr, r % I_OUTC, lane); continue; } r -= 2 * I_OUTC;
            if (r < 8 * I_GU) { const int L = r / (2 * I_GU), wh = (r / I_GU) & 1; p0_transpose_item((wh ? a.w_up : a.w_gate) + (size_t)L * D * FF, D, FF, Wb + W_GU + (size_t)L * 2 * FF * D, 1 + wh, a.ln_mix_g + L * D, scr, r % I_GU, lane, true, a.ln_mix_b + L * D, PF + (SM_GW_GU - SM_GW_AB1) + L * 5632, PF + (SM_BW_GU - SM_GW_AB1) + L * 5632); continue; } r -= 8 * I_GU;
            { const int L = r / I_DN; p0_transpose_item(a.w_down + (size_t)L * FF * D, FF, D, Wb + W_DN + (size_t)L * D * FF, 0, nullptr, scr, r % I_DN, lane); }
        }
        for (int r = gw; r < 2048; r += NGW) { const float w0 = a.c_ws[(size_t)r * 128 + 2 * lane], w1 = a.c_ws[(size_t)r * 128 + 2 * lane + 1];
            { const int tr = r & 127, sc2 = 2 * lane;
              *(unsigned*)((bf16*)(ws + WS_WSB) + (size_t)(r >> 7) * 16384 + ((((tr >> 5) * 8 + (sc2 >> 4)) * 64) + (tr & 31) + 32 * ((sc2 >> 3) & 1)) * 8 + (sc2 & 7)) = pk2(w0, w1); } const float rs = wave_sum(w0 + w1); if (lane == 0) smallf[SM_RSW + r] = rs; }
        for (int i = bx * NTHR + tid; i < 2048; i += G * NTHR) { const int jj = i >> 10, r = i & 1023; float v = 0.f;
            if (jj == 1) { const float l0 = a.lb_logits[r], l1 = a.lb_logits[1024 + r]; const float mxx = fmaxf(l0, l1), e0 = expf(l0 - mxx), e1 = expf(l1 - mxx); const float p0 = e0 / (e0 + e1), p1 = e1 / (e0 + e1); v = fmaxf((p0 + p1) - p0, 0.f); }
            smallf[SM_LB + i] = v; }
        static_assert(M % (4 * NGW) == 0, "x conversion: 4 rows per wave per step");
        for (int m0 = gw; m0 < M; m0 += 4 * NGW) { f32x4 v[4][4];
#pragma unroll
            for (int q = 0; q < 4; ++q) { const int m = m0 + q * NGW; const float* xr = m < MP ? a.x_prompt + (size_t)m * D : a.x_sample + (size_t)(m - MP) * D; const GAS f32x4* xp = (const GAS f32x4*)xr + lane;
#pragma unroll
                for (int jq = 0; jq < 4; ++jq) v[q][jq] = xp[64 * jq]; }
#pragma unroll
            for (int q = 0; q < 4; ++q) { GAS v2u* o8 = (GAS v2u*)(XB + (size_t)(m0 + q * NGW) * D) + lane;
#pragma unroll
                for (int jq = 0; jq < 4; ++jq) { v2u w; w.x = pk2h(v[q][jq].x, v[q][jq].y); w.y = pk2h(v[q][jq].z, v[q][jq].w); o8[64 * jq] = w; } } }
    }
    GRID_BAR();
    {
        PH_ARGS(); PH_TID(); const float* PF = (const float*)(ws + WS_PF);
        for (int i = bx * NTHR + tid; i < FOLD_N; i += G * NTHR) { float acc = 0.f;
#pragma unroll
            for (int kb = 0; kb < 16; ++kb) acc += PF[(size_t)kb * FOLD_N + i];
            smallf[SM_GW_AB1 + i] = acc; }
    }

    for (int L = 0; L < 4; ++L) {
        const int j = L >> 1;
        if ((L & 1) == 0) {
            { PH_ARGS(); pg8::Gemm g{XB, Wb + W_INAB + (size_t)j * NZ * D, M, NZ, D}; pg8::StaticOrder S; S.init(M, NZ, G, bx);
              pg8::EpiZ E{Zb, NZ, L == 0 ? nullptr : stat_ffn, smallf + SM_GW_AB1, smallf + SM_BW_AB1};
              for (int rep = 0; rep < REP_G; ++rep) pg8::gemm_phase<pg8::EpiZ, pg8::StaticOrder, true, true, true>(lds, g, S, E, wave_s); }
            GRID_BAR();
            { PH_ARGS();
#if NAIVE_HGRN
              for (int u = bx; u < 66; u += G) naive_hgrn_unit(a, u, j, lds, wave_s);
#else
#ifndef SKIP_HA
              for (int rep = 0; rep < REP_HA; ++rep) for (int u = bx; u < 512; u += G) hgrn_a_unit2(a, u, j, lds, wave_s);
#endif
#endif
#if NAIVE_ATTN
              for (int u = bx; u < M / 64; u += G) naive_attn_unit(a, u, j, wave_s);
#else
              for (int rep = 0; rep < REP_ATT; ++rep) for (int u = bx; u < (M / 128) * 2; u += G) attn_unit(a, u, j, lds, wave_s);
#endif
            }
            GRID_BAR();
            { PH_ARGS();
#if NAIVE_HGRN
              naive_hgrn_finish(a, j, vcu, NGW, wave_s);
#else
#ifndef SKIP_HB
              for (int rep = 0; rep < REP_HBC; ++rep) for (int it = bx; it < 256; it += G) hgrn_b_item(a, it, wave_s);
#endif
#endif
            }
            GRID_BAR();
#if !NAIVE_HGRN
            { PH_ARGS();
#ifndef SKIP_HC
              for (int rep = 0; rep < REP_HBC; ++rep) for (int i = 0; i < 5; ++i) hgrn_c_wave4(a, i < 4 ? (bx * 4 + i) * 8 + wave_s : 8192 + bx * 8 + wave_s, j, lds, wave_s);
#endif
            }
            GRID_BAR();
#endif
            { PH_ARGS(); pg8::Gemm g{OB, Wb + W_OUTAB + (size_t)j * D * D, M, D, D}; pg8::StaticOrder S; S.init(M, D, G, bx);
              if (L == 0) { pg8::EpiResid<true> E{nullptr, nullptr, nullptr, XB, stat_mix, nullptr, nullptr, nullptr, ALPHA};
                  pg8::gemm_phase<pg8::EpiResid<true>, pg8::StaticOrder, true, true>(lds, g, S, E, wave_s); }
              else { pg8::EpiResid<false> E{nullptr, nullptr, nullptr, XB, stat_mix, stat_ffn, a.ln_ffn_g + (L - 1) * D, a.ln_ffn_b + (L - 1) * D, ALPHA};
                  pg8::gemm_phase<pg8::EpiResid<false>, pg8::StaticOrder, true, true>(lds, g, S, E, wave_s); } }
            GRID_BAR();
        } else {
            { PH_ARGS(); pg8::Gemm g{XB, Wb + W_INC + (size_t)j * 4096 * D, M, 4096, D}; pg8::StaticOrder S; S.init(M, 4096, G, bx);
              pg8::EpiGeluUV E{Zb, (bf16*)(ws + WS_R1), vstat, stat_ffn, smallf + SM_GW_C + j * 4096, smallf + SM_BW_C + j * 4096};
              for (int rep = 0; rep < REP_G; ++rep) pg8::gemm_phase<pg8::EpiGeluUV, pg8::StaticOrder, true, true, true>(lds, g, S, E, wave_s); }
            GRID_BAR();
            { PH_ARGS();
#if NAIVE_SGU
              for (int u = bx; u < (M / 128) * 8; u += G) naive_sgu_unit(a, u, j, lds, wave_s);
#else
              for (int i5 = 0; i5 < 5; ++i5) {
                  const int pmi = 40 * ((bx >> 2) & 7) + 8 * (4 - i5) + (bx >> 5); sgu_unit4(a, (2 * pmi + ((bx >> 1) & 1)) * 2 + (bx & 1), j, lds, wave_s); }
#endif
            }
            GRID_BAR();
            { PH_ARGS(); pg8::Gemm g{Zb, Wb + W_OUTC + (size_t)j * D * CW, M, D, CW}; pg8::StaticOrder S; S.init(M, D, G, bx);
              pg8::EpiResid<false> E{nullptr, nullptr, nullptr, XB, stat_mix, stat_ffn, a.ln_ffn_g + (L - 1) * D, a.ln_ffn_b + (L - 1) * D, ALPHA};
              pg8::gemm_phase<pg8::EpiResid<false>, pg8::StaticOrder, true, true>(lds, g, S, E, wave_s); }
            GRID_BAR();
        }
        { PH_ARGS(); pg8::Gemm g{XB, Wb + W_GU + (size_t)L * 2 * FF * D, M, 2 * FF, D}; pg8::StaticOrder S; S.init(M, 2 * FF, G, bx);
          pg8::EpiSwiglu E{Zb, stat_mix, smallf + SM_GW_GU + L * 5632, smallf + SM_BW_GU + L * 5632};
          for (int rep = 0; rep < REP_G; ++rep) pg8::gemm_phase<pg8::EpiSwiglu, pg8::StaticOrder, true, true, true>(lds, g, S, E, wave_s); }
        GRID_BAR();
        { PH_ARGS(); pg8::Gemm g{Zb, Wb + W_DN + (size_t)L * D * FF, M, D, FF}; pg8::StaticOrder S; S.init(M, D, G, bx, true);
          pg8::EpiResid<false> E{nullptr, nullptr, nullptr, XB, stat_ffn, stat_mix, a.ln_mix_g + L * D, a.ln_mix_b + L * D, ALPHA};
          pg8::gemm_phase<pg8::EpiResid<false>, pg8::StaticOrder, true, true>(lds, g, S, E, wave_s); }
        GRID_BAR();
    }
    { PH_ARGS(); PH_TID();
      f32x4 gq[4], bq[4];
#pragma unroll
      for (int jq = 0; jq < 4; ++jq) { gq[jq] = *((const f32x4*)(a.ln_ffn_g + 3 * D) + lane + 64 * jq); bq[jq] = *((const f32x4*)(a.ln_ffn_b + 3 * D) + lane + 64 * jq); }
      static_assert(M % (2 * NGW) == 0, "final LayerNorm: two rows per wave per step");
      for (int m0 = gw; m0 < M; m0 += 2 * NGW) {
          v2u xw[2][4]; f32x4 sv[2][8];
#pragma unroll
          for (int rr = 0; rr < 2; ++rr) { const int m = m0 + rr * NGW; const GAS v2u* xq = (const GAS v2u*)(XB + (size_t)m * D) + lane; const f32x4* sp = (const f32x4*)(stat_ffn + (size_t)m * 32);
#pragma unroll
              for (int jq = 0; jq < 4; ++jq) xw[rr][jq] = xq[64 * jq];
#pragma unroll
              for (int i8 = 0; i8 < 8; ++i8) sv[rr][i8] = sp[i8]; }
          __builtin_amdgcn_sched_barrier(0);
#pragma unroll
          for (int rr = 0; rr < 2; ++rr) { const int m = m0 + rr * NGW; float ms = 0.f;
#pragma unroll
              for (int i8 = 0; i8 < 8; ++i8) ms += sv[rr][i8][0] + sv[rr][i8][2];
              const float mu = ms * (1.0f / 16.0f); float q = 0.f;
#pragma unroll
              for (int i8 = 0; i8 < 8; ++i8) { const float d0 = sv[rr][i8][0] - mu, d1 = sv[rr][i8][2] - mu; q += (sv[rr][i8][1] + sv[rr][i8][3]) + 64.0f * (d0 * d0 + d1 * d1); }
              const float rstd = __builtin_amdgcn_rsqf(q * (1.0f / 1024.0f) + pg8::LN_EPS);
              GAS f32x4* op = (GAS f32x4*)(a.out + (size_t)m * D) + lane;
#pragma unroll
              for (int jq = 0; jq < 4; ++jq) { pg8::u32x2 w2; w2.x = xw[rr][jq].x; w2.y = xw[rr][jq].y; const f32x4 v = pg8::f16x4_to_f32(w2); op[64 * jq] = (v - mu) * rstd * gq[jq] + bq[jq]; } } } }
}

extern "C" void kernel_launch(void* const* d_in, const int* in_sizes, int n_in, void* d_out, int out_size, void* d_ws, size_t ws_size, hipStream_t stream) {
    static int grid = 0;
    if (grid == 0) {
        if (n_in != 20 || out_size != M * D || ws_size < WS_END) { fprintf(stderr, "kernel_launch: unexpected shapes (n_in %d out %d ws %zu)\n", n_in, out_size, ws_size); grid = -1; return; }
        int dev = 0, cus = 0, per_cu = 0;
        if (hipGetDevice(&dev) != hipSuccess || hipDeviceGetAttribute(&cus, hipDeviceAttributeMultiprocessorCount, dev) != hipSuccess) { grid = -1; return; }
        if (hipFuncSetAttribute((const void*)fwd_kernel, hipFuncAttributeMaxDynamicSharedMemorySize, LDS_BYTES) != hipSuccess) { fprintf(stderr, "kernel_launch: hipFuncSetAttribute failed\n"); grid = -1; return; }
        if (hipOccupancyMaxActiveBlocksPerMultiprocessor(&per_cu, (const void*)fwd_kernel, NTHR, LDS_BYTES) != hipSuccess || per_cu < 1) fprintf(stderr, "kernel_launch: occupancy query says %d\n", per_cu);
        (void)hipGetLastError();
        if (cus < 256) { fprintf(stderr, "kernel_launch: needs 256 CUs, device has %d\n", cus); grid = -1; return; }
        grid = 256;
    }
    if (grid < 0) return;
    (void)hipMemsetAsync((char*)d_ws + WS_CTL, 0, CTL_ZERO_BYTES, stream);
    Args a{};
    a.x_prompt = (const float*)d_in[0]; a.x_sample = (const float*)d_in[1]; a.w_in_ab = (const float*)d_in[2]; a.lb_logits = (const float*)d_in[3]; a.hgrn_norm_g = (const float*)d_in[4];
    a.attn_sink = (const float*)d_in[5]; a.w_out_ab = (const float*)d_in[6]; a.w_in_c = (const float*)d_in[7]; a.c_ln_g = (const float*)d_in[8]; a.c_ln_b = (const float*)d_in[9];
    a.c_ws = (const float*)d_in[10]; a.c_bs = (const float*)d_in[11]; a.w_out_c = (const float*)d_in[12]; a.w_gate = (const float*)d_in[13]; a.w_up = (const float*)d_in[14];
    a.w_down = (const float*)d_in[15]; a.ln_mix_g = (const float*)d_in[16]; a.ln_mix_b = (const float*)d_in[17]; a.ln_ffn_g = (const float*)d_in[18]; a.ln_ffn_b = (const float*)d_in[19];
    a.out = (float*)d_out; a.ws = (unsigned char*)d_ws;
    hipLaunchKernelGGL(fwd_kernel, dim3(grid), dim3(NTHR), LDS_BYTES, stream, a);
}
```

```cpp
#include <hip/hip_runtime.h>
#include <cstdio>
#include <cstdint>

#ifndef NAIVE_HGRN
#define NAIVE_HGRN 0
#endif
#ifndef NAIVE_ATTN
#define NAIVE_ATTN 0
#endif
#ifndef REP_G
#define REP_G 1
#endif
#ifndef REP_HA
#define REP_HA 1
#endif
#ifndef REP_ATT
#define REP_ATT 1
#endif
#ifndef REP_HBC
#define REP_HBC 1
#endif
#ifndef NAIVE_SGU
#define NAIVE_SGU 0
#endif

__device__ __forceinline__ int tid_from_wave(int wave_s) { return wave_s * 64 + (int)__builtin_amdgcn_mbcnt_hi(~0u, __builtin_amdgcn_mbcnt_lo(~0u, 0u)); }
namespace pg8 {
#define PG8_LAS __attribute__((address_space(3)))
typedef unsigned short bf16_t;
typedef short bf16x8 __attribute__((ext_vector_type(8)));
typedef _Float16 f16x8 __attribute__((ext_vector_type(8)));
typedef _Float16 f16x2 __attribute__((ext_vector_type(2)));
typedef float f32x4 __attribute__((ext_vector_type(4)));
typedef float f32x2 __attribute__((ext_vector_type(2)));
typedef unsigned u32x4 __attribute__((ext_vector_type(4)));
typedef unsigned u32x2 __attribute__((ext_vector_type(2)));
constexpr int BM = 256, BK = 64, HALF = 128, HTB = HALF * BK * 2, STAGE_BYTES = 8 * HTB, NXCD = 8, WGM = 8;

__host__ __device__ __forceinline__ int lds_byte(int r, int c) { const int st = (r >> 4) * 2 + (c >> 5), rr = r & 15, cc = c & 31, ob = rr * 64 + cc * 2; return st * 1024 + (ob ^ (((ob >> 9) & 1) << 5)); }
__host__ __device__ __forceinline__ void stage_rc(int b, int& R, int& C) { const int st = b / 1024, sb = b % 1024, swz = sb ^ (((sb >> 9) & 1) << 5); R = (st >> 1) * 16 + swz / 64; C = (st & 1) * 32 + (swz % 64) / 2; }
__host__ __device__ __forceinline__ int perm32(int rho) { const int n = rho >> 4, i = rho & 15; return 8 * (i >> 2) + 4 * n + (i & 3); }

struct Unit { int pm, pn; };
struct Gemm { const bf16_t* A; const bf16_t* Bt; int M, N, K; };

struct StaticOrder {
    int nM, nN, nwg, G, c; bool rev;
    __host__ __device__ void init(int M, int N, int G_, int c_, bool rev_ = false) { nM = M / BM; nN = N / BM; nwg = nM * nN; G = G_; c = c_; rev = rev_; }
    __host__ __device__ bool next(int i, Unit& u) const {
        const long L = (long)i * G + c; if (L >= nwg) return false;
        int wgid = (int)L; { const int q = nwg / NXCD, r = nwg % NXCD, xcd = wgid % NXCD, off = wgid / NXCD, cnt = xcd < r ? q + 1 : q; wgid = (xcd < r ? xcd * (q + 1) : r * (q + 1) + (xcd - r) * q) + (rev ? cnt - 1 - off : off); }
        const int nig = WGM * nN, gid = wgid / nig, fm = gid * WGM, gsz = (nM - fm) < WGM ? (nM - fm) : WGM;
        u.pm = fm + ((wgid % nig) % gsz); u.pn = (wgid % nig) / gsz; return true;
    }
    __device__ __forceinline__ void a_ready(const Unit&) const {}
    __device__ __forceinline__ void done(const Unit&) const {}
};

typedef __bf16 bf16x2_t __attribute__((ext_vector_type(2)));
__device__ __forceinline__ unsigned cvt_pk_bf16(float lo, float hi) { bf16x2_t v = {(__bf16)lo, (__bf16)hi}; return __builtin_bit_cast(unsigned, v); }
__device__ __forceinline__ f32x2 gelu_pk(f32x2 v) {
    const f32x2 av = __builtin_elementwise_abs(v), d = av * 0.2316418882f + 1.0f;
    f32x2 t; t.x = __builtin_amdgcn_rcpf(d.x); t.y = __builtin_amdgcn_rcpf(d.y);
    f32x2 q = t * 0.5307027145f + (-0.7265760135f); q = q * t + 0.7107068705f; q = q * t + (-0.142248368f); q = q * t + 0.127414796f; q = q * t;
    const f32x2 s = (v * v) * (-0.72134752044f);
    f32x2 e; e.x = __builtin_amdgcn_exp2f(s.x); e.y = __builtin_amdgcn_exp2f(s.y);
    const f32x2 m = v * (q * e), r = v - m;
    f32x2 o; o.x = v.x < 0.f ? m.x : r.x; o.y = v.y < 0.f ? m.y : r.y; return o;
}

constexpr float LN_EPS = 1e-5f;
__device__ __forceinline__ void row_mu_rstd(const float* stat, int row, float& mu, float& rstd) {
    const f32x4* p = (const f32x4*)(stat + (size_t)row * 32);
    f32x4 v[8]; float ms = 0.f;
#pragma unroll
    for (int i = 0; i < 8; ++i) { v[i] = p[i]; ms += v[i][0] + v[i][2]; }
    const float mean = ms * (1.0f / 16.0f); float q = 0.f;
#pragma unroll
    for (int i = 0; i < 8; ++i) { const float d0 = v[i][0] - mean, d1 = v[i][2] - mean; q += (v[i][1] + v[i][3]) + 64.0f * (d0 * d0 + d1 * d1); }
    mu = mean; rstd = __builtin_amdgcn_rsqf(q * (1.0f / 1024.0f) + LN_EPS);
}

constexpr int STAT_TAB_OFF = STAGE_BYTES;
__device__ __forceinline__ float lane_xor1(float x) { return __builtin_bit_cast(float, __builtin_amdgcn_update_dpp(0, __builtin_bit_cast(int, x), 0xB1, 0xF, 0xF, false)); }
__device__ __forceinline__ void stat_tab_build(PG8_LAS unsigned char* lds, const float* stat, int pm, int wr, int wc, int lane) {
    const int lrow = (wc >> 1) * HALF + wr * 64 + (wc & 1) * 32 + (lane >> 1);
    const f32x4* p = (const f32x4*)(stat + (size_t)(pm * BM + lrow) * 32 + (lane & 1) * 16);
    const f32x4 v0 = p[0], v1 = p[1], v2 = p[2], v3 = p[3];
    float ms = ((v0[0] + v0[2]) + (v1[0] + v1[2])) + ((v2[0] + v2[2]) + (v3[0] + v3[2])); ms += lane_xor1(ms);
    const float mean = ms * (1.0f / 16.0f);
    const float d0 = v0[0] - mean, d1 = v0[2] - mean, d2 = v1[0] - mean, d3 = v1[2] - mean, d4 = v2[0] - mean, d5 = v2[2] - mean, d6 = v3[0] - mean, d7 = v3[2] - mean;
    float q = (((v0[1] + v0[3]) + (v1[1] + v1[3])) + ((v2[1] + v2[3]) + (v3[1] + v3[3]))) + 64.0f * (((d0 * d0 + d1 * d1) + (d2 * d2 + d3 * d3)) + ((d4 * d4 + d5 * d5) + (d6 * d6 + d7 * d7)));
    q += lane_xor1(q);
    const float rstd = __builtin_amdgcn_rsqf(q * (1.0f / 1024.0f) + LN_EPS);
    if ((lane & 1) == 0) *(PG8_LAS f32x2*)(lds + STAT_TAB_OFF + lrow * 8) = (f32x2){mean, rstd};
    asm volatile("s_waitcnt lgkmcnt(0)" ::: "memory");
    __builtin_amdgcn_s_barrier();
}
__device__ __forceinline__ void stat_tab_get(PG8_LAS unsigned char* lds, int lrow, float& mu, float& rstd) { const f32x2 t = *(const PG8_LAS f32x2*)(lds + STAT_TAB_OFF + lrow * 8); mu = t.x; rstd = t.y; }
#define RG_ROW(rg) (row0 + ((rg) >> 2) * HALF + ((rg) & 3) * 16)

struct EpiZ {
    static constexpr bool PERM = true, AFTER_DRAIN = false;
    bf16_t* O; int ldc; const float* stat; const float* gW; const float* bW;
    __device__ __forceinline__ void operator()(const f32x4 (&acc)[2][2][4][2], const Unit& u, int wr, int wc, int fr, int fq, PG8_LAS unsigned char* lds, bool tab_valid) const {
        const int row0 = u.pm * BM + wr * 64 + fr, col0 = u.pn * BM + wc * 32 + 8 * fq;
        f32x4 gv[2][2], bv[2][2];
#pragma unroll
        for (int bj = 0; bj < 2; ++bj)
#pragma unroll
            for (int n = 0; n < 2; ++n) { gv[bj][n] = stat ? *(const f32x4*)(gW + col0 + bj * HALF + 4 * n) : (f32x4){0.f, 0.f, 0.f, 0.f}; bv[bj][n] = stat ? *(const f32x4*)(bW + col0 + bj * HALF + 4 * n) : (f32x4){0.f, 0.f, 0.f, 0.f}; }
        if (stat && !tab_valid) stat_tab_build(lds, stat, u.pm, wr, wc, fr + 16 * fq);
#pragma unroll
        for (int rg = 0; rg < 8; ++rg) { const int ai = rg >> 2, m = rg & 3; const int row = RG_ROW(rg); bf16_t* rowp = O + (size_t)row * ldc + col0;
                float mu = 0.f, rstd = 1.f; if (stat) stat_tab_get(lds, row - u.pm * BM, mu, rstd);
#pragma unroll
                for (int bj = 0; bj < 2; ++bj) { const f32x4 v0 = (acc[ai][bj][m][0] - mu * gv[bj][0]) * rstd + bv[bj][0], v1 = (acc[ai][bj][m][1] - mu * gv[bj][1]) * rstd + bv[bj][1];
                    u32x4 w; w.x = cvt_pk_bf16(v0[0], v0[1]); w.y = cvt_pk_bf16(v0[2], v0[3]); w.z = cvt_pk_bf16(v1[0], v1[1]); w.w = cvt_pk_bf16(v1[2], v1[3]);
                    *(u32x4*)(rowp + bj * HALF) = w; }
                asm volatile("" ::: "memory"); }
    }
};
struct EpiGeluUV {
    static constexpr bool PERM = true, AFTER_DRAIN = false;
    bf16_t* U; bf16_t* V; float* vstat; const float* stat; const float* gW; const float* bW;
    __device__ __forceinline__ void operator()(const f32x4 (&acc)[2][2][4][2], const Unit& u, int wr, int wc, int fr, int fq, PG8_LAS unsigned char* lds, bool tab_valid) const {
        const int row0 = u.pm * BM + wr * 64 + fr, col0 = u.pn * BM + wc * 32 + 8 * fq;
        const bool isv = u.pn >= 8; bf16_t* base = isv ? V : U; const int ocol0 = col0 - (isv ? 2048 : 0);
        f32x4 gv[2][2], bv[2][2];
#pragma unroll
        for (int bj = 0; bj < 2; ++bj)
#pragma unroll
            for (int n = 0; n < 2; ++n) { gv[bj][n] = *(const f32x4*)(gW + col0 + bj * HALF + 4 * n); bv[bj][n] = *(const f32x4*)(bW + col0 + bj * HALF + 4 * n); }
        if (!tab_valid) stat_tab_build(lds, stat, u.pm, wr, wc, fr + 16 * fq);
#pragma unroll
        for (int rg = 0; rg < 8; ++rg) { const int ai = rg >> 2, m = rg & 3; const int row = RG_ROW(rg); bf16_t* rowp = base + (size_t)row * 2048 + ocol0;
                float mu, rstd; stat_tab_get(lds, row - u.pm * BM, mu, rstd);
                f32x4 y[2][2];
#pragma unroll
                for (int bj = 0; bj < 2; ++bj) {
#pragma unroll
                    for (int n = 0; n < 2; ++n) { const f32x4 z = (acc[ai][bj][m][n] - mu * gv[bj][n]) * rstd + bv[bj][n];
                        const f32x2 a = gelu_pk((f32x2){z[0], z[1]}), b = gelu_pk((f32x2){z[2], z[3]}); y[bj][n] = (f32x4){a.x, a.y, b.x, b.y}; }
                    u32x4 w; w.x = cvt_pk_bf16(y[bj][0][0], y[bj][0][1]); w.y = cvt_pk_bf16(y[bj][0][2], y[bj][0][3]); w.z = cvt_pk_bf16(y[bj][1][0], y[bj][1][1]); w.w = cvt_pk_bf16(y[bj][1][2], y[bj][1][3]);
                    *(u32x4*)(rowp + bj * HALF) = w; }
                if (isv) {
                    float s = 0.f;
#pragma unroll
                    for (int bj = 0; bj < 2; ++bj)
#pragma unroll
                        for (int n = 0; n < 2; ++n) s += (y[bj][n][0] + y[bj][n][1]) + (y[bj][n][2] + y[bj][n][3]);
                    s += __shfl_xor(s, 16); s += __shfl_xor(s, 32);
                    const float mw = s * (1.0f / 64.0f); float q = 0.f;
#pragma unroll
                    for (int bj = 0; bj < 2; ++bj)
#pragma unroll
                        for (int n = 0; n < 2; ++n) { const f32x4 d = y[bj][n] - mw; q += (d[0] * d[0] + d[1] * d[1]) + (d[2] * d[2] + d[3] * d[3]); }
                    q += __shfl_xor(q, 16); q += __shfl_xor(q, 32);
                    if (fq == 0) *(f32x2*)(vstat + ((size_t)row * 32 + (u.pn - 8) * 4 + wc) * 2) = (f32x2){mw, q};
                }
                asm volatile("" ::: "memory"); }
    }
};
__device__ __forceinline__ float silu_e(float x) { return x * __builtin_amdgcn_rcpf(1.0f + __expf(-x)); }
struct EpiSwiglu {
    static constexpr bool PERM = true, AFTER_DRAIN = false;
    bf16_t* H; const float* stat; const float* gW; const float* bW;
    __device__ __forceinline__ void operator()(const f32x4 (&acc)[2][2][4][2], const Unit& u, int wr, int wc, int fr, int fq, PG8_LAS unsigned char* lds, bool tab_valid) const {
        const int row0 = u.pm * BM + wr * 64 + fr, col0 = u.pn * BM + wc * 32 + 8 * fq, hcol0 = u.pn * HALF + wc * 32 + 8 * fq;
        f32x4 gv[2][2], bv[2][2];
#pragma unroll
        for (int bj = 0; bj < 2; ++bj)
#pragma unroll
            for (int n = 0; n < 2; ++n) { gv[bj][n] = *(const f32x4*)(gW + col0 + bj * HALF + 4 * n); bv[bj][n] = *(const f32x4*)(bW + col0 + bj * HALF + 4 * n); }
        if (!tab_valid) stat_tab_build(lds, stat, u.pm, wr, wc, fr + 16 * fq);
#pragma unroll
        for (int rg = 0; rg < 8; ++rg) { const int ai = rg >> 2, m = rg & 3; const int row = RG_ROW(rg);
                float mu, rstd; stat_tab_get(lds, row - u.pm * BM, mu, rstd);
                f32x4 h[2];
#pragma unroll
                for (int n = 0; n < 2; ++n) { const f32x4 g = (acc[ai][0][m][n] - mu * gv[0][n]) * rstd + bv[0][n], up = (acc[ai][1][m][n] - mu * gv[1][n]) * rstd + bv[1][n];
#pragma unroll
                    for (int j = 0; j < 4; ++j) h[n][j] = silu_e(g[j]) * up[j]; }
                u32x4 w; w.x = cvt_pk_bf16(h[0][0], h[0][1]); w.y = cvt_pk_bf16(h[0][2], h[0][3]); w.z = cvt_pk_bf16(h[1][0], h[1][1]); w.w = cvt_pk_bf16(h[1][2], h[1][3]);
                *(u32x4*)(H + (size_t)row * 2816 + hcol0) = w;
                asm volatile("" ::: "memory"); }
    }
};
__device__ __forceinline__ f32x4 f16x4_to_f32(const u32x2 w) { const unsigned wx = w.x, wy = w.y;
    const f16x2 a = __builtin_bit_cast(f16x2, wx), b = __builtin_bit_cast(f16x2, wy); return (f32x4){(float)a.x, (float)a.y, (float)b.x, (float)b.y}; }
__device__ __forceinline__ unsigned cvt_pk_f16(float lo, float hi) { f16x2 t; t.x = (_Float16)lo; t.y = (_Float16)hi; return __builtin_bit_cast(unsigned, t); }
template <bool F32IN>
struct EpiResid {
    static constexpr bool PERM = true, AFTER_DRAIN = false;
    const float* Xa; const float* Xb; float* out; bf16_t* xb; float* statOut; const float* stat; const float* lg; const float* lb; float alpha;
    __device__ __forceinline__ void operator()(const f32x4 (&acc)[2][2][4][2], const Unit& u, int wr, int wc, int fr, int fq, PG8_LAS unsigned char* lds, bool tab_valid) const {
        const int row0 = u.pm * BM + wr * 64 + fr, col0 = u.pn * BM + wc * 32 + 8 * fq;
        f32x4 gv[2][2], bv[2][2];
        if constexpr (!F32IN) {
#pragma unroll
            for (int bj = 0; bj < 2; ++bj)
#pragma unroll
                for (int n = 0; n < 2; ++n) { gv[bj][n] = *(const f32x4*)(lg + col0 + bj * HALF + 4 * n); bv[bj][n] = *(const f32x4*)(lb + col0 + bj * HALF + 4 * n); }
        }
        const bf16_t* qbase = xb + (size_t)row0 * 1024 + col0;
        u32x4 xq[2][2];
#pragma unroll
        for (int bj = 0; bj < 2; ++bj) xq[0][bj] = *(const u32x4*)(qbase + bj * HALF);
        if constexpr (!F32IN) { if (!tab_valid) stat_tab_build(lds, stat, u.pm, wr, wc, fr + 16 * fq); }
#pragma unroll
        for (int rg = 0; rg < 8; ++rg) { const int ai = rg >> 2, m = rg & 3; const int row = RG_ROW(rg);
                if (rg < 7) { const size_t ro = (size_t)((((rg + 1) >> 2) * HALF + ((rg + 1) & 3) * 16)) * 1024;
#pragma unroll
                    for (int bj = 0; bj < 2; ++bj) xq[(rg + 1) & 1][bj] = *(const u32x4*)(qbase + ro + bj * HALF); }
                float mu = 0.f, rstd = 1.f; if constexpr (!F32IN) stat_tab_get(lds, row - u.pm * BM, mu, rstd);
                f32x4 y[2][2]; float s = 0.f;
#pragma unroll
                for (int bj = 0; bj < 2; ++bj)
#pragma unroll
                    for (int n = 0; n < 2; ++n) { f32x4 xin;
                        { const u32x4 w4 = xq[rg & 1][bj]; u32x2 w2; w2.x = n ? w4.z : w4.x; w2.y = n ? w4.w : w4.y; xin = f16x4_to_f32(w2); if constexpr (!F32IN) xin = (xin - mu) * rstd * gv[bj][n] + bv[bj][n]; }
                        y[bj][n] = alpha * xin + acc[ai][bj][m][n]; s += (y[bj][n][0] + y[bj][n][1]) + (y[bj][n][2] + y[bj][n][3]); }
                s += __shfl_xor(s, 16); s += __shfl_xor(s, 32);
                const float mw = s * (1.0f / 64.0f); float q = 0.f;
#pragma unroll
                for (int bj = 0; bj < 2; ++bj) {
#pragma unroll
                    for (int n = 0; n < 2; ++n) { const f32x4 d = y[bj][n] - mw; q += (d[0] * d[0] + d[1] * d[1]) + (d[2] * d[2] + d[3] * d[3]);
                        if (out) *(f32x4*)(out + (size_t)row * 1024 + col0 + bj * HALF + 4 * n) = y[bj][n]; }
                    u32x4 w; w.x = cvt_pk_f16(y[bj][0][0], y[bj][0][1]); w.y = cvt_pk_f16(y[bj][0][2], y[bj][0][3]); w.z = cvt_pk_f16(y[bj][1][0], y[bj][1][1]); w.w = cvt_pk_f16(y[bj][1][2], y[bj][1][3]);
                    *(u32x4*)(xb + (size_t)row * 1024 + col0 + bj * HALF) = w; }
                q += __shfl_xor(q, 16); q += __shfl_xor(q, 32);
                if (fq == 0) *(f32x2*)(statOut + ((size_t)row * 16 + u.pn * 4 + wc) * 2) = (f32x2){mw, q};
                asm volatile("" ::: "memory"); }
    }
};

template <class Epi, class Sched, bool ALIGN_EPI = false, bool SP2 = false, bool F16 = false>
__device__ __forceinline__ void gemm_phase(PG8_LAS unsigned char* lds, const Gemm g, const Sched& S, const Epi& E, int wave_s) {
    int tid_ = tid_from_wave(wave_s); asm volatile("" : "+v"(tid_));
    const int tid = tid_, wid = __builtin_amdgcn_readfirstlane(tid >> 6), lane = tid & 63, wr = wid >> 2, wc = wid & 3, fr = lane & 15, fq = lane >> 4;
    const int K = g.K, nt = K / BK;
    unsigned voffA[2], voffB[2];
#pragma unroll
    for (int i = 0; i < 2; ++i) { int R, C; stage_rc(tid * 16 + i * 8192, R, C); const int Rb = Epi::PERM ? ((R & ~31) + perm32(R & 31)) : R;
        voffA[i] = (unsigned)(R * K + C) * 2u; voffB[i] = (unsigned)(Rb * K + C) * 2u; }
    const size_t kstep = (size_t)(BK * 2);
    const size_t hstep = (size_t)HALF * K * 2;
    const size_t tstep = 2 * hstep;
    const unsigned ldsw = (unsigned)wid * 1024u;
    const int aoff = lds_byte(wr * 64 + fr, fq * 8), boff = lds_byte(wc * 32 + fr, fq * 8);
#define PG8_SA(b, h) (((b) * 2 + (h)) * HTB)
#define PG8_SB(b, h) ((4 + (b) * 2 + (h)) * HTB)
#define PG8_STAGE(bufoff, gbase, voff) do { _Pragma("unroll") for (int _i = 0; _i < 2; ++_i) \
        __builtin_amdgcn_global_load_lds((const unsigned*)((const char*)(gbase) + (voff)[_i]), (PG8_LAS unsigned*)(lds + (bufoff) + ldsw + _i * 8192), 16, 0, 0); } while (0)
#define PG8_LDA(dst, b, h) do { _Pragma("unroll") for (int m = 0; m < 4; ++m) _Pragma("unroll") for (int k = 0; k < 2; ++k) dst[m][k] = *(const PG8_LAS bf16x8*)(lds + PG8_SA(b, h) + aoff + m * 2048 + k * 1024); } while (0)
#define PG8_LDB(dst, b, h) do { _Pragma("unroll") for (int n = 0; n < 2; ++n) _Pragma("unroll") for (int k = 0; k < 2; ++k) dst[n][k] = *(const PG8_LAS bf16x8*)(lds + PG8_SB(b, h) + boff + n * 2048 + k * 1024); } while (0)
#define PG8_MMA(ai, bj, At, Bt) do { __builtin_amdgcn_s_setprio(1); _Pragma("unroll") for (int m = 0; m < 4; ++m) _Pragma("unroll") for (int n = 0; n < 2; ++n) _Pragma("unroll") for (int k = 0; k < 2; ++k) \
        { if constexpr (F16) acc[ai][bj][m][n] = __builtin_amdgcn_mfma_f32_16x16x32_f16(__builtin_bit_cast(f16x8, Bt[n][k]), __builtin_bit_cast(f16x8, At[m][k]), acc[ai][bj][m][n], 0, 0, 0); \
          else acc[ai][bj][m][n] = __builtin_amdgcn_mfma_f32_16x16x32_bf16(Bt[n][k], At[m][k], acc[ai][bj][m][n], 0, 0, 0); } __builtin_amdgcn_s_setprio(0); } while (0)
#define PG8_WAIT_V(n) asm volatile("s_waitcnt vmcnt(" #n ")" ::: "memory")
#define PG8_WAIT_L(n) asm volatile("s_waitcnt lgkmcnt(" #n ")" ::: "memory")
#define PG8_BAR __builtin_amdgcn_s_barrier()
#define PG8_SCHED __builtin_amdgcn_sched_barrier(0)
    Unit cur, nxt; int ui = 0, tab_pm = -1;
    if (!S.next(0, cur)) return;
    f32x4 acc[2][2][4][2];
#pragma unroll
    for (int a = 0; a < 2; ++a)
#pragma unroll
        for (int b = 0; b < 2; ++b)
#pragma unroll
            for (int m = 0; m < 4; ++m)
#pragma unroll
                for (int n = 0; n < 2; ++n) acc[a][b][m][n] = (f32x4){0.f, 0.f, 0.f, 0.f};
    bf16x8 At[4][2], B0[2][2], B1[2][2];
    const char* cA = (const char*)g.A + (size_t)cur.pm * tstep; const char* cB = (const char*)g.Bt + (size_t)cur.pn * tstep;
    S.a_ready(cur);
    if constexpr (SP2) {
        PG8_STAGE(PG8_SB(0, 0), cB, voffB); PG8_STAGE(PG8_SB(0, 1), cB + hstep, voffB); PG8_STAGE(PG8_SA(0, 0), cA, voffA); PG8_STAGE(PG8_SA(0, 1), cA + hstep, voffA);
        if (wr == 1) PG8_BAR;
        PG8_WAIT_V(2); PG8_BAR;
        PG8_STAGE(PG8_SB(1, 0), cB + kstep, voffB); PG8_STAGE(PG8_SA(1, 0), cA + kstep, voffA); PG8_STAGE(PG8_SB(1, 1), cB + hstep + kstep, voffB);
        PG8_WAIT_V(6); PG8_BAR;
    } else {
        PG8_STAGE(PG8_SB(0, 0), cB, voffB); PG8_STAGE(PG8_SA(0, 0), cA, voffA); PG8_STAGE(PG8_SB(0, 1), cB + hstep, voffB); PG8_STAGE(PG8_SA(0, 1), cA + hstep, voffA);
        if (wr == 1) PG8_BAR;
        PG8_WAIT_V(4); PG8_BAR;
        PG8_STAGE(PG8_SB(1, 0), cB + kstep, voffB); PG8_STAGE(PG8_SA(1, 0), cA + kstep, voffA); PG8_STAGE(PG8_SB(1, 1), cB + hstep + kstep, voffB);
        PG8_WAIT_V(6); PG8_BAR;
    }
    for (;;) {
        const bool has_next = S.next(ui + 1, nxt);
        const char* nA = has_next ? (const char*)g.A + (size_t)nxt.pm * tstep : cA; const char* nB = has_next ? (const char*)g.Bt + (size_t)nxt.pn * tstep : cB;
        for (int t = 0; t < nt; t += 2) {
            const bool last = (t == nt - 2);
            const char* a1 = cA + (size_t)(t + 1) * kstep;
            const char* a2 = last ? nA : cA + (size_t)(t + 2) * kstep; const char* b2 = last ? nB : cB + (size_t)(t + 2) * kstep;
            const char* a3 = a2 + kstep; const char* b3 = b2 + kstep;
            if (last && has_next) S.a_ready(nxt);
            if constexpr (SP2) {
            PG8_LDB(B0, 0, 0); PG8_LDB(B1, 0, 1); PG8_SCHED; PG8_LDA(At, 0, 0); PG8_STAGE(PG8_SA(1, 1), a1 + hstep, voffA);
            PG8_WAIT_V(8); PG8_WAIT_L(0); PG8_BAR; PG8_MMA(0, 0, At, B0); PG8_MMA(0, 1, At, B1); PG8_BAR; PG8_SCHED;
            PG8_LDA(At, 0, 1); PG8_STAGE(PG8_SB(0, 0), b2, voffB); PG8_STAGE(PG8_SB(0, 1), b2 + hstep, voffB); PG8_STAGE(PG8_SA(0, 0), a2, voffA);
            PG8_WAIT_V(8); PG8_WAIT_L(0); PG8_BAR; PG8_MMA(1, 0, At, B0); PG8_MMA(1, 1, At, B1); PG8_BAR; PG8_SCHED;
            PG8_LDB(B0, 1, 0); PG8_LDB(B1, 1, 1); PG8_SCHED; PG8_LDA(At, 1, 0); PG8_STAGE(PG8_SA(0, 1), a2 + hstep, voffA);
            PG8_WAIT_V(8); PG8_WAIT_L(0); PG8_BAR; PG8_MMA(0, 0, At, B0); PG8_MMA(0, 1, At, B1); PG8_BAR; PG8_SCHED;
            PG8_LDA(At, 1, 1); PG8_STAGE(PG8_SB(1, 0), b3, voffB); PG8_STAGE(PG8_SB(1, 1), b3 + hstep, voffB); PG8_STAGE(PG8_SA(1, 0), a3, voffA);
            PG8_WAIT_V(8); PG8_WAIT_L(0); PG8_BAR; PG8_MMA(1, 0, At, B0); PG8_MMA(1, 1, At, B1); PG8_BAR; PG8_SCHED;
            } else {
            PG8_LDB(B0, 0, 0); PG8_SCHED; PG8_LDA(At, 0, 0); PG8_STAGE(PG8_SA(1, 1), a1 + hstep, voffA);
            PG8_WAIT_L(8); PG8_BAR; PG8_WAIT_L(0); PG8_MMA(0, 0, At, B0); PG8_BAR; PG8_SCHED;
            PG8_LDB(B1, 0, 1); PG8_STAGE(PG8_SB(0, 0), b2, voffB);
            PG8_BAR; PG8_WAIT_L(0); PG8_MMA(0, 1, At, B1); PG8_BAR;
            PG8_LDA(At, 0, 1); PG8_STAGE(PG8_SA(0, 0), a2, voffA);
            PG8_BAR; PG8_WAIT_L(0); PG8_MMA(1, 0, At, B0); PG8_BAR; PG8_SCHED;
            PG8_STAGE(PG8_SB(0, 1), b2 + hstep, voffB);
            PG8_WAIT_V(6); PG8_BAR; PG8_MMA(1, 1, At, B1); PG8_BAR;
            PG8_LDB(B0, 1, 0); PG8_SCHED; PG8_LDA(At, 1, 0); PG8_STAGE(PG8_SA(0, 1), a2 + hstep, voffA);
            PG8_WAIT_L(8); PG8_BAR; PG8_WAIT_L(0); PG8_MMA(0, 0, At, B0); PG8_BAR; PG8_SCHED;
            PG8_LDB(B1, 1, 1); PG8_STAGE(PG8_SB(1, 0), b3, voffB);
            PG8_BAR; PG8_WAIT_L(0); PG8_MMA(0, 1, At, B1); PG8_BAR;
            PG8_LDA(At, 1, 1); PG8_STAGE(PG8_SA(1, 0), a3, voffA);
            PG8_BAR; PG8_WAIT_L(0); PG8_MMA(1, 0, At, B0); PG8_BAR; PG8_SCHED;
            PG8_STAGE(PG8_SB(1, 1), b3 + hstep, voffB);
            PG8_WAIT_V(6); PG8_BAR; PG8_MMA(1, 1, At, B1); PG8_BAR;
            }
        }
        if constexpr (ALIGN_EPI) { if (wr == 0) PG8_BAR; }
        if constexpr (!Epi::AFTER_DRAIN) { E(acc, cur, wr, wc, fr, fq, lds, cur.pm == tab_pm); tab_pm = cur.pm; S.done(cur); }
        if (!has_next) break;
#pragma unroll
        for (int a = 0; a < 2; ++a)
#pragma unroll
            for (int b = 0; b < 2; ++b)
#pragma unroll
                for (int m = 0; m < 4; ++m)
#pragma unroll
                    for (int n = 0; n < 2; ++n) acc[a][b][m][n] = (f32x4){0.f, 0.f, 0.f, 0.f};
        cur = nxt; cA = nA; cB = nB; ++ui;
        if constexpr (ALIGN_EPI) { if (wr == 1) PG8_BAR; }
    }
    PG8_WAIT_V(0);
    if constexpr (!ALIGN_EPI) { if (wr == 0) PG8_BAR; }
    PG8_BAR;
#undef PG8_SA
#undef PG8_SB
#undef PG8_STAGE
#undef PG8_LDA
#undef PG8_LDB
#undef PG8_MMA
#undef PG8_WAIT_V
#undef PG8_WAIT_L
#undef PG8_BAR
#undef PG8_SCHED
}
}

__device__ __forceinline__ float silu_f(float x) { return x * __builtin_amdgcn_rcpf(1.0f + __expf(-x)); }
constexpr int NWAVES = 8, NTHR = 512;
constexpr int D = 1024, MP = 65536, MS = 16384, M = MP + MS;
constexpr int AW = 512, NZ = 3328, FF = 2816, CW = 2048;
constexpr int ZQ = 0, ZFF = 512, ZFB = 1024, ZI = 1536, ZG = 2048, ZQB = 2560, ZKB = 3072, ZVB = 3200;
constexpr float ALPHA = 1.681792830507429f, RMS_EPS = 1e-6f;
__device__ __forceinline__ int seq_start(int t) { return t < MP ? (t & ~2047) : MP; }
__device__ __forceinline__ int seq_end(int t) { return t < MP ? (t & ~2047) + 2048 : M; }

constexpr size_t MiB = 1u << 20;
constexpr size_t WS_CTL = 0, CTL_ZERO_BYTES = 64 * 1024;
constexpr size_t WS_SMALL = 1 * MiB;
constexpr size_t SM_LB = 0;
constexpr size_t SM_GW_AB1 = 4096, SM_BW_AB1 = SM_GW_AB1 + 3328;
constexpr size_t SM_GW_C = SM_BW_AB1 + 3328;
constexpr size_t SM_BW_C = SM_GW_C + 2 * 4096;
constexpr size_t SM_GW_GU = SM_BW_C + 2 * 4096;
constexpr size_t SM_BW_GU = SM_GW_GU + 4 * 5632;
constexpr size_t SM_RSW = SM_BW_GU + 4 * 5632;
constexpr size_t SM_TDEC = SM_RSW + 2048;
constexpr size_t SM_END = SM_TDEC + 1280 * 128;
constexpr int FOLD_N = (int)(SM_RSW - SM_GW_AB1);
constexpr size_t WS_PF = 3 * MiB + 512 * 1024;
static_assert(WS_PF + 16ull * FOLD_N * 4 <= 8 * MiB, "fold partials");
static_assert(SM_END * 4 <= 2 * MiB, "small region");
constexpr size_t WS_WSB = 3 * MiB;
constexpr size_t WS_STATMIX = 8 * MiB, WS_STATFFN = 18 * MiB, WS_VSTAT = 28 * MiB;
constexpr size_t WS_W = 48 * MiB;
constexpr size_t W_INAB = 0, W_OUTAB = W_INAB + 2ull * NZ * D, W_INC = W_OUTAB + 2ull * D * D, W_OUTC = W_INC + 2ull * 4096 * D, W_GU = W_OUTC + 2ull * D * CW, W_DN = W_GU + 4ull * 2 * FF * D, W_END = W_DN + 4ull * D * FF;
static_assert(W_END * 2 <= 108 * MiB, "weights");
constexpr size_t WS_XB = 156 * MiB;
constexpr size_t WS_Z = 316 * MiB;
constexpr size_t WS_R1 = 836 * MiB;
constexpr size_t WS_OB = WS_R1, WS_QT = WS_R1 + 160 * MiB;
constexpr size_t WS_F = 1156 * MiB, WS_SIN = 1236 * MiB, WS_END = 1276 * MiB;

constexpr int LDS_BYTES = 163840;
constexpr int MISC_OFF = 163840 - 256;

#define GAS __attribute__((address_space(1)))
#define LAS __attribute__((address_space(3)))
typedef unsigned short bf16;
typedef unsigned v4u __attribute__((ext_vector_type(4)));
typedef unsigned v2u __attribute__((ext_vector_type(2)));
typedef float f32x4 __attribute__((ext_vector_type(4)));
typedef short bf16x8 __attribute__((ext_vector_type(8)));
typedef GAS unsigned gu32;
#define RLX_AGENT __ATOMIC_RELAXED, __HIP_MEMORY_SCOPE_AGENT
#define LDS_WAIT() asm volatile("s_waitcnt lgkmcnt(0)" ::: "memory")
#define LDS_SYNC() do { asm volatile("s_waitcnt lgkmcnt(0)" ::: "memory"); __builtin_amdgcn_s_barrier(); asm volatile("" ::: "memory"); } while (0)
#define VM_WAIT() asm volatile("s_waitcnt vmcnt(0)" ::: "memory")
__device__ __forceinline__ unsigned f2bf(float f) { unsigned u = __builtin_bit_cast(unsigned, f); return (u + 0x7fffu + ((u >> 16) & 1u)) >> 16; }
__device__ __forceinline__ unsigned pk2(float lo, float hi) { return f2bf(lo) | (f2bf(hi) << 16); }
__device__ __forceinline__ unsigned pk2h(float lo, float hi) { pg8::f16x2 t; t.x = (_Float16)lo; t.y = (_Float16)hi; return __builtin_bit_cast(unsigned, t); }
__device__ __forceinline__ float bf2f(unsigned short b) { return __builtin_bit_cast(float, (unsigned)b << 16); }
__device__ __forceinline__ float bflo(unsigned w) { return __builtin_bit_cast(float, w << 16); }
__device__ __forceinline__ float bfhi(unsigned w) { return __builtin_bit_cast(float, w & 0xffff0000u); }

#define XB_TMO      128
#define XB_XCNT(j)  (256  + 64 * (j))
#define XB_XSUB(j)  (1280 + 64 * (j))
#define XB_XGEN(j)  (2304 + 64 * (j))
#define XB_TOP      3328
#define XB_TOPGEN   3392
#define XCD_BAR_WORDS 3456
#define XB_SPIN_CAP (1u << 22)
__device__ __forceinline__ unsigned xb_ld(unsigned* p)              { return __hip_atomic_load(p, __ATOMIC_RELAXED, __HIP_MEMORY_SCOPE_AGENT); }
__device__ __forceinline__ unsigned xb_add(unsigned* p, unsigned v) { return __hip_atomic_fetch_add(p, v, __ATOMIC_RELAXED, __HIP_MEMORY_SCOPE_AGENT); }
__device__ __forceinline__ unsigned xb_xcc_id() { return (unsigned)__builtin_amdgcn_s_getreg((3 << 11) | 20) & 0xFu; }
#define XB_SPIN(cond, bar) do { unsigned _sp = 0; while (cond) { __builtin_amdgcn_s_sleep(1); \
    if ((++_sp & 255u) == 0u) { if (xb_ld(&(bar)[XB_TMO])) break; if (_sp > XB_SPIN_CAP) { atomicAdd(&(bar)[XB_TMO], 1u); break; } } } } while (0)
struct XcdBarrier { unsigned* bar; unsigned x; volatile LAS unsigned* st; };
__device__ __forceinline__ XcdBarrier xcd_barrier_post(unsigned* bar, volatile LAS unsigned* st, bool is_t0) {
    XcdBarrier b; b.bar = bar; b.x = xb_xcc_id(); b.st = st;
    if (is_t0) (void)xb_add(&bar[XB_XCNT(b.x)], 1u);
    return b;
}
__device__ __forceinline__ void xcd_barrier_complete(unsigned* bar, unsigned x, unsigned& nloc, unsigned& nx) {
    const unsigned G = gridDim.x * gridDim.y * gridDim.z;
    unsigned sum, cnt, mine, sp = 0u;
    for (;;) {
        sum = 0u; cnt = 0u; mine = 0u;
#pragma unroll
        for (unsigned j = 0; j < 16; ++j) { const unsigned c = xb_ld(&bar[XB_XCNT(j)]); sum += c; cnt += (c > 0u) ? 1u : 0u; mine = (j == x) ? c : mine; }
        if (sum == G) break;
        __builtin_amdgcn_s_sleep(1);
        if ((++sp & 255u) == 0u) { if (xb_ld(&bar[XB_TMO])) break; if (sp > XB_SPIN_CAP) { atomicAdd(&bar[XB_TMO], 1u); break; } }
    }
    nloc = mine > 0u ? mine : 1u; nx = cnt > 0u ? cnt : 1u;
}
__device__ __forceinline__ void xcd_barrier(const XcdBarrier& b, bool is_t0) {
    asm volatile("s_waitcnt vmcnt(0)" ::: "memory");
    __syncthreads();
    if (is_t0) {
        unsigned* bar = b.bar;
        __builtin_amdgcn_s_waitcnt(0);
        unsigned nloc = b.st[0], nx = b.st[1];
        if (nloc == 0u) { xcd_barrier_complete(bar, b.x, nloc, nx); b.st[0] = nloc; b.st[1] = nx; }
        const unsigned old = xb_add(&bar[XB_XSUB(b.x)], 1u);
        const unsigned gen = old / nloc;
        if (old + 1u == (gen + 1u) * nloc) {
            __builtin_amdgcn_fence(__ATOMIC_RELEASE, "agent");
            asm volatile("s_waitcnt vmcnt(0)" ::: "memory");
            const unsigned og = xb_add(&bar[XB_TOP], 1u);
            const unsigned tg = og / nx;
            if (og + 1u == (tg + 1u) * nx) xb_add(&bar[XB_TOPGEN], 1u);
            else XB_SPIN(xb_ld(&bar[XB_TOPGEN]) == tg, bar);
            __builtin_amdgcn_fence(__ATOMIC_ACQUIRE, "agent");
            xb_add(&bar[XB_XGEN(b.x)], 1u);
            asm volatile("s_waitcnt vmcnt(0)" ::: "memory");
        } else {
            XB_SPIN(xb_ld(&bar[XB_XGEN(b.x)]) == gen, bar);
            __builtin_amdgcn_fence(__ATOMIC_ACQUIRE, "agent");
            asm volatile("s_waitcnt vmcnt(0)" ::: "memory");
        }
    }
    __syncthreads();
}

struct Args {
    const float* x_prompt; const float* x_sample; const float* w_in_ab; const float* lb_logits; const float* hgrn_norm_g; const float* attn_sink; const float* w_out_ab;
    const float* w_in_c; const float* c_ln_g; const float* c_ln_b; const float* c_ws; const float* c_bs; const float* w_out_c;
    const float* w_gate; const float* w_up; const float* w_down; const float* ln_mix_g; const float* ln_mix_b; const float* ln_ffn_g; const float* ln_ffn_b;
    float* out; unsigned char* ws;
};

__device__ __forceinline__ float wave_sum(float v) {
#pragma unroll
    for (int o = 1; o < 64; o <<= 1) v += __shfl_xor(v, o);
    return v;
}

__device__ __forceinline__ int rowmap(int n, int mode) { return mode == 0 ? n : (256 * (n >> 7) + (n & 127) + (mode == 2 ? 128 : 0)); }
__device__ __forceinline__ void p0_transpose_item(const float* W, int K, int N, bf16* WT, int mode, const float* scale, LAS float* scr, int item, int lane, bool f16 = false, const float* bvec = nullptr, float* pg = nullptr, float* pb = nullptr) {
    const int nblk = N / 64, kb = item / nblk, nb = item % nblk, k0 = 64 * kb, n0 = 64 * nb;
    float sg = 0.f, sb = 0.f;
    const float scv = scale ? scale[k0 + lane] : 1.0f, bvv = bvec ? bvec[k0 + lane] : 0.0f;
    float wv[64];
#pragma unroll
    for (int kk = 0; kk < 64; ++kk) wv[kk] = W[(size_t)(k0 + kk) * N + n0 + lane];
    __builtin_amdgcn_sched_barrier(0);
#pragma unroll
    for (int kk = 0; kk < 64; ++kk) { const float sc = __builtin_bit_cast(float, __builtin_amdgcn_readlane(__builtin_bit_cast(int, scv), kk)); const float w = wv[kk]; scr[kk * 65 + lane] = w * sc;
        if (pg) { sg += w * sc; sb += w * __builtin_bit_cast(float, __builtin_amdgcn_readlane(__builtin_bit_cast(int, bvv), kk)); } }
    if (pg) { const size_t o = (size_t)kb * FOLD_N + rowmap(n0 + lane, mode); pg[o] = sg; pb[o] = sb; }
    LDS_WAIT(); asm volatile("" ::: "memory");
    const int c = lane & 7;
#pragma unroll
    for (int j = 0; j < 8; ++j) { const int n = (lane >> 3) + 8 * j; const LAS float* s = scr + (8 * c) * 65 + n;
        v4u o; if (f16) { o.x = pk2h(s[0 * 65], s[1 * 65]); o.y = pk2h(s[2 * 65], s[3 * 65]); o.z = pk2h(s[4 * 65], s[5 * 65]); o.w = pk2h(s[6 * 65], s[7 * 65]); }
        else { o.x = pk2(s[0 * 65], s[1 * 65]); o.y = pk2(s[2 * 65], s[3 * 65]); o.z = pk2(s[4 * 65], s[5 * 65]); o.w = pk2(s[6 * 65], s[7 * 65]); }
        *(GAS v4u*)(WT + (size_t)rowmap(n0 + n, mode) * K + k0 + 8 * c) = o; }
    LDS_WAIT(); asm volatile("" ::: "memory");
}
__device__ __forceinline__ void p0_fold_item(const float* W, int N, const float* g, const float* b, float* gW, float* bW, int mode, int item, int lane) {
    const int n = item * 64 + lane; float sg = 0.f, sb = 0.f;
#pragma unroll 32
    for (int k = 0; k < 1024; ++k) { const float w = W[(size_t)k * N + n]; sg += g[k] * w; sb += b[k] * w; }
    gW[rowmap(n, mode)] = sg; bW[rowmap(n, mode)] = sb;
}

__device__ __forceinline__ void naive_hgrn_unit(const Args& a, int unit, int j, LAS unsigned char* lds, int wave_s) {
    const bf16* Z = (const bf16*)(a.ws + WS_Z); bf16* OP = (bf16*)a.out; const float* lbv = (const float*)(a.ws + WS_SMALL) + SM_LB + (size_t)j * 1024;
    int tid_ = tid_from_wave(wave_s); asm volatile("" : "+v"(tid_)); const int tid = tid_, grp = tid >> 7, e = tid & 127;
    int seq, h, dir;
    if (unit < 64) { const int ch = unit * 4 + grp; seq = ch >> 3; h = (ch >> 1) & 3; dir = ch & 1; } else { const int ch = (unit - 64) * 4 + grp; seq = 32; h = ch >> 1; dir = ch & 1; }
    const int t0 = seq < 32 ? seq * 2048 : MP, len = seq < 32 ? 2048 : MS;
    const float lb = lbv[dir * 512 + h * 128 + e], oml = 1.0f - lb;
    LAS float* sq = (LAS float*)lds + grp * (3 * 16 * 128); LAS float* sf = sq + 16 * 128; LAS float* sk = sf + 16 * 128;
    float S[128];
#pragma unroll
    for (int i = 0; i < 128; ++i) S[i] = 0.f;
    for (int tb = 0; tb < len; tb += 16) {
        float v[16];
#pragma unroll
        for (int i = 0; i < 16; ++i) { const int tok = dir == 0 ? t0 + tb + i : t0 + len - 1 - tb - i; const bf16* zr = Z + (size_t)tok * NZ + h * 128 + e;
            const float qr = bf2f(zr[ZQ]), fr = bf2f(zr[dir == 0 ? ZFF : ZFB]); v[i] = bf2f(zr[ZI]);
            const float sg = 1.0f / (1.0f + expf(-fr));
            sq[i * 128 + e] = qr / (1.0f + expf(-qr)); sf[i * 128 + e] = lb + oml * sg; sk[i * 128 + e] = oml * (1.0f - sg); }
        __syncthreads();
        for (int i = 0; i < 16; ++i) { const int tok = dir == 0 ? t0 + tb + i : t0 + len - 1 - tb - i; float o = 0.f; const float vi = v[0];
#pragma unroll
            for (int d4 = 0; d4 < 32; ++d4) { const f32x4 q4 = *(const LAS f32x4*)(sq + i * 128 + d4 * 4), f4 = *(const LAS f32x4*)(sf + i * 128 + d4 * 4), k4 = *(const LAS f32x4*)(sk + i * 128 + d4 * 4);
#pragma unroll
                for (int jj = 0; jj < 4; ++jj) { S[d4 * 4 + jj] = f4[jj] * S[d4 * 4 + jj] + k4[jj] * vi; o += q4[jj] * S[d4 * 4 + jj]; } }
            OP[((size_t)dir * M + tok) * 512 + h * 128 + e] = (bf16)f2bf(o);
#pragma unroll
            for (int s = 0; s < 15; ++s) v[s] = v[s + 1]; }
        __syncthreads();
    }
}
__device__ __forceinline__ void naive_hgrn_finish(const Args& a, int j, int vcu, int ngw, int wave_s) {
    int tid_ = tid_from_wave(wave_s); asm volatile("" : "+v"(tid_)); const int lane = tid_ & 63, gw = vcu * NWAVES + __builtin_amdgcn_readfirstlane(tid_ >> 6);
    const bf16* Z = (const bf16*)(a.ws + WS_Z); const bf16* OP = (const bf16*)a.out; bf16* OB = (bf16*)(a.ws + WS_OB); const float* ng = a.hgrn_norm_g + j * 128;
    for (int it = gw; it < M * 4; it += ngw) { const int tok = it >> 2, h = it & 3; const size_t o0 = (size_t)tok * 512 + h * 128 + 2 * lane;
        const unsigned w0 = *(const unsigned*)(OP + o0), w1 = *(const unsigned*)(OP + (size_t)M * 512 + o0);
        const float x0 = bflo(w0) + bflo(w1), x1 = bfhi(w0) + bfhi(w1);
        const float ss = wave_sum(x0 * x0 + x1 * x1); const float r = 1.0f / sqrtf(ss * (1.0f / 128.0f) + RMS_EPS);
        const unsigned gw2 = *(const unsigned*)(Z + (size_t)tok * NZ + ZG + h * 128 + 2 * lane); const float g0 = bflo(gw2), g1 = bfhi(gw2);
        const float y0 = x0 * r * ng[2 * lane] * (g0 / (1.0f + expf(-g0))), y1 = x1 * r * ng[2 * lane + 1] * (g1 / (1.0f + expf(-g1)));
        *(unsigned*)(OB + (size_t)tok * 1024 + h * 128 + 2 * lane) = pk2(y0, y1); }
}
__device__ __forceinline__ void naive_attn_unit(const Args& a, int unit, int j, int wave_s) {
    const bf16* Z = (const bf16*)(a.ws + WS_Z); bf16* OB = (bf16*)(a.ws + WS_OB);
    int tid_ = tid_from_wave(wave_s); asm volatile("" : "+v"(tid_)); const int tid = tid_, hq = tid & 7, t = unit * 64 + (tid >> 3), kvh = hq >> 2;
    const float slope = exp2f(-(float)(hq + 1)), sink = a.attn_sink[j * 8 + hq];
    float q[64], o[64];
    { const v4u* qp = (const v4u*)(Z + (size_t)t * NZ + ZQB + hq * 64);
#pragma unroll
      for (int i = 0; i < 8; ++i) { const v4u w = qp[i]; q[8 * i] = bflo(w.x); q[8 * i + 1] = bfhi(w.x); q[8 * i + 2] = bflo(w.y); q[8 * i + 3] = bfhi(w.y); q[8 * i + 4] = bflo(w.z); q[8 * i + 5] = bfhi(w.z); q[8 * i + 6] = bflo(w.w); q[8 * i + 7] = bfhi(w.w); } }
#pragma unroll
    for (int i = 0; i < 64; ++i) o[i] = 0.f;
    float mx = sink, l = 1.0f;
    const int s0 = seq_start(t), s1 = seq_end(t);
    for (int dlt = -128; dlt <= 128; ++dlt) { const int s = t + dlt; if (s < s0 || s >= s1) continue;
        const v4u* kp = (const v4u*)(Z + (size_t)s * NZ + ZKB + kvh * 64); float sc = 0.f;
#pragma unroll
        for (int i = 0; i < 8; ++i) { const v4u w = kp[i]; sc += q[8 * i] * bflo(w.x) + q[8 * i + 1] * bfhi(w.x) + q[8 * i + 2] * bflo(w.y) + q[8 * i + 3] * bfhi(w.y) + q[8 * i + 4] * bflo(w.z) + q[8 * i + 5] * bfhi(w.z) + q[8 * i + 6] * bflo(w.w) + q[8 * i + 7] * bfhi(w.w); }
        sc = sc * 0.125f - slope * fabsf((float)dlt);
        const float mn = fmaxf(mx, sc), cf = expf(mx - mn), p = expf(sc - mn); l = l * cf + p; mx = mn;
        const v4u* vp = (const v4u*)(Z + (size_t)s * NZ + ZVB + kvh * 64);
#pragma unroll
        for (int i = 0; i < 8; ++i) { const v4u w = vp[i]; o[8 * i] = o[8 * i] * cf + p * bflo(w.x); o[8 * i + 1] = o[8 * i + 1] * cf + p * bfhi(w.x); o[8 * i + 2] = o[8 * i + 2] * cf + p * bflo(w.y); o[8 * i + 3] = o[8 * i + 3] * cf + p * bfhi(w.y);
            o[8 * i + 4] = o[8 * i + 4] * cf + p * bflo(w.z); o[8 * i + 5] = o[8 * i + 5] * cf + p * bfhi(w.z); o[8 * i + 6] = o[8 * i + 6] * cf + p * bflo(w.w); o[8 * i + 7] = o[8 * i + 7] * cf + p * bfhi(w.w); } }
    const float inv = 1.0f / l; v4u* op = (v4u*)(OB + (size_t)t * 1024 + 512 + hq * 64);
#pragma unroll
    for (int i = 0; i < 8; ++i) { v4u w; w.x = pk2(o[8 * i] * inv, o[8 * i + 1] * inv); w.y = pk2(o[8 * i + 2] * inv, o[8 * i + 3] * inv); w.z = pk2(o[8 * i + 4] * inv, o[8 * i + 5] * inv); w.w = pk2(o[8 * i + 6] * inv, o[8 * i + 7] * inv); op[i] = w; }
}
__device__ __forceinline__ void vrow_mu_rstd(const float* vstat, int row, float& mu, float& rstd) {
    const f32x4* p = (const f32x4*)(vstat + (size_t)row * 64); float ms = 0.f; f32x4 v[16];
#pragma unroll
    for (int i = 0; i < 16; ++i) v[i] = p[i];
    __builtin_amdgcn_sched_barrier(0);
#pragma unroll
    for (int i = 0; i < 16; ++i) ms += v[i][0] + v[i][2];
    const float mean = ms * (1.0f / 32.0f); float q = 0.f;
#pragma unroll
    for (int i = 0; i < 16; ++i) { const float d0 = v[i][0] - mean, d1 = v[i][2] - mean; q += (v[i][1] + v[i][3]) + 64.0f * (d0 * d0 + d1 * d1); }
    mu = mean; rstd = 1.0f / sqrtf(q * (1.0f / 2048.0f) + pg8::LN_EPS);
}
__device__ __forceinline__ void naive_sgu_unit(const Args& a, int unit, int j, LAS unsigned char* lds, int wave_s) {
    int tid_ = tid_from_wave(wave_s); asm volatile("" : "+v"(tid_)); const int chunk = unit >> 3, g = unit & 7, tid = tid_, ch = tid & 255, half = tid >> 8;
    bf16* U = (bf16*)(a.ws + WS_Z); const bf16* V = (const bf16*)(a.ws + WS_R1); const float* vstat = (const float*)(a.ws + WS_VSTAT);
    LAS float* vn = (LAS float*)lds; LAS float* st = vn + 128 * 256;
    const int tok0 = chunk * 128;
    __syncthreads();
    if (tid < 128) { float mu, rstd; vrow_mu_rstd(vstat, tok0 + tid, mu, rstd); st[2 * tid] = mu; st[2 * tid + 1] = rstd; }
    __syncthreads();
    const float cg = a.c_ln_g[j * 2048 + g * 256 + ch], cb = a.c_ln_b[j * 2048 + g * 256 + ch];
    for (int s = half; s < 128; s += 2) vn[s * 256 + ch] = (bf2f(V[(size_t)(tok0 + s) * 2048 + g * 256 + ch]) - st[2 * s]) * st[2 * s + 1] * cg + cb;
    __syncthreads();
    const float* Wg = a.c_ws + ((size_t)(j * 8 + g) * 128) * 128;
    for (int t = half * 64; t < half * 64 + 64; ++t) { float acc = 0.f; const float* wr = Wg + (size_t)t * 128;
#pragma unroll 8
        for (int s = 0; s < 128; ++s) acc += wr[s] * vn[s * 256 + ch];
        acc += a.c_bs[(j * 8 + g) * 128 + t];
        bf16* up = U + (size_t)(tok0 + t) * 2048 + g * 256 + ch; *up = (bf16)f2bf(bf2f(*up) * acc); }
}


typedef float f32x16 __attribute__((ext_vector_type(16)));
__device__ __forceinline__ unsigned cvtpk(float lo, float hi) { return pg8::cvt_pk_bf16(lo, hi); }
__device__ __forceinline__ float max_xor32(float x) { const unsigned xi = __builtin_bit_cast(unsigned, x); const auto r = __builtin_amdgcn_permlane32_swap(xi, xi, false, false); const unsigned a = r[0], b = r[1]; return fmaxf(__builtin_bit_cast(float, a), __builtin_bit_cast(float, b)); }
__device__ __forceinline__ float sum_xor32(float x) { const unsigned xi = __builtin_bit_cast(unsigned, x); const auto r = __builtin_amdgcn_permlane32_swap(xi, xi, false, false); const unsigned a = r[0], b = r[1]; return __builtin_bit_cast(float, a) + __builtin_bit_cast(float, b); }
__device__ __forceinline__ v4u widen_pair(v2u a, v2u b) {
    const auto r0 = __builtin_amdgcn_permlane32_swap(a.x, b.x, false, false); const auto r1 = __builtin_amdgcn_permlane32_swap(a.y, b.y, false, false);
    const unsigned ax = r0[0], bx = r0[1], ay = r1[0], by = r1[1];
    return (v4u){ax, ay, bx, by};
}

__device__ __forceinline__ void sgu_unit(const Args& a, int unit, int j, LAS unsigned char* lds, int wave_s) {
    int tid_ = tid_from_wave(wave_s); asm volatile("" : "+v"(tid_)); const int tid = tid_, lane = tid & 63, wave = __builtin_amdgcn_readfirstlane(tid >> 6), l31 = lane & 31, h = lane >> 5;
    const int chunk = unit >> 3, g = unit & 7, tok0 = chunk * 128;
    bf16* U = (bf16*)(a.ws + WS_Z); const bf16* V = (const bf16*)(a.ws + WS_R1); const float* vstat = (const float*)(a.ws + WS_VSTAT);
    const bf16* Wsb = (const bf16*)(a.ws + WS_WSB) + (size_t)(j * 8 + g) * 128 * 128;
    const float* rsw = (const float*)(a.ws + WS_SMALL) + SM_RSW + (j * 8 + g) * 128; const float* bs = a.c_bs + (j * 8 + g) * 128;
    LAS float* st = (LAS float*)(lds + 65536);
    __syncthreads();
    if (tid < 128) { float mu, rstd; vrow_mu_rstd(vstat, tok0 + tid, mu, rstd); st[2 * tid] = mu; st[2 * tid + 1] = rstd; }
    __syncthreads();
#pragma unroll
    for (int it = 0; it < 8; ++it) { const int p = tid & 7, sl = (it >> 2) * 64 + (tid >> 3), c0 = (it & 3) * 64 + 8 * p;
        const v4u w = *(const v4u*)(V + (size_t)(tok0 + sl) * 2048 + g * 256 + c0); const float mu = st[2 * sl], rstd = st[2 * sl + 1];
        const unsigned ww[4] = {w.x, w.y, w.z, w.w};
#pragma unroll
        for (int i = 0; i < 8; ++i) { const int c = c0 + i; const float x = (i & 1) ? bfhi(ww[i >> 1]) : bflo(ww[i >> 1]);
            const unsigned short ob = (unsigned short)f2bf((x - mu) * rstd);
            *(LAS unsigned short*)(lds + c * 256 + ((((sl >> 3) ^ ((c ^ (c >> 3)) & 15))) << 4) + (sl & 7) * 2) = ob; } }
    __syncthreads();
    const int tt = wave & 3, cq = wave >> 2, t = 32 * tt + l31;
    bf16x8 bw[8];
#pragma unroll
    for (int kk = 0; kk < 8; ++kk) bw[kk] = *(const bf16x8*)(Wsb + (size_t)t * 128 + 16 * kk + 8 * h);
    f32x16 acc[4];
#pragma unroll
    for (int i = 0; i < 4; ++i) { acc[i] = (f32x16){0.f, 0.f, 0.f, 0.f, 0.f, 0.f, 0.f, 0.f, 0.f, 0.f, 0.f, 0.f, 0.f, 0.f, 0.f, 0.f};
        const int c = 32 * (4 * cq + i) + l31, sw = (c ^ (c >> 3)) & 15;
#pragma unroll
        for (int kk = 0; kk < 8; ++kk) { const bf16x8 af = *(const LAS bf16x8*)(lds + c * 256 + (((2 * kk + h) ^ sw) << 4));
            acc[i] = __builtin_amdgcn_mfma_f32_32x32x16_bf16(af, bw[kk], acc[i], 0, 0, 0); } }
    const float rswt = rsw[t], bst = bs[t];
    bf16* urow = U + (size_t)(tok0 + t) * 2048 + g * 256; const float* cgp = a.c_ln_g + j * 2048 + g * 256; const float* cbp = a.c_ln_b + j * 2048 + g * 256;
#pragma unroll
    for (int i = 0; i < 4; ++i)
#pragma unroll
        for (int qd = 0; qd < 4; ++qd) { const int c = 32 * (4 * cq + i) + 8 * qd + 4 * h;
            const v2u uw = *(const v2u*)(urow + c); const f32x4 cg4 = *(const f32x4*)(cgp + c), cb4 = *(const f32x4*)(cbp + c);
            const float o0 = bflo(uw.x) * (cg4[0] * acc[i][4 * qd + 0] + cb4[0] * rswt + bst), o1 = bfhi(uw.x) * (cg4[1] * acc[i][4 * qd + 1] + cb4[1] * rswt + bst);
            const float o2 = bflo(uw.y) * (cg4[2] * acc[i][4 * qd + 2] + cb4[2] * rswt + bst), o3 = bfhi(uw.y) * (cg4[3] * acc[i][4 * qd + 3] + cb4[3] * rswt + bst);
            v2u ow; ow.x = cvtpk(o0, o1); ow.y = cvtpk(o2, o3); *(v2u*)(urow + c) = ow; }
}

__device__ __forceinline__ void sgu_unit2(const Args& a, int unit, int j, LAS unsigned char* lds, int wave_s) {
    int tid_ = tid_from_wave(wave_s); asm volatile("" : "+v"(tid_)); const int tid = tid_, lane = tid & 63, wave = __builtin_amdgcn_readfirstlane(tid >> 6), l31 = lane & 31, h = lane >> 5;
    const int chunk = unit >> 1, g0 = (unit & 1) * 4, tok0 = chunk * 128;
    bf16* U = (bf16*)(a.ws + WS_Z); const bf16* V = (const bf16*)(a.ws + WS_R1); const float* vstat = (const float*)(a.ws + WS_VSTAT);
    LAS float* st = (LAS float*)(lds + 131072);
    __syncthreads();
    if (tid < 128) { float mu, rstd; vrow_mu_rstd(vstat, tok0 + tid, mu, rstd); st[2 * tid] = mu; st[2 * tid + 1] = rstd; }
    const int tt = wave & 3, cq = wave >> 2, t = 32 * tt + l31;
    v4u vreg[8];
#pragma unroll
    for (int it = 0; it < 8; ++it) { const int sl = (it >> 2) * 64 + (tid >> 3), c0 = (it & 3) * 64 + 8 * (tid & 7); vreg[it] = *(const v4u*)(V + (size_t)(tok0 + sl) * 2048 + g0 * 256 + c0); }
    __syncthreads();
    for (int k = 0; k < 4; ++k) {
        const int g = g0 + k; LAS unsigned char* buf = lds + (k & 1) * 65536;
        const float* cgp = a.c_ln_g + j * 2048 + g * 256; const float* cbp = a.c_ln_b + j * 2048 + g * 256;
        int tk = tid; asm volatile("" : "+v"(tk)); const int p = tk & 7;
#pragma unroll
        for (int it = 0; it < 8; ++it) { const int sl = (it >> 2) * 64 + (tk >> 3), c0 = (it & 3) * 64 + 8 * p; const float mu = st[2 * sl], rstd = st[2 * sl + 1];
            const f32x4 ga = *(const f32x4*)(cgp + c0), gb = *(const f32x4*)(cgp + c0 + 4); const float gg[8] = {ga[0], ga[1], ga[2], ga[3], gb[0], gb[1], gb[2], gb[3]};
            const unsigned ww[4] = {vreg[it].x, vreg[it].y, vreg[it].z, vreg[it].w};
#pragma unroll
            for (int i = 0; i < 8; ++i) { const int c = c0 + i; const float x = (i & 1) ? bfhi(ww[i >> 1]) : bflo(ww[i >> 1]);
                *(LAS unsigned short*)(buf + c * 256 + ((((sl >> 3) ^ ((c ^ (c >> 3)) & 15))) << 4) + (sl & 7) * 2) = (unsigned short)f2bf((x - mu) * rstd * gg[i]); } }
        __syncthreads();
        const bf16* Wsb = (const bf16*)(a.ws + WS_WSB) + (size_t)(j * 8 + g) * 128 * 128;
        bf16x8 bw[8];
#pragma unroll
        for (int kk = 0; kk < 8; ++kk) bw[kk] = *(const bf16x8*)(Wsb + (size_t)t * 128 + 16 * kk + 8 * h);
        f32x16 acc[4];
#pragma unroll
        for (int i = 0; i < 4; ++i) { acc[i] = (f32x16){0.f, 0.f, 0.f, 0.f, 0.f, 0.f, 0.f, 0.f, 0.f, 0.f, 0.f, 0.f, 0.f, 0.f, 0.f, 0.f};
            const int c = 32 * (4 * cq + i) + l31, sw = (c ^ (c >> 3)) & 15;
#pragma unroll
            for (int kk = 0; kk < 8; ++kk) { const bf16x8 af = *(const LAS bf16x8*)(buf + c * 256 + (((2 * kk + h) ^ sw) << 4));
                acc[i] = __builtin_amdgcn_mfma_f32_32x32x16_bf16(af, bw[kk], acc[i], 0, 0, 0); } }
        if (k < 3) {
#pragma unroll
            for (int it = 0; it < 8; ++it) { const int sl = (it >> 2) * 64 + (tk >> 3), c0 = (it & 3) * 64 + 8 * p; vreg[it] = *(const v4u*)(V + (size_t)(tok0 + sl) * 2048 + (g + 1) * 256 + c0); } }
        const float rswt = ((const float*)(a.ws + WS_SMALL))[SM_RSW + (j * 8 + g) * 128 + t], bst = a.c_bs[(j * 8 + g) * 128 + t];
        bf16* urow = U + (size_t)(tok0 + t) * 2048 + g * 256;
#pragma unroll
        for (int i = 0; i < 4; ++i)
#pragma unroll
            for (int qd = 0; qd < 4; ++qd) { const int c = 32 * (4 * cq + i) + 8 * qd + 4 * h;
                const v2u uw = *(const v2u*)(urow + c); const f32x4 cb4 = *(const f32x4*)(cbp + c);
                const float o0 = bflo(uw.x) * (acc[i][4 * qd + 0] + cb4[0] * rswt + bst), o1 = bfhi(uw.x) * (acc[i][4 * qd + 1] + cb4[1] * rswt + bst);
                const float o2 = bflo(uw.y) * (acc[i][4 * qd + 2] + cb4[2] * rswt + bst), o3 = bfhi(uw.y) * (acc[i][4 * qd + 3] + cb4[3] * rswt + bst);
                v2u ow; ow.x = cvtpk(o0, o1); ow.y = cvtpk(o2, o3); *(v2u*)(urow + c) = ow; }
    }
}

typedef short s16x4 __attribute__((ext_vector_type(4)));
__device__ __forceinline__ unsigned sgu_off_b(unsigned row, unsigned ch) { return 256u * row + 16u * (ch ^ (((row & 3) << 2) | ((row >> 2) & 3))); }
__device__ __forceinline__ s16x4 sgu_tr(const LAS unsigned char* p) { return __builtin_amdgcn_ds_read_tr16_b64_v4i16((LAS s16x4*)p); }
__device__ __forceinline__ void sgu_unit3(const Args& a, int unit, int j, LAS unsigned char* lds, int wave_s) {
    int tid_ = tid_from_wave(wave_s); asm volatile("" : "+v"(tid_)); const int tid = tid_, lane = tid & 63, wave = __builtin_amdgcn_readfirstlane(tid >> 6), l31 = lane & 31, h = lane >> 5;
    const int chunk = unit >> 1, g0 = (unit & 1) * 4, tok0 = chunk * 128;
    bf16* U = (bf16*)(a.ws + WS_Z); const bf16* V = (const bf16*)(a.ws + WS_R1); const float* vstat = (const float*)(a.ws + WS_VSTAT);
    LAS float* st = (LAS float*)(lds + 131072);
    __syncthreads();
    if (tid < 128) { float mu, rstd; vrow_mu_rstd(vstat, tok0 + tid, mu, rstd); st[2 * tid] = mu; st[2 * tid + 1] = rstd; }
    const int tt = wave & 3, cq = wave >> 2, t = 32 * tt + l31;
    v4u vreg[8];
#pragma unroll
    for (int it = 0; it < 8; ++it) { const int sl = (it >> 2) * 64 + (tid >> 3), c0 = (it & 3) * 64 + 8 * (tid & 7); vreg[it] = *(const v4u*)(V + (size_t)(tok0 + sl) * 2048 + g0 * 256 + c0); }
    __syncthreads();
    for (int k = 0; k < 4; ++k) {
        const int g = g0 + k; LAS unsigned char* buf = lds + (k & 1) * 65536;
        const float* cgp = a.c_ln_g + j * 2048 + g * 256; const float* cbp = a.c_ln_b + j * 2048 + g * 256;
        int tk = tid; asm volatile("" : "+v"(tk)); const int p = tk & 7;
#pragma unroll
        for (int it = 0; it < 8; ++it) { const int sl = (it >> 2) * 64 + (tk >> 3), c0 = (it & 3) * 64 + 8 * p; const float mu = st[2 * sl], rstd = st[2 * sl + 1];
            const f32x4 ga = *(const f32x4*)(cgp + c0), gb = *(const f32x4*)(cgp + c0 + 4);
            const unsigned w0 = vreg[it].x, w1 = vreg[it].y, w2 = vreg[it].z, w3 = vreg[it].w;
            v4u o; o.x = cvtpk((bflo(w0) - mu) * rstd * ga[0], (bfhi(w0) - mu) * rstd * ga[1]); o.y = cvtpk((bflo(w1) - mu) * rstd * ga[2], (bfhi(w1) - mu) * rstd * ga[3]);
            o.z = cvtpk((bflo(w2) - mu) * rstd * gb[0], (bfhi(w2) - mu) * rstd * gb[1]); o.w = cvtpk((bflo(w3) - mu) * rstd * gb[2], (bfhi(w3) - mu) * rstd * gb[3]);
            *(LAS v4u*)(buf + ((it & 3) >> 1) * 32768 + sgu_off_b((unsigned)sl, (unsigned)((it & 1) * 8 + p))) = o; }
        __syncthreads();
        const bf16* Wsb = (const bf16*)(a.ws + WS_WSB) + (size_t)(j * 8 + g) * 128 * 128;
        bf16x8 bw[8];
#pragma unroll
        for (int kk = 0; kk < 8; ++kk) bw[kk] = *(const bf16x8*)(Wsb + (size_t)t * 128 + 16 * kk + 8 * h);
        f32x16 acc[4];
#pragma unroll
        for (int i = 0; i < 4; ++i) { acc[i] = (f32x16){0.f, 0.f, 0.f, 0.f, 0.f, 0.f, 0.f, 0.f, 0.f, 0.f, 0.f, 0.f, 0.f, 0.f, 0.f, 0.f};
            const int ct = 4 * cq + i; const unsigned lq = (unsigned)(lane & 15) >> 2, lp = (unsigned)lane & 3, lblk = ((unsigned)lane >> 4) & 1;
            const LAS unsigned char* ib = buf + (ct >> 2) * 32768;
            const unsigned a0 = sgu_off_b(8u * h + lq, 4u * (ct & 3) + 2u * lblk + (lp >> 1)) + 8u * (lp & 1), a1 = sgu_off_b(8u * h + 4u + lq, 4u * (ct & 3) + 2u * lblk + (lp >> 1)) + 8u * (lp & 1);
#pragma unroll
            for (int kk = 0; kk < 8; ++kk) { const s16x4 lo = sgu_tr(ib + a0 + kk * 4096), hi = sgu_tr(ib + a1 + kk * 4096);
                const bf16x8 af = __builtin_shufflevector(lo, hi, 0, 1, 2, 3, 4, 5, 6, 7);
                acc[i] = __builtin_amdgcn_mfma_f32_32x32x16_bf16(af, bw[kk], acc[i], 0, 0, 0); } }
        if (k < 3) {
#pragma unroll
            for (int it = 0; it < 8; ++it) { const int sl = (it >> 2) * 64 + (tk >> 3), c0 = (it & 3) * 64 + 8 * p; vreg[it] = *(const v4u*)(V + (size_t)(tok0 + sl) * 2048 + (g + 1) * 256 + c0); } }
        const float rswt = ((const float*)(a.ws + WS_SMALL))[SM_RSW + (j * 8 + g) * 128 + t], bst = a.c_bs[(j * 8 + g) * 128 + t];
        bf16* urow = U + (size_t)(tok0 + t) * 2048 + g * 256;
#pragma unroll
        for (int i = 0; i < 4; ++i)
#pragma unroll
            for (int qd = 0; qd < 4; ++qd) { const int c = 32 * (4 * cq + i) + 8 * qd + 4 * h;
                const v2u uw = *(const v2u*)(urow + c); const f32x4 cb4 = *(const f32x4*)(cbp + c);
                const float o0 = bflo(uw.x) * (acc[i][4 * qd + 0] + cb4[0] * rswt + bst), o1 = bfhi(uw.x) * (acc[i][4 * qd + 1] + cb4[1] * rswt + bst);
                const float o2 = bflo(uw.y) * (acc[i][4 * qd + 2] + cb4[2] * rswt + bst), o3 = bfhi(uw.y) * (acc[i][4 * qd + 3] + cb4[3] * rswt + bst);
                v2u ow; ow.x = cvtpk(o0, o1); ow.y = cvtpk(o2, o3); *(v2u*)(urow + c) = ow; }
    }
}

__device__ __forceinline__ void sgu_unit4(const Args& a, int unit, int j, LAS unsigned char* lds, int wave_s) {
    int tid_ = tid_from_wave(wave_s); asm volatile("" : "+v"(tid_)); const int tid = tid_, lane = tid & 63, wave = __builtin_amdgcn_readfirstlane(tid >> 6), l31 = lane & 31, h = lane >> 5;
    const int chunk = unit >> 1, g0 = (unit & 1) * 4, tok0 = chunk * 128;
    bf16* U = (bf16*)(a.ws + WS_Z); const bf16* V = (const bf16*)(a.ws + WS_R1); const float* vstat = (const float*)(a.ws + WS_VSTAT);
    LAS float* st = (LAS float*)(lds + 131072);
    __syncthreads();
    const int tt = wave & 3, cq = wave >> 2, t = 32 * tt + l31;
    v4u vreg[8];
#pragma unroll
    for (int it = 0; it < 8; ++it) { const int sl = (it >> 2) * 64 + (tid >> 3), c0 = (it & 3) * 64 + 8 * (tid & 7); vreg[it] = *(const v4u*)(V + (size_t)(tok0 + sl) * 2048 + g0 * 256 + c0); }
#define cgL ((LAS float*)(lds + 132096))
#define cbL ((LAS float*)(lds + 136192))
#define rsL ((LAS float*)(lds + 140288))
#define bsL ((LAS float*)(lds + 142336))
    if (tid < 128) { float mu, rstd; vrow_mu_rstd(vstat, tok0 + tid, mu, rstd); st[2 * tid] = mu; st[2 * tid + 1] = rstd; }
    { const float c0v = a.c_ln_g[j * 2048 + g0 * 256 + tid], c1v = a.c_ln_g[j * 2048 + g0 * 256 + 512 + tid], b0v = a.c_ln_b[j * 2048 + g0 * 256 + tid], b1v = a.c_ln_b[j * 2048 + g0 * 256 + 512 + tid];
      const float rv = ((const float*)(a.ws + WS_SMALL))[SM_RSW + (j * 8 + g0) * 128 + tid], sv = a.c_bs[(j * 8 + g0) * 128 + tid];
      cgL[tid] = c0v; cgL[512 + tid] = c1v; cbL[tid] = b0v; cbL[512 + tid] = b1v; rsL[tid] = rv; bsL[tid] = sv; }
    __syncthreads();
    for (int k = 0; k < 4; ++k) {
        const int g = g0 + k; LAS unsigned char* buf = lds + (k & 1) * 65536;
        bf16* ubase = U + (size_t)(tok0 + 32 * tt + 4 * h) * 2048 + g * 256 + 128 * cq + 2 * l31;
        unsigned uwv[16][2];
#pragma unroll
        for (int r = 0; r < 16; ++r)
#pragma unroll
            for (int u = 0; u < 2; ++u) uwv[r][u] = *(const unsigned*)(ubase + (size_t)(8 * (r >> 2) + (r & 3)) * 2048 + 64 * u);
        int tk = tid; asm volatile("" : "+v"(tk)); const int p = tk & 7;
#pragma unroll
        for (int it = 0; it < 8; ++it) { const int sl = (it >> 2) * 64 + (tk >> 3), c0 = (it & 3) * 64 + 8 * p; const float mu = st[2 * sl], rstd = st[2 * sl + 1];
            const f32x4 ga = *(const LAS f32x4*)(cgL + k * 256 + c0), gb = *(const LAS f32x4*)(cgL + k * 256 + c0 + 4);
            const unsigned w0 = vreg[it].x, w1 = vreg[it].y, w2 = vreg[it].z, w3 = vreg[it].w;
            const float e0 = (bflo(w0) - mu) * rstd * ga[0], e1 = (bfhi(w0) - mu) * rstd * ga[1], e2 = (bflo(w1) - mu) * rstd * ga[2], e3 = (bfhi(w1) - mu) * rstd * ga[3];
            const float e4 = (bflo(w2) - mu) * rstd * gb[0], e5 = (bfhi(w2) - mu) * rstd * gb[1], e6 = (bflo(w3) - mu) * rstd * gb[2], e7 = (bfhi(w3) - mu) * rstd * gb[3];
            v2u ev, od; ev.x = cvtpk(e0, e2); ev.y = cvtpk(e4, e6); od.x = cvtpk(e1, e3); od.y = cvtpk(e5, e7);
            LAS unsigned char* ib = buf + ((it & 3) >> 1) * 32768 + 8 * (p & 1);
            *(LAS v2u*)(ib + sgu_off_b((unsigned)sl, (unsigned)((it & 1) * 8 + (p >> 1)))) = ev; *(LAS v2u*)(ib + sgu_off_b((unsigned)sl, (unsigned)((it & 1) * 8 + 4 + (p >> 1)))) = od; }
        const bf16* Wsb = (const bf16*)(a.ws + WS_WSB) + (size_t)(j * 8 + g) * 128 * 128;
        bf16x8 bw[8];
#pragma unroll
        for (int kk = 0; kk < 8; ++kk) bw[kk] = *(const bf16x8*)(Wsb + (size_t)((tt * 8 + kk) * 64 + lane) * 8);
        if (k < 3) {
#pragma unroll
            for (int it = 0; it < 8; ++it) { const int sl = (it >> 2) * 64 + (tk >> 3), c0 = (it & 3) * 64 + 8 * p; vreg[it] = *(const v4u*)(V + (size_t)(tok0 + sl) * 2048 + (g + 1) * 256 + c0); } }
        LDS_SYNC();
        f32x16 acc[4];
#pragma unroll
        for (int i = 0; i < 4; ++i) { acc[i] = (f32x16){0.f, 0.f, 0.f, 0.f, 0.f, 0.f, 0.f, 0.f, 0.f, 0.f, 0.f, 0.f, 0.f, 0.f, 0.f, 0.f};
            const int ct = 4 * cq + i; const unsigned lq = (unsigned)(lane & 15) >> 2, lp = (unsigned)lane & 3, lblk = ((unsigned)lane >> 4) & 1;
            const LAS unsigned char* ib = buf + (ct >> 2) * 32768;
            const unsigned a0 = sgu_off_b(8u * h + lq, 4u * (ct & 3) + 2u * lblk + (lp >> 1)) + 8u * (lp & 1), a1 = sgu_off_b(8u * h + 4u + lq, 4u * (ct & 3) + 2u * lblk + (lp >> 1)) + 8u * (lp & 1);
#pragma unroll
            for (int kk = 0; kk < 8; ++kk) { const s16x4 lo = sgu_tr(ib + a0 + kk * 4096), hi = sgu_tr(ib + a1 + kk * 4096);
                const bf16x8 af = __builtin_shufflevector(lo, hi, 0, 1, 2, 3, 4, 5, 6, 7);
                acc[i] = __builtin_amdgcn_mfma_f32_32x32x16_bf16(bw[kk], af, acc[i], 0, 0, 0); } }
        const LAS float* rswp = rsL + k * 128 + 32 * tt + 4 * h; const LAS float* bsp = bsL + k * 128 + 32 * tt + 4 * h;
        pg8::f32x2 cb2[2];
#pragma unroll
        for (int u = 0; u < 2; ++u) cb2[u] = *(const LAS pg8::f32x2*)(cbL + k * 256 + 64 * (2 * cq + u) + 2 * l31);
#pragma unroll
        for (int rq = 0; rq < 4; ++rq) { const f32x4 rs4 = *(const LAS f32x4*)(rswp + 8 * rq), bs4 = *(const LAS f32x4*)(bsp + 8 * rq);
#pragma unroll
            for (int rr = 0; rr < 4; ++rr)
#pragma unroll
                for (int u = 0; u < 2; ++u) { unsigned* up = (unsigned*)(ubase + (size_t)(8 * rq + rr) * 2048 + 64 * u); const unsigned uw = uwv[4 * rq + rr][u];
                    const float o0 = bflo(uw) * (acc[2 * u][4 * rq + rr] + cb2[u].x * rs4[rr] + bs4[rr]), o1 = bfhi(uw) * (acc[2 * u + 1][4 * rq + rr] + cb2[u].y * rs4[rr] + bs4[rr]);
                    *up = cvtpk(o0, o1); } }
    }
}
#undef cgL
#undef cbL
#undef rsL
#undef bsL

constexpr int ATT_VT_OFF = 49152, ATT_VT_PITCH = 776;
__device__ __forceinline__ void attn_unit(const Args& a, int unit, int j, LAS unsigned char* lds, int wave_s) {
    int tid_ = tid_from_wave(wave_s); asm volatile("" : "+v"(tid_)); const int tid = tid_, lane = tid & 63, wave = __builtin_amdgcn_readfirstlane(tid >> 6), l31 = lane & 31, h = lane >> 5;
    const bf16* Z = (const bf16*)(a.ws + WS_Z); bf16* OB = (bf16*)(a.ws + WS_OB);
    const int blk = unit >> 1, kvh = unit & 1, t0 = blk * 128, ss = seq_start(t0), se = seq_end(t0), kbase = t0 - 128;
    __syncthreads();
    v4u kwv[6], vwv[6];
#pragma unroll
    for (int it = 0; it < 6; ++it) { const int idx = it * 512 + tid, row = idx >> 3, q = idx & 7; int sr = kbase + row; sr = sr < ss ? ss : sr; sr = sr > se - 1 ? se - 1 : sr;
        kwv[it] = *(const v4u*)(Z + (size_t)sr * NZ + ZKB + kvh * 64 + 8 * q); vwv[it] = *(const v4u*)(Z + (size_t)sr * NZ + ZVB + kvh * 64 + 8 * q); }
    bf16x8 qfa[2][4];
#pragma unroll
    for (int qi = 0; qi < 2; ++qi) { const int qt = wave * 2 + qi, hq = kvh * 4 + (qt >> 2), tq = t0 + 32 * (qt & 3) + l31;
#pragma unroll
        for (int kk = 0; kk < 4; ++kk) qfa[qi][kk] = *(const bf16x8*)(Z + (size_t)tq * NZ + ZQB + hq * 64 + 16 * kk + 8 * h); }
    __builtin_amdgcn_sched_barrier(0);
#pragma unroll
    for (int it = 0; it < 6; ++it) { const int idx = it * 512 + tid, row = idx >> 3, q = idx & 7, sx = kbase + row; const bool ok = sx >= ss && sx < se;
        const v4u zero4 = (v4u){0u, 0u, 0u, 0u}; const v4u kw = ok ? kwv[it] : zero4, vw = ok ? vwv[it] : zero4;
        *(LAS v4u*)(lds + row * 128 + ((q ^ ((row >> 1) & 7)) << 4)) = kw;
        const unsigned ww[4] = {vw.x, vw.y, vw.z, vw.w};
#pragma unroll
        for (int i = 0; i < 8; ++i) *(LAS unsigned short*)(lds + ATT_VT_OFF + (8 * q + i) * ATT_VT_PITCH + row * 2) = (unsigned short)((i & 1) ? (ww[i >> 1] >> 16) : (ww[i >> 1] & 0xffffu)); }
    __syncthreads();
    const float ninf = -__builtin_inff(); const bool edge = !(kbase >= ss && kbase + 384 <= se);
    for (int qi = 0; qi < 2; ++qi) {
        const int qt = wave * 2 + qi, g = qt >> 2, sb = qt & 3, hq = kvh * 4 + g, tq = t0 + 32 * sb + l31;
        const float slope = exp2f(-(float)(hq + 1)) * 1.4426950408889634f, sink = a.attn_sink[j * 8 + hq] * 1.4426950408889634f; constexpr float QS = 0.125f * 1.4426950408889634f;
        bf16x8 qf[4];
#pragma unroll
        for (int kk = 0; kk < 4; ++kk) qf[kk] = qi ? qfa[1][kk] : qfa[0][kk];
        float m = sink, lsum = h == 0 ? 1.0f : 0.0f;
        f32x16 o0 = (f32x16){0.f, 0.f, 0.f, 0.f, 0.f, 0.f, 0.f, 0.f, 0.f, 0.f, 0.f, 0.f, 0.f, 0.f, 0.f, 0.f}, o1 = o0;
        for (int kt = sb; kt < sb + 9; ++kt) {
            f32x16 sc = (f32x16){0.f, 0.f, 0.f, 0.f, 0.f, 0.f, 0.f, 0.f, 0.f, 0.f, 0.f, 0.f, 0.f, 0.f, 0.f, 0.f};
            const int row = 32 * kt + l31, rsw = (row >> 1) & 7;
#pragma unroll
            for (int kk = 0; kk < 4; ++kk) { const bf16x8 kf = *(const LAS bf16x8*)(lds + row * 128 + (((2 * kk + h) ^ rsw) << 4)); sc = __builtin_amdgcn_mfma_f32_32x32x16_bf16(kf, qf[kk], sc, 0, 0, 0); }
            float mx = m;
            if (edge || kt == sb || kt == sb + 8) {
#pragma unroll
                for (int r = 0; r < 16; ++r) { const int s = kbase + 32 * kt + (r & 3) + 8 * (r >> 2) + 4 * h; const int dd = tq - s, dist = dd < 0 ? -dd : dd;
                    const bool ok = dist <= 128 && s >= ss && s < se; const float v = ok ? sc[r] * QS - slope * (float)dist : ninf; sc[r] = v; mx = fmaxf(mx, v); }
            } else {
                const float fd = (float)(tq - (kbase + 32 * kt) - 4 * h);
#pragma unroll
                for (int r = 0; r < 16; ++r) { const float v = sc[r] * QS - slope * fabsf(fd - (float)((r & 3) + 8 * (r >> 2))); sc[r] = v; mx = fmaxf(mx, v); }
            }
            mx = max_xor32(mx);
            const float cf = __builtin_amdgcn_exp2f(m - mx); m = mx; lsum *= cf; o0 = o0 * cf; o1 = o1 * cf;
#pragma unroll
            for (int r = 0; r < 16; ++r) { sc[r] = __builtin_amdgcn_exp2f(sc[r] - m); lsum += sc[r]; }
            bf16x8 pf[2];
#pragma unroll
            for (int sp = 0; sp < 2; ++sp) { v4u w; w.x = cvtpk(sc[8 * sp + 0], sc[8 * sp + 1]); w.y = cvtpk(sc[8 * sp + 2], sc[8 * sp + 3]); w.z = cvtpk(sc[8 * sp + 4], sc[8 * sp + 5]); w.w = cvtpk(sc[8 * sp + 6], sc[8 * sp + 7]); pf[sp] = __builtin_bit_cast(bf16x8, w); }
#pragma unroll
            for (int sp = 0; sp < 2; ++sp) {
                const int ko = (32 * kt + 16 * sp + 4 * h) * 2;
                { const LAS unsigned char* vp = lds + ATT_VT_OFF + l31 * ATT_VT_PITCH + ko; const v2u lo = *(const LAS v2u*)vp, hi = *(const LAS v2u*)(vp + 16); const v4u w = (v4u){lo.x, lo.y, hi.x, hi.y};
                  o0 = __builtin_amdgcn_mfma_f32_32x32x16_bf16(__builtin_bit_cast(bf16x8, w), pf[sp], o0, 0, 0, 0); }
                { const LAS unsigned char* vp = lds + ATT_VT_OFF + (32 + l31) * ATT_VT_PITCH + ko; const v2u lo = *(const LAS v2u*)vp, hi = *(const LAS v2u*)(vp + 16); const v4u w = (v4u){lo.x, lo.y, hi.x, hi.y};
                  o1 = __builtin_amdgcn_mfma_f32_32x32x16_bf16(__builtin_bit_cast(bf16x8, w), pf[sp], o1, 0, 0, 0); } }
        }
        lsum = sum_xor32(lsum); const float inv = 1.0f / lsum;
        bf16* orow = OB + (size_t)tq * 1024 + 512 + hq * 64;
#pragma unroll
        for (int qp = 0; qp < 2; ++qp) { v2u a0, a1, b0, b1;
            a0.x = cvtpk(o0[8 * qp] * inv, o0[8 * qp + 1] * inv); a0.y = cvtpk(o0[8 * qp + 2] * inv, o0[8 * qp + 3] * inv); a1.x = cvtpk(o0[8 * qp + 4] * inv, o0[8 * qp + 5] * inv); a1.y = cvtpk(o0[8 * qp + 6] * inv, o0[8 * qp + 7] * inv);
            b0.x = cvtpk(o1[8 * qp] * inv, o1[8 * qp + 1] * inv); b0.y = cvtpk(o1[8 * qp + 2] * inv, o1[8 * qp + 3] * inv); b1.x = cvtpk(o1[8 * qp + 4] * inv, o1[8 * qp + 5] * inv); b1.y = cvtpk(o1[8 * qp + 6] * inv, o1[8 * qp + 7] * inv);
            *(v4u*)(orow + 16 * qp + 8 * h) = widen_pair(a0, a1); *(v4u*)(orow + 32 + 16 * qp + 8 * h) = widen_pair(b0, b1); }
    }
}


constexpr int HA_G = 0, HA_T = 32768, HA_QT = 34816, HA_KT = HA_QT + 17408, HA_QF = HA_KT + 17408, HA_KE = HA_QF + 17408, HA_VT = HA_KE + 17408, HA_ST = HA_VT + 17408, HA_END = HA_ST + 34816;
static_assert(HA_END <= MISC_OFF, "HGRN level A LDS map");
__device__ __forceinline__ void hgrn_a_unit(const Args& a, int unit, int j, LAS unsigned char* lds, int wave_s) {
    int tid_ = tid_from_wave(wave_s); asm volatile("" : "+v"(tid_)); const int tid = tid_, lane = tid & 63, wave = __builtin_amdgcn_readfirstlane(tid >> 6), l31 = lane & 31, h = lane >> 5;
    const int sc = unit >> 3, hh = (unit >> 1) & 3, dir = unit & 1, scbase = sc * 512;
    const bf16* Z = (const bf16*)(a.ws + WS_Z); bf16* OP = (bf16*)a.out + (size_t)dir * M * 512; bf16* QTg = (bf16*)(a.ws + WS_QT) + (size_t)dir * M * 512;
    float* Fo = (float*)(a.ws + WS_F) + (size_t)unit * 16384; float* Td = (float*)(a.ws + WS_SMALL) + SM_TDEC + (size_t)unit * 128;
    const float* lbv = (const float*)(a.ws + WS_SMALL) + SM_LB + (size_t)j * 1024 + dir * 512 + hh * 128;
    const int ri = tid >> 3, d0 = (tid & 7) * 16, cd = tid & 127, rg = tid >> 7, ti = wave >> 2, ej = wave & 3;
    LAS float* Gm = (LAS float*)(lds + HA_G); LAS float* Tm = (LAS float*)(lds + HA_T);
    float lb16[16], Bc[16];
#pragma unroll
    for (int e = 0; e < 16; ++e) { lb16[e] = lbv[d0 + e]; Bc[e] = 0.f; }
    const f32x16 zero16 = (f32x16){0.f, 0.f, 0.f, 0.f, 0.f, 0.f, 0.f, 0.f, 0.f, 0.f, 0.f, 0.f, 0.f, 0.f, 0.f, 0.f};
    f32x16 sacc0 = zero16, sacc1 = zero16;
    __syncthreads();
    for (int i = tid; i < 34816 / 16; i += NTHR) *(LAS v4u*)(lds + HA_ST + 16 * i) = (v4u){0u, 0u, 0u, 0u};
    __syncthreads();
    for (int cc = 0; cc < 8; ++cc) {
        const int tok = dir == 0 ? scbase + 64 * cc + ri : scbase + 511 - 64 * cc - ri;
        float q[16], kk[16]; unsigned vraw[8];
        {
            const bf16* zr = Z + (size_t)tok * NZ + hh * 128 + d0;
            const v4u qa = *(const v4u*)(zr + ZQ), qb = *(const v4u*)(zr + ZQ + 8), fa = *(const v4u*)(zr + (dir == 0 ? ZFF : ZFB)), fb = *(const v4u*)(zr + (dir == 0 ? ZFF : ZFB) + 8), va = *(const v4u*)(zr + ZI), vb = *(const v4u*)(zr + ZI + 8);
            const unsigned qw[8] = {qa.x, qa.y, qa.z, qa.w, qb.x, qb.y, qb.z, qb.w}, fw[8] = {fa.x, fa.y, fa.z, fa.w, fb.x, fb.y, fb.z, fb.w};
            vraw[0] = va.x; vraw[1] = va.y; vraw[2] = va.z; vraw[3] = va.w; vraw[4] = vb.x; vraw[5] = vb.y; vraw[6] = vb.z; vraw[7] = vb.w;
            float lf[16];
#pragma unroll
            for (int e = 0; e < 16; ++e) { const float qr = (e & 1) ? bfhi(qw[e >> 1]) : bflo(qw[e >> 1]), fr = (e & 1) ? bfhi(fw[e >> 1]) : bflo(fw[e >> 1]);
                q[e] = qr * __builtin_amdgcn_rcpf(1.0f + __expf(-qr));
                const float ea = __expf(-fabsf(fr)), rc = __builtin_amdgcn_rcpf(1.0f + ea), sg = fr >= 0.f ? rc : ea * rc;
                const float lb = lb16[e], oml = 1.0f - lb;
                kk[e] = oml * (1.0f - sg);
                lf[e] = lb == 0.f ? (fminf(fr, 0.f) - __logf(1.0f + ea)) : __logf(lb + oml * sg); }
#pragma unroll
            for (int c4 = 0; c4 < 4; ++c4) *(LAS f32x4*)(Gm + ri * 128 + d0 + 4 * c4) = (f32x4){lf[4 * c4], lf[4 * c4 + 1], lf[4 * c4 + 2], lf[4 * c4 + 3]};
        }
        __syncthreads();
        {
            float pre[16]; float run = 0.f;
#pragma unroll
            for (int k = 0; k < 16; ++k) { run += Gm[(16 * rg + k) * 128 + cd]; pre[k] = run; }
            Tm[rg * 128 + cd] = run;
            __syncthreads();
            float off = 0.f;
#pragma unroll
            for (int r2 = 0; r2 < 3; ++r2) off += (r2 < rg) ? Tm[r2 * 128 + cd] : 0.f;
#pragma unroll
            for (int k = 0; k < 16; ++k) Gm[(16 * rg + k) * 128 + cd] = pre[k] + off;
        }
        __syncthreads();
        {
            float b[16], rr[16], bl[16];
#pragma unroll
            for (int c4 = 0; c4 < 4; ++c4) { const f32x4 x = *(const LAS f32x4*)(Gm + ri * 128 + d0 + 4 * c4), y = *(const LAS f32x4*)(Gm + 31 * 128 + d0 + 4 * c4), z = *(const LAS f32x4*)(Gm + 63 * 128 + d0 + 4 * c4);
#pragma unroll
                for (int i = 0; i < 4; ++i) { b[4 * c4 + i] = x[i]; rr[4 * c4 + i] = y[i]; bl[4 * c4 + i] = z[i]; } }
            unsigned wqt[8], wkt[8], wqf[8], wqg[8]; unsigned short ke[16];
#pragma unroll
            for (int e2 = 0; e2 < 8; ++e2) { float qt2[2], kt2[2], qf2[2], qg2[2];
#pragma unroll
                for (int x = 0; x < 2; ++x) { const int e = 2 * e2 + x; const float ex = __expf(b[e] - rr[e]), er = __expf(rr[e]), elr = __expf(bl[e] - rr[e]), ebc = __expf(Bc[e]);
                    qt2[x] = q[e] * ex; kt2[x] = kk[e] * __builtin_amdgcn_rcpf(ex); qf2[x] = qt2[x] * er; qg2[x] = qf2[x] * ebc; ke[e] = (unsigned short)f2bf(kt2[x] * elr); }
                wqt[e2] = cvtpk(qt2[0], qt2[1]); wkt[e2] = cvtpk(kt2[0], kt2[1]); wqf[e2] = cvtpk(qf2[0], qf2[1]); wqg[e2] = cvtpk(qg2[0], qg2[1]); }
            *(LAS v4u*)(lds + HA_QT + ri * 272 + d0 * 2) = (v4u){wqt[0], wqt[1], wqt[2], wqt[3]}; *(LAS v4u*)(lds + HA_QT + ri * 272 + d0 * 2 + 16) = (v4u){wqt[4], wqt[5], wqt[6], wqt[7]};
            *(LAS v4u*)(lds + HA_KT + ri * 272 + d0 * 2) = (v4u){wkt[0], wkt[1], wkt[2], wkt[3]}; *(LAS v4u*)(lds + HA_KT + ri * 272 + d0 * 2 + 16) = (v4u){wkt[4], wkt[5], wkt[6], wkt[7]};
            *(LAS v4u*)(lds + HA_QF + ri * 272 + d0 * 2) = (v4u){wqf[0], wqf[1], wqf[2], wqf[3]}; *(LAS v4u*)(lds + HA_QF + ri * 272 + d0 * 2 + 16) = (v4u){wqf[4], wqf[5], wqf[6], wqf[7]};
            *(v4u*)(QTg + (size_t)tok * 512 + hh * 128 + d0) = (v4u){wqg[0], wqg[1], wqg[2], wqg[3]}; *(v4u*)(QTg + (size_t)tok * 512 + hh * 128 + d0 + 8) = (v4u){wqg[4], wqg[5], wqg[6], wqg[7]};
#pragma unroll
            for (int e = 0; e < 16; ++e) { *(LAS unsigned short*)(lds + HA_KE + (d0 + e) * 136 + ri * 2) = ke[e];
                *(LAS unsigned short*)(lds + HA_VT + (d0 + e) * 136 + ri * 2) = (unsigned short)((e & 1) ? (vraw[e >> 1] >> 16) : (vraw[e >> 1] & 0xffffu)); Bc[e] += bl[e]; }
        }
        __syncthreads();
        bf16x8 vf[2][2]; float dec0, dec1;
        {
            bf16x8 pf[2][2];
#pragma unroll
            for (int sj = 0; sj < 2; ++sj) {
                if (sj <= ti) {
                    f32x16 pt = zero16;
#pragma unroll
                    for (int k8 = 0; k8 < 8; ++k8) { const bf16x8 af = *(const LAS bf16x8*)(lds + HA_KT + (32 * sj + l31) * 272 + (16 * k8 + 8 * h) * 2), bq = *(const LAS bf16x8*)(lds + HA_QT + (32 * ti + l31) * 272 + (16 * k8 + 8 * h) * 2);
                        pt = __builtin_amdgcn_mfma_f32_32x32x16_bf16(af, bq, pt, 0, 0, 0); }
#pragma unroll
                    for (int r = 0; r < 16; ++r) { const int sl = 32 * sj + (r & 3) + 8 * (r >> 2) + 4 * h, tl = 32 * ti + l31; pt[r] = sl <= tl ? pt[r] : 0.f; }
#pragma unroll
                    for (int sp = 0; sp < 2; ++sp) { v4u w; w.x = cvtpk(pt[8 * sp + 0], pt[8 * sp + 1]); w.y = cvtpk(pt[8 * sp + 2], pt[8 * sp + 3]); w.z = cvtpk(pt[8 * sp + 4], pt[8 * sp + 5]); w.w = cvtpk(pt[8 * sp + 6], pt[8 * sp + 7]); pf[sj][sp] = __builtin_bit_cast(bf16x8, w); }
                } else { pf[sj][0] = (bf16x8){0, 0, 0, 0, 0, 0, 0, 0}; pf[sj][1] = pf[sj][0]; }
            }
            f32x16 ot = zero16;
#pragma unroll
            for (int k8 = 0; k8 < 8; ++k8) { const bf16x8 af = *(const LAS bf16x8*)(lds + HA_ST + (32 * ej + l31) * 272 + (16 * k8 + 8 * h) * 2), bq = *(const LAS bf16x8*)(lds + HA_QF + (32 * ti + l31) * 272 + (16 * k8 + 8 * h) * 2);
                ot = __builtin_amdgcn_mfma_f32_32x32x16_bf16(af, bq, ot, 0, 0, 0); }
#pragma unroll
            for (int sj = 0; sj < 2; ++sj)
#pragma unroll
                for (int sp = 0; sp < 2; ++sp) { const LAS unsigned char* vp = lds + HA_VT + (32 * ej + l31) * 136 + (32 * sj + 16 * sp + 4 * h) * 2; const v2u lo = *(const LAS v2u*)vp, hi = *(const LAS v2u*)(vp + 16);
                    vf[sj][sp] = __builtin_bit_cast(bf16x8, ((v4u){lo.x, lo.y, hi.x, hi.y})); }
#pragma unroll
            for (int sj = 0; sj < 2; ++sj)
#pragma unroll
                for (int sp = 0; sp < 2; ++sp) ot = __builtin_amdgcn_mfma_f32_32x32x16_bf16(vf[sj][sp], pf[sj][sp], ot, 0, 0, 0);
            dec0 = __expf(Gm[63 * 128 + 32 * (2 * ti) + l31]); dec1 = __expf(Gm[63 * 128 + 32 * (2 * ti + 1) + l31]);
            const int tl = 32 * ti + l31, tokc = dir == 0 ? scbase + 64 * cc + tl : scbase + 511 - 64 * cc - tl;
            bf16* orow = OP + (size_t)tokc * 512 + hh * 128 + 32 * ej + 4 * h;
#pragma unroll
            for (int qd = 0; qd < 4; ++qd) { v2u w; w.x = cvtpk(ot[4 * qd], ot[4 * qd + 1]); w.y = cvtpk(ot[4 * qd + 2], ot[4 * qd + 3]); *(v2u*)(orow + 8 * qd) = w; }
        }
        __syncthreads();
        {
            sacc0 = sacc0 * dec0; sacc1 = sacc1 * dec1;
#pragma unroll
            for (int sj = 0; sj < 2; ++sj)
#pragma unroll
                for (int sp = 0; sp < 2; ++sp) {
                    { const LAS unsigned char* kp = lds + HA_KE + (32 * (2 * ti) + l31) * 136 + (32 * sj + 16 * sp + 4 * h) * 2; const v2u lo = *(const LAS v2u*)kp, hi = *(const LAS v2u*)(kp + 16);
                      sacc0 = __builtin_amdgcn_mfma_f32_32x32x16_bf16(vf[sj][sp], __builtin_bit_cast(bf16x8, ((v4u){lo.x, lo.y, hi.x, hi.y})), sacc0, 0, 0, 0); }
                    { const LAS unsigned char* kp = lds + HA_KE + (32 * (2 * ti + 1) + l31) * 136 + (32 * sj + 16 * sp + 4 * h) * 2; const v2u lo = *(const LAS v2u*)kp, hi = *(const LAS v2u*)(kp + 16);
                      sacc1 = __builtin_amdgcn_mfma_f32_32x32x16_bf16(vf[sj][sp], __builtin_bit_cast(bf16x8, ((v4u){lo.x, lo.y, hi.x, hi.y})), sacc1, 0, 0, 0); } }
#pragma unroll
            for (int r = 0; r < 16; ++r) { const int e = 32 * ej + (r & 3) + 8 * (r >> 2) + 4 * h;
                *(LAS unsigned short*)(lds + HA_ST + e * 272 + (32 * (2 * ti) + l31) * 2) = (unsigned short)f2bf(sacc0[r]);
                *(LAS unsigned short*)(lds + HA_ST + e * 272 + (32 * (2 * ti + 1) + l31) * 2) = (unsigned short)f2bf(sacc1[r]); }
        }
    }
#pragma unroll
    for (int r = 0; r < 16; ++r) { const int e = 32 * ej + (r & 3) + 8 * (r >> 2) + 4 * h; Fo[(size_t)e * 128 + 32 * (2 * ti) + l31] = sacc0[r]; Fo[(size_t)e * 128 + 32 * (2 * ti + 1) + l31] = sacc1[r]; }
    if (ri == 0) {
#pragma unroll
        for (int e = 0; e < 16; ++e) Td[d0 + e] = __expf(Bc[e]); }
}
constexpr int HB_T = 0, HB_BL = 4096, HB_QT = 8192, HB_KT = HB_QT + 17408, HB_QF = HB_KT + 17408, HB_KE = HB_QF + 17408, HB_VT = HB_KE + 17408, HB_ST = HB_VT + 17408, HB_END = HB_ST + 34816;
static_assert(HB_END <= MISC_OFF, "HGRN level A v2 LDS map");
__device__ __forceinline__ void hgrn_a_unit2(const Args& a, int unit, int j, LAS unsigned char* lds, int wave_s) {
    int tid_ = tid_from_wave(wave_s); asm volatile("" : "+v"(tid_)); const int tid = tid_, lane = tid & 63, wave = __builtin_amdgcn_readfirstlane(tid >> 6), l31 = lane & 31, h = lane >> 5;
    const bool smp = unit >= 256; const int uv = smp ? unit - 256 : unit, hh = (uv >> 1) & 3, dir = uv & 1;
    const int scbase = smp ? MP + (uv >> 3) * 512 : (uv >> 3) * 2048, nch = smp ? 8 : 32, lastt = 64 * nch - 1;
    const int funit = smp ? (MP / 512 + (uv >> 3)) * 8 + hh * 2 + dir : 0;
    const bf16* Z = (const bf16*)(a.ws + WS_Z); bf16* OP = (bf16*)a.out + (size_t)dir * M * 512; bf16* QTg = (bf16*)(a.ws + WS_QT) + (size_t)dir * M * 512;
    float* Fo = (float*)(a.ws + WS_F) + (size_t)funit * 16384; float* Td = (float*)(a.ws + WS_SMALL) + SM_TDEC + (size_t)funit * 128;
    const float* lbv = (const float*)(a.ws + WS_SMALL) + SM_LB + (size_t)j * 1024 + dir * 512 + hh * 128;
    const int c0 = 2 * lane, rg = wave, ti = wave >> 2, ej = wave & 3, zf = dir == 0 ? ZFF : ZFB;
    LAS float* Tm = (LAS float*)(lds + HB_T); LAS float* BLm = (LAS float*)(lds + HB_BL);
    const float lb0 = lbv[c0], lb1 = lbv[c0 + 1];
    float Bc0 = 0.f, Bc1 = 0.f;
    const f32x16 zero16 = (f32x16){0.f, 0.f, 0.f, 0.f, 0.f, 0.f, 0.f, 0.f, 0.f, 0.f, 0.f, 0.f, 0.f, 0.f, 0.f, 0.f};
    f32x16 sacc0 = zero16, sacc1 = zero16;
    unsigned rq[8], rf[8], rv[8];
#pragma unroll
    for (int r = 0; r < 8; ++r) { const int tok = dir == 0 ? scbase + 8 * rg + r : scbase + lastt - 8 * rg - r; const bf16* zr = Z + (size_t)tok * NZ + hh * 128 + c0;
        rq[r] = *(const unsigned*)(zr + ZQ); rf[r] = *(const unsigned*)(zr + zf); rv[r] = *(const unsigned*)(zr + ZI); }
    __syncthreads();
    { unsigned z0 = 0u; asm volatile("" : "+v"(z0));
      for (int i = tid; i < 34816 / 16; i += NTHR) *(LAS v4u*)(lds + HB_ST + 16 * i) = (v4u){z0, z0, z0, z0}; }
    for (int cc = 0; cc < nch; ++cc) {
        float q[8][2], kk[8][2], pre[8][2]; unsigned vw[8];
        {
            float run0 = 0.f, run1 = 0.f;
#pragma unroll
            for (int r = 0; r < 8; ++r) { vw[r] = rv[r];
#pragma unroll
                for (int x = 0; x < 2; ++x) { const float qr = x ? bfhi(rq[r]) : bflo(rq[r]), fr = x ? bfhi(rf[r]) : bflo(rf[r]), lb = x ? lb1 : lb0, oml = 1.0f - lb;
                    q[r][x] = qr * __builtin_amdgcn_rcpf(1.0f + __expf(-qr));
                    const float ea = __expf(-fabsf(fr)), rc = __builtin_amdgcn_rcpf(1.0f + ea), sg = fr >= 0.f ? rc : ea * rc;
                    kk[r][x] = oml * (1.0f - sg);
                    const float lf = lb == 0.f ? (fminf(fr, 0.f) - __logf(1.0f + ea)) : __logf(lb + oml * sg);
                    if (x) { run1 += lf; pre[r][1] = run1; } else { run0 += lf; pre[r][0] = run0; } } }
            *(LAS pg8::f32x2*)(Tm + rg * 128 + c0) = (pg8::f32x2){run0, run1};
        }
        __syncthreads();
        {
            float off0 = 0.f, off1 = 0.f, r310 = 0.f, r311 = 0.f, bl0 = 0.f, bl1 = 0.f;
#pragma unroll
            for (int r2 = 0; r2 < 8; ++r2) { const pg8::f32x2 tv = *(const LAS pg8::f32x2*)(Tm + r2 * 128 + c0); if (r2 < rg) { off0 += tv[0]; off1 += tv[1]; } if (r2 < 4) { r310 += tv[0]; r311 += tv[1]; } bl0 += tv[0]; bl1 += tv[1]; }
            const float er0 = __expf(r310), er1 = __expf(r311), elr0 = __expf(bl0 - r310), elr1 = __expf(bl1 - r311), ebc0 = __expf(Bc0), ebc1 = __expf(Bc1);
            float ke[8][2];
#pragma unroll
            for (int r = 0; r < 8; ++r) { const int row = 8 * rg + r, tok = dir == 0 ? scbase + 64 * cc + row : scbase + lastt - 64 * cc - row;
                const float ex0 = __expf(pre[r][0] + off0 - r310), ex1 = __expf(pre[r][1] + off1 - r311);
                const float qt0 = q[r][0] * ex0, qt1 = q[r][1] * ex1, kt0 = kk[r][0] * __builtin_amdgcn_rcpf(ex0), kt1 = kk[r][1] * __builtin_amdgcn_rcpf(ex1);
                const float qf0 = qt0 * er0, qf1 = qt1 * er1; ke[r][0] = kt0 * elr0; ke[r][1] = kt1 * elr1;
                *(LAS unsigned*)(lds + HB_QT + row * 272 + c0 * 2) = cvtpk(qt0, qt1);
                *(LAS unsigned*)(lds + HB_KT + row * 272 + c0 * 2) = cvtpk(kt0, kt1);
                *(LAS unsigned*)(lds + HB_QF + row * 272 + c0 * 2) = cvtpk(qf0, qf1);
                if (smp) *(unsigned*)(QTg + (size_t)tok * 512 + hh * 128 + c0) = cvtpk(qf0 * ebc0, qf1 * ebc1); }
#pragma unroll
            for (int x = 0; x < 2; ++x) { LAS unsigned char* kp = lds + HB_KE + (c0 + x) * 136 + 16 * rg; LAS unsigned char* vp = lds + HB_VT + (c0 + x) * 136 + 16 * rg;
                *(LAS v2u*)kp = (v2u){cvtpk(ke[0][x], ke[1][x]), cvtpk(ke[2][x], ke[3][x])}; *(LAS v2u*)(kp + 8) = (v2u){cvtpk(ke[4][x], ke[5][x]), cvtpk(ke[6][x], ke[7][x])};
                unsigned vv[4];
#pragma unroll
                for (int r2 = 0; r2 < 4; ++r2) vv[r2] = x ? ((vw[2 * r2] >> 16) | (vw[2 * r2 + 1] & 0xffff0000u)) : ((vw[2 * r2] & 0xffffu) | (vw[2 * r2 + 1] << 16));
                *(LAS v2u*)vp = (v2u){vv[0], vv[1]}; *(LAS v2u*)(vp + 8) = (v2u){vv[2], vv[3]}; }
            if (rg == 0) *(LAS pg8::f32x2*)(BLm + c0) = (pg8::f32x2){bl0, bl1};
            Bc0 += bl0; Bc1 += bl1;
            if (cc < nch - 1) {
#pragma unroll
                for (int r = 0; r < 8; ++r) { const int row = 8 * rg + r, tok = dir == 0 ? scbase + 64 * (cc + 1) + row : scbase + lastt - 64 * (cc + 1) - row; const bf16* zr = Z + (size_t)tok * NZ + hh * 128 + c0;
                    rq[r] = *(const unsigned*)(zr + ZQ); rf[r] = *(const unsigned*)(zr + zf); rv[r] = *(const unsigned*)(zr + ZI); } }
        }
        __syncthreads();
        bf16x8 vf[2][2]; float dec0, dec1;
        {
            bf16x8 pf[2][2];
#pragma unroll
            for (int sj = 0; sj < 2; ++sj) {
                if (sj <= ti) {
                    f32x16 pt = zero16;
#pragma unroll
                    for (int k8 = 0; k8 < 8; ++k8) { const bf16x8 af = *(const LAS bf16x8*)(lds + HB_KT + (32 * sj + l31) * 272 + (16 * k8 + 8 * h) * 2), bq = *(const LAS bf16x8*)(lds + HB_QT + (32 * ti + l31) * 272 + (16 * k8 + 8 * h) * 2);
                        pt = __builtin_amdgcn_mfma_f32_32x32x16_bf16(af, bq, pt, 0, 0, 0); }
#pragma unroll
                    for (int r = 0; r < 16; ++r) { const int sl = 32 * sj + (r & 3) + 8 * (r >> 2) + 4 * h, tl = 32 * ti + l31; pt[r] = sl <= tl ? pt[r] : 0.f; }
#pragma unroll
                    for (int sp = 0; sp < 2; ++sp) { v4u w; w.x = cvtpk(pt[8 * sp + 0], pt[8 * sp + 1]); w.y = cvtpk(pt[8 * sp + 2], pt[8 * sp + 3]); w.z = cvtpk(pt[8 * sp + 4], pt[8 * sp + 5]); w.w = cvtpk(pt[8 * sp + 6], pt[8 * sp + 7]); pf[sj][sp] = __builtin_bit_cast(bf16x8, w); }
                } else { pf[sj][0] = (bf16x8){0, 0, 0, 0, 0, 0, 0, 0}; pf[sj][1] = pf[sj][0]; }
            }
            f32x16 ot = zero16;
#pragma unroll
            for (int k8 = 0; k8 < 8; ++k8) { const bf16x8 af = *(const LAS bf16x8*)(lds + HB_ST + (32 * ej + l31) * 272 + (16 * k8 + 8 * h) * 2), bq = *(const LAS bf16x8*)(lds + HB_QF + (32 * ti + l31) * 272 + (16 * k8 + 8 * h) * 2);
                ot = __builtin_amdgcn_mfma_f32_32x32x16_bf16(af, bq, ot, 0, 0, 0); }
#pragma unroll
            for (int sj = 0; sj < 2; ++sj)
#pragma unroll
                for (int sp = 0; sp < 2; ++sp) { const LAS unsigned char* vp = lds + HB_VT + (32 * ej + l31) * 136 + (32 * sj + 16 * sp + 4 * h) * 2; const v2u lo = *(const LAS v2u*)vp, hi = *(const LAS v2u*)(vp + 16);
                    vf[sj][sp] = __builtin_bit_cast(bf16x8, ((v4u){lo.x, lo.y, hi.x, hi.y})); }
#pragma unroll
            for (int sj = 0; sj < 2; ++sj)
#pragma unroll
                for (int sp = 0; sp < 2; ++sp) ot = __builtin_amdgcn_mfma_f32_32x32x16_bf16(vf[sj][sp], pf[sj][sp], ot, 0, 0, 0);
            dec0 = __expf(BLm[32 * (2 * ti) + l31]); dec1 = __expf(BLm[32 * (2 * ti + 1) + l31]);
            const int tl = 32 * ti + l31, tokc = dir == 0 ? scbase + 64 * cc + tl : scbase + lastt - 64 * cc - tl;
            bf16* orow = OP + (size_t)tokc * 512 + hh * 128 + 32 * ej + 8 * h;
#pragma unroll
            for (int qp = 0; qp < 2; ++qp) { v2u w0, w1; w0.x = cvtpk(ot[8 * qp], ot[8 * qp + 1]); w0.y = cvtpk(ot[8 * qp + 2], ot[8 * qp + 3]); w1.x = cvtpk(ot[8 * qp + 4], ot[8 * qp + 5]); w1.y = cvtpk(ot[8 * qp + 6], ot[8 * qp + 7]);
                *(v4u*)(orow + 16 * qp) = widen_pair(w0, w1); }
        }
        __syncthreads();
        {
            sacc0 = sacc0 * dec0; sacc1 = sacc1 * dec1;
#pragma unroll
            for (int sj = 0; sj < 2; ++sj)
#pragma unroll
                for (int sp = 0; sp < 2; ++sp) {
                    { const LAS unsigned char* kp = lds + HB_KE + (32 * (2 * ti) + l31) * 136 + (32 * sj + 16 * sp + 4 * h) * 2; const v2u lo = *(const LAS v2u*)kp, hi = *(const LAS v2u*)(kp + 16);
                      sacc0 = __builtin_amdgcn_mfma_f32_32x32x16_bf16(vf[sj][sp], __builtin_bit_cast(bf16x8, ((v4u){lo.x, lo.y, hi.x, hi.y})), sacc0, 0, 0, 0); }
                    { const LAS unsigned char* kp = lds + HB_KE + (32 * (2 * ti + 1) + l31) * 136 + (32 * sj + 16 * sp + 4 * h) * 2; const v2u lo = *(const LAS v2u*)kp, hi = *(const LAS v2u*)(kp + 16);
                      sacc1 = __builtin_amdgcn_mfma_f32_32x32x16_bf16(vf[sj][sp], __builtin_bit_cast(bf16x8, ((v4u){lo.x, lo.y, hi.x, hi.y})), sacc1, 0, 0, 0); } }
#pragma unroll
            for (int r = 0; r < 16; ++r) { const int e = 32 * ej + (r & 3) + 8 * (r >> 2) + 4 * h;
                *(LAS unsigned short*)(lds + HB_ST + e * 272 + (32 * (2 * ti) + l31) * 2) = (unsigned short)f2bf(sacc0[r]);
                *(LAS unsigned short*)(lds + HB_ST + e * 272 + (32 * (2 * ti + 1) + l31) * 2) = (unsigned short)f2bf(sacc1[r]); }
        }
    }
    if (smp) {
#pragma unroll
    for (int r = 0; r < 16; ++r) { const int e = 32 * ej + (r & 3) + 8 * (r >> 2) + 4 * h; Fo[(size_t)e * 128 + 32 * (2 * ti) + l31] = sacc0[r]; Fo[(size_t)e * 128 + 32 * (2 * ti + 1) + l31] = sacc1[r]; }
    if (rg == 0) *(pg8::f32x2*)(Td + c0) = (pg8::f32x2){__expf(Bc0), __expf(Bc1)}; }
}
__device__ __forceinline__ int sin_frag_off(int e4) { const int e = e4 >> 7, dk = e4 & 127; return ((((e >> 5) * 8 + (dk >> 4)) * 64) + (e & 31) + 32 * ((dk >> 3) & 1)) * 8 + (dk & 7); }
template <int NB>
__device__ __forceinline__ void hgrn_b_chain(const float* Fo, const float* Td, bf16* SIN, int sc0, int nsc, int hh, int dir, int e4, f32x4& carry) {
    const int dk = e4 & 127;
    for (int k0 = 0; k0 < nsc; k0 += NB) {
        f32x4 f[NB], t[NB];
#pragma unroll
        for (int i = 0; i < NB; ++i) { const int sc = dir == 0 ? sc0 + k0 + i : sc0 + nsc - 1 - (k0 + i); const size_t unit = (size_t)sc * 8 + hh * 2 + dir;
            f[i] = *(const f32x4*)(Fo + unit * 16384 + e4); t[i] = *(const f32x4*)(Td + unit * 128 + dk); }
#pragma unroll
        for (int i = 0; i < NB; ++i) { const int sc = dir == 0 ? sc0 + k0 + i : sc0 + nsc - 1 - (k0 + i); const size_t unit = (size_t)sc * 8 + hh * 2 + dir;
            v2u w; w.x = cvtpk(carry[0], carry[1]); w.y = cvtpk(carry[2], carry[3]); *(v2u*)(SIN + unit * 16384 + sin_frag_off(e4)) = w; carry = t[i] * carry + f[i]; }
    }
}
__device__ __forceinline__ void hgrn_b_item(const Args& a, int it, int wave_s) {
    int tid_ = tid_from_wave(wave_s); asm volatile("" : "+v"(tid_)); const int tid = tid_;
    const float* Fo = (const float*)(a.ws + WS_F); const float* Td = (const float*)(a.ws + WS_SMALL) + SM_TDEC; bf16* SIN = (bf16*)(a.ws + WS_SIN);
    f32x4 carry = (f32x4){0.f, 0.f, 0.f, 0.f};
    if (it < 256) { if (tid < 128) { const int ch = it >> 5; hgrn_b_chain<8>(Fo, Td, SIN, MP / 512, MS / 512, ch >> 1, ch & 1, (it & 31) * 512 + tid * 4, carry); } }
    else { const int r = it - 256, pc = r >> 3; hgrn_b_chain<4>(Fo, Td, SIN, (pc >> 3) * 4, 4, (pc >> 1) & 3, pc & 1, (r & 7) * 2048 + tid * 4, carry); }
}
__device__ __forceinline__ void hgrn_c_unit(const Args& a, int unit, int j, LAS unsigned char* lds, int wave_s) {
    int tid_ = tid_from_wave(wave_s); asm volatile("" : "+v"(tid_)); const int tid = tid_, lane = tid & 63, wave = __builtin_amdgcn_readfirstlane(tid >> 6), l31 = lane & 31, h = lane >> 5;
    const int tt = unit >> 2, hh = unit & 3, ti = wave >> 2, ej = wave & 3, tok = tt * 64 + 32 * ti + l31, sc = (tt * 64) >> 9;
    const bf16* Z = (const bf16*)(a.ws + WS_Z); const bf16* OP = (const bf16*)a.out; const bf16* QTg = (const bf16*)(a.ws + WS_QT); const bf16* SIN = (const bf16*)(a.ws + WS_SIN); bf16* OB = (bf16*)(a.ws + WS_OB);
    f32x16 acc = (f32x16){0.f, 0.f, 0.f, 0.f, 0.f, 0.f, 0.f, 0.f, 0.f, 0.f, 0.f, 0.f, 0.f, 0.f, 0.f, 0.f};
#pragma unroll
    for (int dir = 0; dir < 2; ++dir) { const bf16* sin = SIN + ((size_t)sc * 8 + hh * 2 + dir) * 16384 + (size_t)(32 * ej + l31) * 128 + 8 * h; const bf16* qt = QTg + ((size_t)dir * M + tok) * 512 + hh * 128 + 8 * h;
        bf16x8 af[8], bq[8];
#pragma unroll
        for (int k8 = 0; k8 < 8; ++k8) { af[k8] = *(const bf16x8*)(sin + 16 * k8); bq[k8] = *(const bf16x8*)(qt + 16 * k8); }
#pragma unroll
        for (int k8 = 0; k8 < 8; ++k8) acc = __builtin_amdgcn_mfma_f32_32x32x16_bf16(af[k8], bq[k8], acc, 0, 0, 0); }
    float ss = 0.f;
#pragma unroll
    for (int qd = 0; qd < 4; ++qd) { const int e0 = 32 * ej + 8 * qd + 4 * h; const v2u p0 = *(const v2u*)(OP + (size_t)tok * 512 + hh * 128 + e0), p1 = *(const v2u*)(OP + ((size_t)M + tok) * 512 + hh * 128 + e0);
        acc[4 * qd] += bflo(p0.x) + bflo(p1.x); acc[4 * qd + 1] += bfhi(p0.x) + bfhi(p1.x); acc[4 * qd + 2] += bflo(p0.y) + bflo(p1.y); acc[4 * qd + 3] += bfhi(p0.y) + bfhi(p1.y);
        ss += (acc[4 * qd] * acc[4 * qd] + acc[4 * qd + 1] * acc[4 * qd + 1]) + (acc[4 * qd + 2] * acc[4 * qd + 2] + acc[4 * qd + 3] * acc[4 * qd + 3]); }
    ss += __shfl_xor(ss, 32);
    LAS float* sq = (LAS float*)lds;
    __syncthreads();
    if (h == 0) sq[(ti * 4 + ej) * 32 + l31] = ss;
    __syncthreads();
    const float tot = (sq[(ti * 4 + 0) * 32 + l31] + sq[(ti * 4 + 1) * 32 + l31]) + (sq[(ti * 4 + 2) * 32 + l31] + sq[(ti * 4 + 3) * 32 + l31]);
    const float rstd = 1.0f / sqrtf(tot * (1.0f / 128.0f) + RMS_EPS);
    const float* ng = a.hgrn_norm_g + j * 128;
#pragma unroll
    for (int qd = 0; qd < 4; ++qd) { const int e0 = 32 * ej + 8 * qd + 4 * h; const v2u gw2 = *(const v2u*)(Z + (size_t)tok * NZ + ZG + hh * 128 + e0); const f32x4 n4 = *(const f32x4*)(ng + e0);
        const float g0 = bflo(gw2.x), g1 = bfhi(gw2.x), g2 = bflo(gw2.y), g3 = bfhi(gw2.y);
        const float y0 = acc[4 * qd] * rstd * n4[0] * silu_f(g0), y1 = acc[4 * qd + 1] * rstd * n4[1] * silu_f(g1), y2 = acc[4 * qd + 2] * rstd * n4[2] * silu_f(g2), y3 = acc[4 * qd + 3] * rstd * n4[3] * silu_f(g3);
        v2u w; w.x = cvtpk(y0, y1); w.y = cvtpk(y2, y3); *(v2u*)(OB + (size_t)tok * 1024 + hh * 128 + e0) = w; }
}

__device__ __forceinline__ void hgrn_c_wave(const Args& a, int wu, int j, int wave_s) {
    int tid_ = tid_from_wave(wave_s); asm volatile("" : "+v"(tid_)); const int lane = tid_ & 63, l31 = lane & 31, h = lane >> 5;
    const int tile = wu >> 2, hh = wu & 3, tok = tile * 32 + l31, sc = (tile * 32) >> 9;
    const bf16* Z = (const bf16*)(a.ws + WS_Z); const bf16* OP = (const bf16*)a.out; const bf16* QTg = (const bf16*)(a.ws + WS_QT); const bf16* SIN = (const bf16*)(a.ws + WS_SIN); bf16* OB = (bf16*)(a.ws + WS_OB);
    const f32x16 zero16 = (f32x16){0.f, 0.f, 0.f, 0.f, 0.f, 0.f, 0.f, 0.f, 0.f, 0.f, 0.f, 0.f, 0.f, 0.f, 0.f, 0.f};
    f32x16 acc[4] = {zero16, zero16, zero16, zero16};
#pragma unroll
    for (int dir = 0; dir < 2; ++dir) {
        const bf16* sin = SIN + ((size_t)sc * 8 + hh * 2 + dir) * 16384 + (size_t)l31 * 128 + 8 * h; const bf16* qt = QTg + ((size_t)dir * M + tok) * 512 + hh * 128 + 8 * h;
#pragma unroll
        for (int kh = 0; kh < 2; ++kh) {
            bf16x8 af[4][4], bq[4];
#pragma unroll
            for (int k4 = 0; k4 < 4; ++k4) { bq[k4] = *(const bf16x8*)(qt + 16 * (4 * kh + k4));
#pragma unroll
                for (int et = 0; et < 4; ++et) af[k4][et] = *(const bf16x8*)(sin + (size_t)et * 32 * 128 + 16 * (4 * kh + k4)); }
#pragma unroll
            for (int k4 = 0; k4 < 4; ++k4)
#pragma unroll
                for (int et = 0; et < 4; ++et) acc[et] = __builtin_amdgcn_mfma_f32_32x32x16_bf16(af[k4][et], bq[k4], acc[et], 0, 0, 0);
        }
    }
    float ss = 0.f;
#pragma unroll
    for (int et = 0; et < 4; ++et)
#pragma unroll
        for (int qd = 0; qd < 4; ++qd) { const int e0 = 32 * et + 8 * qd + 4 * h; const v2u p0 = *(const v2u*)(OP + (size_t)tok * 512 + hh * 128 + e0), p1 = *(const v2u*)(OP + ((size_t)M + tok) * 512 + hh * 128 + e0);
            acc[et][4 * qd] += bflo(p0.x) + bflo(p1.x); acc[et][4 * qd + 1] += bfhi(p0.x) + bfhi(p1.x); acc[et][4 * qd + 2] += bflo(p0.y) + bflo(p1.y); acc[et][4 * qd + 3] += bfhi(p0.y) + bfhi(p1.y);
            ss += (acc[et][4 * qd] * acc[et][4 * qd] + acc[et][4 * qd + 1] * acc[et][4 * qd + 1]) + (acc[et][4 * qd + 2] * acc[et][4 * qd + 2] + acc[et][4 * qd + 3] * acc[et][4 * qd + 3]); }
    ss += __shfl_xor(ss, 32);
    const float rstd = 1.0f / sqrtf(ss * (1.0f / 128.0f) + RMS_EPS);
    const float* ng = a.hgrn_norm_g + j * 128;
#pragma unroll
    for (int et = 0; et < 4; ++et)
#pragma unroll
        for (int qd = 0; qd < 4; ++qd) { const int e0 = 32 * et + 8 * qd + 4 * h; const v2u gw2 = *(const v2u*)(Z + (size_t)tok * NZ + ZG + hh * 128 + e0); const f32x4 n4 = *(const f32x4*)(ng + e0);
            const float g0 = bflo(gw2.x), g1 = bfhi(gw2.x), g2 = bflo(gw2.y), g3 = bfhi(gw2.y);
            const float y0 = acc[et][4 * qd] * rstd * n4[0] * silu_f(g0), y1 = acc[et][4 * qd + 1] * rstd * n4[1] * silu_f(g1), y2 = acc[et][4 * qd + 2] * rstd * n4[2] * silu_f(g2), y3 = acc[et][4 * qd + 3] * rstd * n4[3] * silu_f(g3);
            v2u w; w.x = cvtpk(y0, y1); w.y = cvtpk(y2, y3); *(v2u*)(OB + (size_t)tok * 1024 + hh * 128 + e0) = w; }
}

constexpr int HC_PITCH = 272, HC_BUF = 32 * HC_PITCH, HC_WAVE = 2 * HC_BUF;
static_assert(8 * HC_WAVE <= MISC_OFF, "HGRN level C v4 LDS map");
__device__ __forceinline__ void hgrn_c_wave4(const Args& a, int wu, int j, LAS unsigned char* lds, int wave_s) {
    int tid_ = tid_from_wave(wave_s); asm volatile("" : "+v"(tid_)); const int lane = tid_ & 63, l31 = lane & 31, h = lane >> 5;
    const int tile = wu >> 2, hh = wu & 3, tok = tile * 32 + l31, sc = (tile * 32) >> 9;
    const bf16* Z = (const bf16*)(a.ws + WS_Z); const bf16* OP = (const bf16*)a.out; const bf16* QTg = (const bf16*)(a.ws + WS_QT); const bf16* SIN = (const bf16*)(a.ws + WS_SIN); bf16* OB = (bf16*)(a.ws + WS_OB);
    LAS unsigned char* b0 = lds + wave_s * HC_WAVE; LAS unsigned char* b1 = b0 + HC_BUF;
    const int cch = lane & 15, rsub = lane >> 4;
    const int lco = rsub * HC_PITCH + cch * 16, lmf = l31 * HC_PITCH + 8 * h;
    const f32x16 zero16 = (f32x16){0.f, 0.f, 0.f, 0.f, 0.f, 0.f, 0.f, 0.f, 0.f, 0.f, 0.f, 0.f, 0.f, 0.f, 0.f, 0.f};
    f32x16 acc[4] = {zero16, zero16, zero16, zero16};
    v4u pa[8], pb[8];
    { const bf16* o0 = OP + ((size_t)tile * 32 + rsub) * 512 + hh * 128 + 8 * cch; const bf16* o1 = o0 + (size_t)M * 512;
#pragma unroll
      for (int it = 0; it < 8; ++it) { pa[it] = *(const v4u*)(o0 + (size_t)(4 * it) * 512); pb[it] = *(const v4u*)(o1 + (size_t)(4 * it) * 512); } }
    __builtin_amdgcn_sched_barrier(0);
    if (tile * 32 >= MP) {
#pragma unroll
    for (int dir = 0; dir < 2; ++dir) {
        const bf16* sin = SIN + ((size_t)sc * 8 + hh * 2 + dir) * 16384 + (size_t)lane * 8; const bf16* qt = QTg + ((size_t)dir * M + tok) * 512 + hh * 128 + 8 * h;
#pragma unroll
        for (int kh = 0; kh < 4; ++kh) {
            bf16x8 af[2][4], bq[2];
#pragma unroll
            for (int k2 = 0; k2 < 2; ++k2) { bq[k2] = *(const bf16x8*)(qt + 16 * (2 * kh + k2));
#pragma unroll
                for (int et = 0; et < 4; ++et) af[k2][et] = *(const bf16x8*)(sin + (size_t)((et * 8 + 2 * kh + k2) * 64) * 8); }
#pragma unroll
            for (int k2 = 0; k2 < 2; ++k2)
#pragma unroll
                for (int et = 0; et < 4; ++et) acc[et] = __builtin_amdgcn_mfma_f32_32x32x16_bf16(af[k2][et], bq[k2], acc[et], 0, 0, 0);
        }
    }
    }
    __builtin_amdgcn_sched_barrier(0);
#pragma unroll
    for (int it = 0; it < 8; ++it) { *(LAS v4u*)(b0 + lco + it * 4 * HC_PITCH) = pa[it]; *(LAS v4u*)(b1 + lco + it * 4 * HC_PITCH) = pb[it]; }
    { const bf16* g0p = Z + ((size_t)tile * 32 + rsub) * NZ + ZG + hh * 128 + 8 * cch;
#pragma unroll
      for (int it = 0; it < 8; ++it) pa[it] = *(const v4u*)(g0p + (size_t)(4 * it) * NZ); }
    LDS_WAIT();
    float ss = 0.f;
#pragma unroll
    for (int et = 0; et < 4; ++et)
#pragma unroll
        for (int qd = 0; qd < 4; ++qd) { const v2u p0 = *(const LAS v2u*)(b0 + lmf + (32 * et + 8 * qd) * 2), p1 = *(const LAS v2u*)(b1 + lmf + (32 * et + 8 * qd) * 2);
            acc[et][4 * qd] += bflo(p0.x) + bflo(p1.x); acc[et][4 * qd + 1] += bfhi(p0.x) + bfhi(p1.x); acc[et][4 * qd + 2] += bflo(p0.y) + bflo(p1.y); acc[et][4 * qd + 3] += bfhi(p0.y) + bfhi(p1.y);
            ss += (acc[et][4 * qd] * acc[et][4 * qd] + acc[et][4 * qd + 1] * acc[et][4 * qd + 1]) + (acc[et][4 * qd + 2] * acc[et][4 * qd + 2] + acc[et][4 * qd + 3] * acc[et][4 * qd + 3]); }
    ss = sum_xor32(ss);
    const float rstd = 1.0f / sqrtf(ss * (1.0f / 128.0f) + RMS_EPS);
    LDS_WAIT();
#pragma unroll
    for (int it = 0; it < 8; ++it) *(LAS v4u*)(b0 + lco + it * 4 * HC_PITCH) = pa[it];
    LDS_WAIT();
    const float* ng = a.hgrn_norm_g + j * 128;
#pragma unroll
    for (int et = 0; et < 4; ++et)
#pragma unroll
        for (int qd = 0; qd < 4; ++qd) { const int e0 = 32 * et + 8 * qd + 4 * h; const v2u gw2 = *(const LAS v2u*)(b0 + lmf + (32 * et + 8 * qd) * 2); const f32x4 n4 = *(const f32x4*)(ng + e0);
            const float g0 = bflo(gw2.x), g1 = bfhi(gw2.x), g2 = bflo(gw2.y), g3 = bfhi(gw2.y);
            const float y0 = acc[et][4 * qd] * rstd * n4[0] * silu_f(g0), y1 = acc[et][4 * qd + 1] * rstd * n4[1] * silu_f(g1), y2 = acc[et][4 * qd + 2] * rstd * n4[2] * silu_f(g2), y3 = acc[et][4 * qd + 3] * rstd * n4[3] * silu_f(g3);
            v2u w; w.x = cvtpk(y0, y1); w.y = cvtpk(y2, y3); *(LAS v2u*)(b1 + lmf + (32 * et + 8 * qd) * 2) = w; }
    LDS_WAIT();
    { bf16* ob = OB + ((size_t)tile * 32 + rsub) * 1024 + hh * 128 + 8 * cch;
#pragma unroll
      for (int it = 0; it < 8; ++it) *(v4u*)(ob + (size_t)(4 * it) * 1024) = *(const LAS v4u*)(b1 + lco + it * 4 * HC_PITCH); }
    LDS_WAIT();
}

__device__ __forceinline__ Args load_args() {
#if defined(__HIP_DEVICE_COMPILE__)
    unsigned long long p = (unsigned long long)__builtin_amdgcn_kernarg_segment_ptr(); asm volatile("" : "+s"(p)); return *(const __attribute__((address_space(4))) Args*)p;
#else
    return Args{};
#endif
}
#define PH_ARGS() const Args a = load_args(); unsigned char* const ws = a.ws; float* const smallf = (float*)(ws + WS_SMALL); bf16* const Wb = (bf16*)(ws + WS_W); bf16* const XB = (bf16*)(ws + WS_XB); bf16* const Zb = (bf16*)(ws + WS_Z); \
    bf16* const OB = (bf16*)(ws + WS_OB); float* const stat_mix = (float*)(ws + WS_STATMIX); float* const stat_ffn = (float*)(ws + WS_STATFFN); float* const vstat = (float*)(ws + WS_VSTAT); \
    (void)smallf; (void)Wb; (void)XB; (void)Zb; (void)OB; (void)stat_mix; (void)stat_ffn; (void)vstat
#define PH_TID() int tid_ = tid_from_wave(wave_s); asm volatile("" : "+v"(tid_)); const int tid = tid_, lane = tid & 63, wave = __builtin_amdgcn_readfirstlane(tid >> 6), gw = vcu * NWAVES + wave; (void)lane; (void)gw

__global__ void __launch_bounds__(NTHR, 2) fwd_kernel(Args a_unused) {
    extern __shared__ __attribute__((aligned(16))) unsigned char lds_raw[];
    LAS unsigned char* lds = (LAS unsigned char*)lds_raw;
    volatile LAS unsigned* MISC = (volatile LAS unsigned*)(lds + MISC_OFF);
    constexpr int G = 256, NGW = G * NWAVES;
    const int bx = blockIdx.x; __builtin_assume(bx >= 0 && bx < 256);
    const int vcu = (bx & 7) * (G / 8) + (bx >> 3);
    const int wave_s = __builtin_amdgcn_readfirstlane((int)threadIdx.x >> 6);
    if (threadIdx.x < 64) MISC[threadIdx.x] = 0u;
    __syncthreads();
    { const Args a = load_args(); (void)xcd_barrier_post((unsigned*)(a.ws + WS_CTL), MISC + 8, tid_from_wave(wave_s) == 0); }
#define GRID_BAR() do { const Args a_ = load_args(); XcdBarrier b_; b_.bar = (unsigned*)(a_.ws + WS_CTL); b_.x = xb_xcc_id(); b_.st = MISC + 8; int t_ = tid_from_wave(wave_s); asm volatile("" : "+v"(t_)); xcd_barrier(b_, t_ == 0); } while (0)

    {
        PH_ARGS(); PH_TID();
        LAS float* scr = (LAS float*)(lds + wave * 16640);
        constexpr int I_INAB = (D / 64) * (NZ / 64), I_OUTAB = (D / 64) * (D / 64), I_INC = (D / 64) * (4096 / 64), I_OUTC = (CW / 64) * (D / 64), I_GU = (D / 64) * (FF / 64), I_DN = (FF / 64) * (D / 64);
        float* const PF = (float*)(ws + WS_PF);
        constexpr int NITEMS = 2 * I_INAB + 2 * I_OUTAB + 2 * I_INC + 2 * I_OUTC + 8 * I_GU + 4 * I_DN;
        for (int it = gw; it < NITEMS; it += NGW) {
            int r = it;
            if (r < 2 * I_INAB) { const int jj = r / I_INAB; p0_transpose_item(a.w_in_ab + (size_t)jj * D * NZ, D, NZ, Wb + W_INAB + (size_t)jj * NZ * D, 0, jj ? a.ln_ffn_g + 1 * D : nullptr, scr, r % I_INAB, lane, true, jj ? a.ln_ffn_b + 1 * D : nullptr, jj ? PF : nullptr, jj ? PF + (SM_BW_AB1 - SM_GW_AB1) : nullptr); continue; } r -= 2 * I_INAB;
            if (r < 2 * I_OUTAB) { const int jj = r / I_OUTAB; p0_transpose_item(a.w_out_ab + (size_t)jj * D * D, D, D, Wb + W_OUTAB + (size_t)jj * D * D, 0, nullptr, scr, r % I_OUTAB, lane); continue; } r -= 2 * I_OUTAB;
            if (r < 2 * I_INC) { const int jj = r / I_INC; p0_transpose_item(a.w_in_c + (size_t)jj * D * 4096, D, 4096, Wb + W_INC + (size_t)jj * 4096 * D, 0, a.ln_ffn_g + (2 * jj) * D, scr, r % I_INC, lane, true, a.ln_ffn_b + (2 * jj) * D, PF + (SM_GW_C - SM_GW_AB1) + jj * 4096, PF + (SM_BW_C - SM_GW_AB1) + jj * 4096); continue; } r -= 2 * I_INC;
            if (r < 2 * I_OUTC) { const int jj = r / I_OUTC; p0_transpose_item(a.w_out_c + (size_t)jj * CW * D, CW, D, Wb + W_OUTC + (size_t)jj * D * CW, 0, nullptr, scr, r % I_OUTC, lane); continue; } r -= 2 * I_OUTC;
            if (r < 8 * I_GU) { const int L = r / (2 * I_GU), wh = (r / I_GU) & 1; p0_transpose_item((wh ? a.w_up : a.w_gate) + (size_t)L * D * FF, D, FF, Wb + W_GU + (size_t)L * 2 * FF * D, 1 + wh, a.ln_mix_g + L * D, scr, r % I_GU, lane, true, a.ln_mix_b + L * D, PF + (SM_GW_GU - SM_GW_AB1) + L * 5632, PF + (SM_BW_GU - SM_GW_AB1) + L * 5632); continue; } r -= 8 * I_GU;
            { const int L = r / I_DN; p0_transpose_item(a.w_down + (size_t)L * FF * D, FF, D, Wb + W_DN + (size_t)L * D * FF, 0, nullptr, scr, r % I_DN, lane); }
        }
        for (int r = gw; r < 2048; r += NGW) { const float w0 = a.c_ws[(size_t)r * 128 + 2 * lane], w1 = a.c_ws[(size_t)r * 128 + 2 * lane + 1];
            { const int tr = r & 127, sc2 = 2 * lane;
              *(unsigned*)((bf16*)(ws + WS_WSB) + (size_t)(r >> 7) * 16384 + ((((tr >> 5) * 8 + (sc2 >> 4)) * 64) + (tr & 31) + 32 * ((sc2 >> 3) & 1)) * 8 + (sc2 & 7)) = pk2(w0, w1); } const float rs = wave_sum(w0 + w1); if (lane == 0) smallf[SM_RSW + r] = rs; }
        for (int i = bx * NTHR + tid; i < 2048; i += G * NTHR) { const int jj = i >> 10, r = i & 1023; float v = 0.f;
            if (jj == 1) { const float l0 = a.lb_logits[r], l1 = a.lb_logits[1024 + r]; const float mxx = fmaxf(l0, l1), e0 = expf(l0 - mxx), e1 = expf(l1 - mxx); const float p0 = e0 / (e0 + e1), p1 = e1 / (e0 + e1); v = fmaxf((p0 + p1) - p0, 0.f); }
            smallf[SM_LB + i] = v; }
        static_assert(M % (4 * NGW) == 0, "x conversion: 4 rows per wave per step");
        for (int m0 = gw; m0 < M; m0 += 4 * NGW) { f32x4 v[4][4];
#pragma unroll
            for (int q = 0; q < 4; ++q) { const int m = m0 + q * NGW; const float* xr = m < MP ? a.x_prompt + (size_t)m * D : a.x_sample + (size_t)(m - MP) * D; const GAS f32x4* xp = (const GAS f32x4*)xr + lane;
#pragma unroll
                for (int jq = 0; jq < 4; ++jq) v[q][jq] = xp[64 * jq]; }
#pragma unroll
            for (int q = 0; q < 4; ++q) { GAS v2u* o8 = (GAS v2u*)(XB + (size_t)(m0 + q * NGW) * D) + lane;
#pragma unroll
                for (int jq = 0; jq < 4; ++jq) { v2u w; w.x = pk2h(v[q][jq].x, v[q][jq].y); w.y = pk2h(v[q][jq].z, v[q][jq].w); o8[64 * jq] = w; } } }
    }
    GRID_BAR();
    {
        PH_ARGS(); PH_TID(); const float* PF = (const float*)(ws + WS_PF);
        for (int i = bx * NTHR + tid; i < FOLD_N; i += G * NTHR) { float acc = 0.f;
#pragma unroll
            for (int kb = 0; kb < 16; ++kb) acc += PF[(size_t)kb * FOLD_N + i];
            smallf[SM_GW_AB1 + i] = acc; }
    }

    for (int L = 0; L < 4; ++L) {
        const int j = L >> 1;
        if ((L & 1) == 0) {
            { PH_ARGS(); pg8::Gemm g{XB, Wb + W_INAB + (size_t)j * NZ * D, M, NZ, D}; pg8::StaticOrder S; S.init(M, NZ, G, bx);
              pg8::EpiZ E{Zb, NZ, L == 0 ? nullptr : stat_ffn, smallf + SM_GW_AB1, smallf + SM_BW_AB1};
              for (int rep = 0; rep < REP_G; ++rep) pg8::gemm_phase<pg8::EpiZ, pg8::StaticOrder, true, true, true>(lds, g, S, E, wave_s); }
            GRID_BAR();
            { PH_ARGS();
#if NAIVE_HGRN
              for (int u = bx; u < 66; u += G) naive_hgrn_unit(a, u, j, lds, wave_s);
#else
#ifndef SKIP_HA
              for (int rep = 0; rep < REP_HA; ++rep) for (int u = bx; u < 512; u += G) hgrn_a_unit2(a, u, j, lds, wave_s);
#endif
#endif
#if NAIVE_ATTN
              for (int u = bx; u < M / 64; u += G) naive_attn_unit(a, u, j, wave_s);
#else
              for (int rep = 0; rep < REP_ATT; ++rep) for (int u = bx; u < (M / 128) * 2; u += G) attn_unit(a, u, j, lds, wave_s);
#endif
            }
            GRID_BAR();
            { PH_ARGS();
#if NAIVE_HGRN
              naive_hgrn_finish(a, j, vcu, NGW, wave_s);
#else
#ifndef SKIP_HB
              for (int rep = 0; rep < REP_HBC; ++rep) for (int it = bx; it < 256; it += G) hgrn_b_item(a, it, wave_s);
#endif
#endif
            }
            GRID_BAR();
#if !NAIVE_HGRN
            { PH_ARGS();
#ifndef SKIP_HC
              for (int rep = 0; rep < REP_HBC; ++rep) for (int i = 0; i < 5; ++i) hgrn_c_wave4(a, i < 4 ? (bx * 4 + i) * 8 + wave_s : 8192 + bx * 8 + wave_s, j, lds, wave_s);
#endif
            }
            GRID_BAR();
#endif
            { PH_ARGS(); pg8::Gemm g{OB, Wb + W_OUTAB + (size_t)j * D * D, M, D, D}; pg8::StaticOrder S; S.init(M, D, G, bx);
              if (L == 0) { pg8::EpiResid<true> E{nullptr, nullptr, nullptr, XB, stat_mix, nullptr, nullptr, nullptr, ALPHA};
                  pg8::gemm_phase<pg8::EpiResid<true>, pg8::StaticOrder, true, true>(lds, g, S, E, wave_s); }
              else { pg8::EpiResid<false> E{nullptr, nullptr, nullptr, XB, stat_mix, stat_ffn, a.ln_ffn_g + (L - 1) * D, a.ln_ffn_b + (L - 1) * D, ALPHA};
                  pg8::gemm_phase<pg8::EpiResid<false>, pg8::StaticOrder, true, true>(lds, g, S, E, wave_s); } }
            GRID_BAR();
        } else {
            { PH_ARGS(); pg8::Gemm g{XB, Wb + W_INC + (size_t)j * 4096 * D, M, 4096, D}; pg8::StaticOrder S; S.init(M, 4096, G, bx);
              pg8::EpiGeluUV E{Zb, (bf16*)(ws + WS_R1), vstat, stat_ffn, smallf + SM_GW_C + j * 4096, smallf + SM_BW_C + j * 4096};
              for (int rep = 0; rep < REP_G; ++rep) pg8::gemm_phase<pg8::EpiGeluUV, pg8::StaticOrder, true, true, true>(lds, g, S, E, wave_s); }
            GRID_BAR();
            { PH_ARGS();
#if NAIVE_SGU
              for (int u = bx; u < (M / 128) * 8; u += G) naive_sgu_unit(a, u, j, lds, wave_s);
#else
              for (int i5 = 0; i5 < 5; ++i5) {
                  const int pmi = 40 * ((bx >> 2) & 7) + 8 * (4 - i5) + (bx >> 5); sgu_unit4(a, (2 * pmi + ((bx >> 1) & 1)) * 2 + (bx & 1), j, lds, wave_s); }
#endif
            }
            GRID_BAR();
            { PH_ARGS(); pg8::Gemm g{Zb, Wb + W_OUTC + (size_t)j * D * CW, M, D, CW}; pg8::StaticOrder S; S.init(M, D, G, bx);
              pg8::EpiResid<false> E{nullptr, nullptr, nullptr, XB, stat_mix, stat_ffn, a.ln_ffn_g + (L - 1) * D, a.ln_ffn_b + (L - 1) * D, ALPHA};
              pg8::gemm_phase<pg8::EpiResid<false>, pg8::StaticOrder, true, true>(lds, g, S, E, wave_s); }
            GRID_BAR();
        }
        { PH_ARGS(); pg8::Gemm g{XB, Wb + W_GU + (size_t)L * 2 * FF * D, M, 2 * FF, D}; pg8::StaticOrder S; S.init(M, 2 * FF, G, bx);
          pg8::EpiSwiglu E{Zb, stat_mix, smallf + SM_GW_GU + L * 5632, smallf + SM_BW_GU + L * 5632};
          for (int rep = 0; rep < REP_G; ++rep) pg8::gemm_phase<pg8::EpiSwiglu, pg8::StaticOrder, true, true, true>(lds, g, S, E, wave_s); }
        GRID_BAR();
        { PH_ARGS(); pg8::Gemm g{Zb, Wb + W_DN + (size_t)L * D * FF, M, D, FF}; pg8::StaticOrder S; S.init(M, D, G, bx, true);
          pg8::EpiResid<false> E{nullptr, nullptr, nullptr, XB, stat_ffn, stat_mix, a.ln_mix_g + L * D, a.ln_mix_b + L * D, ALPHA};
          pg8::gemm_phase<pg8::EpiResid<false>, pg8::StaticOrder, true, true>(lds, g, S, E, wave_s); }
        GRID_BAR();
    }
    { PH_ARGS(); PH_TID();
      f32x4 gq[4], bq[4];
#pragma unroll
      for (int jq = 0; jq < 4; ++jq) { gq[jq] = *((const f32x4*)(a.ln_ffn_g + 3 * D) + lane + 64 * jq); bq[jq] = *((const f32x4*)(a.ln_ffn_b + 3 * D) + lane + 64 * jq); }
      static_assert(M % (2 * NGW) == 0, "final LayerNorm: two rows per wave per step");
      for (int m0 = gw; m0 < M; m0 += 2 * NGW) {
          v2u xw[2][4]; f32x4 sv[2][8];
#pragma unroll
          for (int rr = 0; rr < 2; ++rr) { const int m = m0 + rr * NGW; const GAS v2u* xq = (const GAS v2u*)(XB + (size_t)m * D) + lane; const f32x4* sp = (const f32x4*)(stat_ffn + (size_t)m * 32);
#pragma unroll
              for (int jq = 0; jq < 4; ++jq) xw[rr][jq] = xq[64 * jq];
#pragma unroll
              for (int i8 = 0; i8 < 8; ++i8) sv[rr][i8] = sp[i8]; }
          __builtin_amdgcn_sched_barrier(0);
#pragma unroll
          for (int rr = 0; rr < 2; ++rr) { const int m = m0 + rr * NGW; float ms = 0.f;
#pragma unroll
              for (int i8 = 0; i8 < 8; ++i8) ms += sv[rr][i8][0] + sv[rr][i8][2];
              const float mu = ms * (1.0f / 16.0f); float q = 0.f;
#pragma unroll
              for (int i8 = 0; i8 < 8; ++i8) { const float d0 = sv[rr][i8][0] - mu, d1 = sv[rr][i8][2] - mu; q += (sv[rr][i8][1] + sv[rr][i8][3]) + 64.0f * (d0 * d0 + d1 * d1); }
              const float rstd = __builtin_amdgcn_rsqf(q * (1.0f / 1024.0f) + pg8::LN_EPS);
              GAS f32x4* op = (GAS f32x4*)(a.out + (size_t)m * D) + lane;
#pragma unroll
              for (int jq = 0; jq < 4; ++jq) { pg8::u32x2 w2; w2.x = xw[rr][jq].x; w2.y = xw[rr][jq].y; const f32x4 v = pg8::f16x4_to_f32(w2); op[64 * jq] = (v - mu) * rstd * gq[jq] + bq[jq]; } } } }
}

extern "C" void kernel_launch(void* const* d_in, const int* in_sizes, int n_in, void* d_out, int out_size, void* d_ws, size_t ws_size, hipStream_t stream) {
    static int grid = 0;
    if (grid == 0) {
        if (n_in != 20 || out_size != M * D || ws_size < WS_END) { fprintf(stderr, "kernel_launch: unexpected shapes (n_in %d out %d ws %zu)\n", n_in, out_size, ws_size); grid = -1; return; }
        int dev = 0, cus = 0, per_cu = 0;
        if (hipGetDevice(&dev) != hipSuccess || hipDeviceGetAttribute(&cus, hipDeviceAttributeMultiprocessorCount, dev) != hipSuccess) { grid = -1; return; }
        if (hipFuncSetAttribute((const void*)fwd_kernel, hipFuncAttributeMaxDynamicSharedMemorySize, LDS_BYTES) != hipSuccess) { fprintf(stderr, "kernel_launch: hipFuncSetAttribute failed\n"); grid = -1; return; }
        if (hipOccupancyMaxActiveBlocksPerMultiprocessor(&per_cu, (const void*)fwd_kernel, NTHR, LDS_BYTES) != hipSuccess || per_cu < 1) fprintf(stderr, "kernel_launch: occupancy query says %d\n", per_cu);
        (void)hipGetLastError();
        if (cus < 256) { fprintf(stderr, "kernel_launch: needs 256 CUs, device has %d\n", cus); grid = -1; return; }
        grid = 256;
    }
    if (grid < 0) return;
    (void)hipMemsetAsync((char*)d_ws + WS_CTL, 0, CTL_ZERO_BYTES, stream);
    Args a{};
    a.x_prompt = (const float*)d_in[0]; a.x_sample = (const float*)d_in[1]; a.w_in_ab = (const float*)d_in[2]; a.lb_logits = (const float*)d_in[3]; a.hgrn_norm_g = (const float*)d_in[4];
    a.attn_sink = (const float*)d_in[5]; a.w_out_ab = (const float*)d_in[6]; a.w_in_c = (const float*)d_in[7]; a.c_ln_g = (const float*)d_in[8]; a.c_ln_b = (const float*)d_in[9];
    a.c_ws = (const float*)d_in[10]; a.c_bs = (const float*)d_in[11]; a.w_out_c = (const float*)d_in[12]; a.w_gate = (const float*)d_in[13]; a.w_up = (const float*)d_in[14];
    a.w_down = (const float*)d_in[15]; a.ln_mix_g = (const float*)d_in[16]; a.ln_mix_b = (const float*)d_in[17]; a.ln_ffn_g = (const float*)d_in[18]; a.ln_ffn_b = (const float*)d_in[19];
    a.out = (float*)d_out; a.ws = (unsigned char*)d_ws;
    hipLaunchKernelGGL(fwd_kernel, dim3(grid), dim3(NTHR), LDS_BYTES, stream, a);
}
```
